# Optimizing an MI355X kernel written in HIP

```python
import numpy as np
import jax
import jax.numpy as jnp
from jax import lax


D_MODEL = 1024
BATCH = 8
SEQ = 4096
DEPTH = 4

EPS = 1e-6
ROPE_THETA = 10000.0
NEG = -1e30
TINY = 1e-30
Q_BLOCK = 128

NSA_HEADS = 8
NSA_KV_GROUPS = 2
NSA_HEAD_DIM = 64
CMP_BLOCK = 32
CMP_STRIDE = 16
CMP_HIDDEN = 4 * NSA_HEAD_DIM
SLC_BLOCK = 64
SLC_TOPK = 16
N_LOCAL_FORCED = 2
FORCE_BONUS = 1e4
SLC_Q_BLOCK = 64
WINDOW = 512

MLA_HEADS = 8
MLA_Q_LORA = 256
MLA_KV_LORA = 128
MLA_NOPE = 64
MLA_ROPE = 32
MLA_V = 64

D_FF = 4 * D_MODEL

NSA_Q_COLS = NSA_HEADS * NSA_HEAD_DIM
NSA_KV_COLS = 2 * NSA_KV_GROUPS * NSA_HEAD_DIM
NSA_GATE_COLS = 3 * NSA_HEADS
IN_SPLITS = (NSA_Q_COLS, NSA_KV_COLS, NSA_KV_COLS, NSA_KV_COLS, NSA_GATE_COLS,
             MLA_Q_LORA, MLA_KV_LORA, MLA_ROPE, D_MODEL, D_MODEL)
IN_COLS = sum(IN_SPLITS)

kernel_name = 'hybrid_nsa_mla_gated_block'


def rms_norm(x, g):
    xf = x.astype(jnp.float32)
    y = xf * lax.rsqrt(jnp.mean(xf * xf, axis=-1, keepdims=True) + EPS)
    return (y * g.astype(jnp.float32)).astype(x.dtype)


def rope(x, pos):
    d = x.shape[-1]
    inv = ROPE_THETA ** (-jnp.arange(0, d, 2, dtype=jnp.float32) / d)
    ang = pos.astype(jnp.float32)[:, None] * inv[None, :]
    cos, sin = jnp.cos(ang), jnp.sin(ang)
    x1, x2 = jnp.split(x.astype(jnp.float32), 2, axis=-1)
    out = jnp.concatenate([x1 * cos - x2 * sin, x1 * sin + x2 * cos], axis=-1)
    return out.astype(x.dtype)


def masked_softmax(s, mask):
    sf = jnp.where(mask, s.astype(jnp.float32), NEG)
    m = jnp.max(sf, axis=-1, keepdims=True)
    e = jnp.where(mask, jnp.exp(sf - m), 0.0)
    p = e / jnp.maximum(jnp.sum(e, axis=-1, keepdims=True), TINY)
    return p.astype(s.dtype)


def split_cols(t):
    offsets = np.cumsum(np.array(IN_SPLITS))[:-1].tolist()
    return jnp.split(t, offsets, axis=-1)


def overlap_matrix(n_cmp, n_slc):
    start = np.arange(n_cmp) * CMP_STRIDE
    sel = np.arange(n_slc) * SLC_BLOCK
    lo = np.maximum(start[:, None], sel[None, :])
    hi = np.minimum(start[:, None] + CMP_BLOCK, sel[None, :] + SLC_BLOCK)
    return (np.clip(hi - lo, 0, None) / CMP_BLOCK).astype(np.float32)


_gather_bg = jax.vmap(jax.vmap(lambda t, i: t[i]))


def nsa_attention(q_flat, kv_cmp, kv_slc, kv_win, gate_logits, cmp_pe, cmp_w1, cmp_w2, pos):
    B, S, _ = q_flat.shape
    G, R, hd = NSA_KV_GROUPS, NSA_HEADS // NSA_KV_GROUPS, NSA_HEAD_DIM
    scale = hd ** -0.5
    q = rope(q_flat.reshape(B, S, G, R, hd).transpose(0, 2, 3, 1, 4), pos)

    def split_kv(kv):
        a = kv.reshape(B, S, 2, G, hd).transpose(2, 0, 3, 1, 4)
        return rope(a[0], pos), a[1]

    k_c, v_c = split_kv(kv_cmp)
    k_s, v_s = split_kv(kv_slc)
    k_w, v_w = split_kv(kv_win)

    n_cmp = (S - CMP_BLOCK) // CMP_STRIDE + 1
    blk_idx = jnp.arange(n_cmp)[:, None] * CMP_STRIDE + jnp.arange(CMP_BLOCK)[None, :]

    def compress(t, j):
        tb = t[:, :, blk_idx] + cmp_pe[j]
        h = jax.nn.silu(tb.reshape(B, G, n_cmp, CMP_BLOCK * hd) @ cmp_w1[j])
        return h @ cmp_w2[j]

    kc = compress(k_c, 0)
    vc = compress(v_c, 1)
    cmp_end = jnp.arange(n_cmp) * CMP_STRIDE + CMP_BLOCK - 1
    cmp_mask = cmp_end[None, :] <= pos[:, None]
    s_cmp = jnp.einsum('bgrsd,bgnd->bgrsn', q, kc) * scale
    p_cmp = masked_softmax(s_cmp, cmp_mask)
    o_cmp = jnp.einsum('bgrsn,bgnd->bgrsd', p_cmp, vc)

    n_slc = S // SLC_BLOCK
    k_top = min(SLC_TOPK, n_slc)
    ov = jnp.asarray(overlap_matrix(n_cmp, n_slc))
    imp = jnp.einsum('bgrsn,nj->bgsj', p_cmp.astype(jnp.float32), ov)
    blk = jnp.arange(n_slc)[None, :]
    cur = (pos // SLC_BLOCK)[:, None]
    causal = blk <= cur
    forced = (blk == 0) | ((cur - blk >= 0) & (cur - blk < N_LOCAL_FORCED))
    score = jnp.where(causal, imp + jnp.where(forced, FORCE_BONUS, 0.0), NEG)
    vals, sel_idx = lax.top_k(score, k_top)
    sel_ok = vals > 0.5 * NEG

    QS = SLC_Q_BLOCK
    nq = S // QS
    qc = jnp.moveaxis(q.reshape(B, G, R, nq, QS, hd), 3, 0)
    ic = jnp.moveaxis(sel_idx.reshape(B, G, nq, QS, k_top), 2, 0)
    okc = jnp.moveaxis(sel_ok.reshape(B, G, nq, QS, k_top), 2, 0)
    pc = pos.reshape(nq, QS)

    def slc_block(args):
        qb, ib, okb, tb = args
        tok = (ib[..., None] * SLC_BLOCK + jnp.arange(SLC_BLOCK)).reshape(
            ib.shape[:-1] + (ib.shape[-1] * SLC_BLOCK,))
        kg = _gather_bg(k_s, tok)
        vg = _gather_bg(v_s, tok)
        mask = jnp.repeat(okb, SLC_BLOCK, axis=-1) & (tok <= tb[:, None])
        s = jnp.einsum('bgrqd,bgqtd->bgrqt', qb, kg) * scale
        p = masked_softmax(s, mask[:, :, None])
        return jnp.einsum('bgrqt,bgqtd->bgrqd', p, vg)

    o_slc = lax.map(slc_block, (qc, ic, okc, pc))
    o_slc = jnp.moveaxis(o_slc, 0, 3).reshape(B, G, R, S, hd)

    nb = S // Q_BLOCK
    pad = ((0, 0), (0, 0), (WINDOW, 0), (0, 0))
    band = jnp.arange(nb)[:, None] * Q_BLOCK + jnp.arange(Q_BLOCK + WINDOW)[None, :]
    kband = jnp.moveaxis(jnp.pad(k_w, pad)[:, :, band], 2, 0)
    vband = jnp.moveaxis(jnp.pad(v_w, pad)[:, :, band], 2, 0)
    kpos = band - WINDOW
    qw = jnp.moveaxis(q.reshape(B, G, R, nb, Q_BLOCK, hd), 3, 0)
    pw = pos.reshape(nb, Q_BLOCK)

    def win_block(args):
        qb, kb, vb, tq, tk = args
        diff = tq[:, None] - tk[None, :]
        mask = (tk[None, :] >= 0) & (diff >= 0) & (diff < WINDOW)
        s = jnp.einsum('bgrqd,bgkd->bgrqk', qb, kb) * scale
        p = masked_softmax(s, mask)
        return jnp.einsum('bgrqk,bgkd->bgrqd', p, vb)

    o_win = lax.map(win_block, (qw, kband, vband, pw, kpos))
    o_win = jnp.moveaxis(o_win, 0, 3).reshape(B, G, R, S, hd)

    g = jax.nn.sigmoid(gate_logits).reshape(B, S, 3, G, R).transpose(2, 0, 3, 4, 1)[..., None]
    o = g[0] * o_cmp + g[1] * o_slc + g[2] * o_win
    return o.transpose(0, 3, 1, 2, 4).reshape(B, S, NSA_HEADS * hd)


def mla_attention(cq, ckv, k_rope_raw, q_norm, kv_norm, w_uq, w_ukv, pos):
    B, S, _ = cq.shape
    H = MLA_HEADS
    dq = MLA_NOPE + MLA_ROPE
    q = (rms_norm(cq, q_norm) @ w_uq).reshape(B, S, H, dq).transpose(0, 2, 1, 3)
    q = jnp.concatenate([q[..., :MLA_NOPE], rope(q[..., MLA_NOPE:], pos)], axis=-1)
    kv = (rms_norm(ckv, kv_norm) @ w_ukv).reshape(B, S, H, MLA_NOPE + MLA_V).transpose(0, 2, 1, 3)
    k_nope, v = kv[..., :MLA_NOPE], kv[..., MLA_NOPE:]
    k_pe = rope(k_rope_raw[:, None], pos)
    k = jnp.concatenate([k_nope, jnp.broadcast_to(k_pe, (B, H, S, MLA_ROPE))], axis=-1)
    scale = dq ** -0.5
    nb = S // Q_BLOCK
    qc = jnp.moveaxis(q.reshape(B, H, nb, Q_BLOCK, dq), 2, 0)
    pc = pos.reshape(nb, Q_BLOCK)

    def blk(args):
        qb, tq = args
        s = jnp.einsum('bhqd,bhkd->bhqk', qb, k) * scale
        p = masked_softmax(s, tq[:, None] >= pos[None, :])
        return jnp.einsum('bhqk,bhkd->bhqd', p, v)

    o = jnp.moveaxis(lax.map(blk, (qc, pc)), 0, 2).reshape(B, H, S, MLA_V)
    return o.transpose(0, 2, 1, 3).reshape(B, S, H * MLA_V)


def setup_inputs(seed: int = 0) -> dict:
    key = jax.random.key(seed)
    ks = jax.random.split(key, 20)
    L = DEPTH
    hd = NSA_HEAD_DIM

    def nrm(k, shape, scale):
        return jax.random.normal(k, shape, jnp.float32) * scale

    def gain(k, shape):
        return 1.0 + nrm(k, shape, 0.02)

    return {
        'x': nrm(ks[0], (BATCH, SEQ, D_MODEL), 1.0),
        'attn_norm': gain(ks[1], (L, D_MODEL)),
        'w_in': nrm(ks[2], (L, D_MODEL, IN_COLS), D_MODEL ** -0.5),
        'cmp_pe': nrm(ks[3], (L, 2, CMP_BLOCK, hd), 0.1),
        'cmp_w1': nrm(ks[4], (L, 2, CMP_BLOCK * hd, CMP_HIDDEN), (CMP_BLOCK * hd) ** -0.5),
        'cmp_w2': nrm(ks[5], (L, 2, CMP_HIDDEN, hd), CMP_HIDDEN ** -0.5),
        'nsa_w_o': nrm(ks[6], (L, NSA_Q_COLS, D_MODEL), NSA_Q_COLS ** -0.5),
        'mla_q_norm': gain(ks[7], (L, MLA_Q_LORA)),
        'mla_kv_norm': gain(ks[8], (L, MLA_KV_LORA)),
        'mla_w_uq': nrm(ks[9], (L, MLA_Q_LORA, MLA_HEADS * (MLA_NOPE + MLA_ROPE)), MLA_Q_LORA ** -0.5),
        'mla_w_ukv': nrm(ks[10], (L, MLA_KV_LORA, MLA_HEADS * (MLA_NOPE + MLA_V)), MLA_KV_LORA ** -0.5),
        'mla_w_o': nrm(ks[11], (L, MLA_HEADS * MLA_V, D_MODEL), (MLA_HEADS * MLA_V) ** -0.5),
        'w_out': nrm(ks[12], (L, D_MODEL, D_MODEL), D_MODEL ** -0.5),
        'mlp_norm': gain(ks[13], (L, D_MODEL)),
        'w_up': nrm(ks[14], (L, D_MODEL, D_FF), D_MODEL ** -0.5),
        'w_down': nrm(ks[15], (L, D_FF, D_MODEL), D_FF ** -0.5),
        'final_norm': gain(ks[16], (D_MODEL,)),
    }


def reference(x, attn_norm, w_in, cmp_pe, cmp_w1, cmp_w2, nsa_w_o, mla_q_norm, mla_kv_norm,
              mla_w_uq, mla_w_ukv, mla_w_o, w_out, mlp_norm, w_up, w_down, final_norm):
    S = x.shape[1]
    pos = jnp.arange(S, dtype=jnp.int32)
    for l in range(DEPTH):
        xn = rms_norm(x, attn_norm[l])
        (nsa_q, kv_c, kv_s, kv_w, nsa_g, cq, ckv, k_rope_raw,
         gate_a, gate_b) = split_cols(xn @ w_in[l])
        o_a = nsa_attention(nsa_q, kv_c, kv_s, kv_w, nsa_g, cmp_pe[l], cmp_w1[l], cmp_w2[l], pos)
        o_b = mla_attention(cq, ckv, k_rope_raw, mla_q_norm[l], mla_kv_norm[l],
                            mla_w_uq[l], mla_w_ukv[l], pos)
        merged = (jax.nn.sigmoid(gate_a) * (o_a @ nsa_w_o[l])
                  + jax.nn.sigmoid(gate_b) * (o_b @ mla_w_o[l]))
        x = x + merged @ w_out[l]
        hn = rms_norm(x, mlp_norm[l])
        x = x + jnp.square(jax.nn.relu(hn @ w_up[l])) @ w_down[l]
    return rms_norm(x, final_norm)
```

```cpp
#include <hip/hip_runtime.h>
#include <hip/hip_cooperative_groups.h>
#include <cstdio>
#include <cstdint>
namespace cg = cooperative_groups;

#ifndef EXP_NOATTN
#define EXP_NOATTN 0
#endif
#ifndef ATT_STATIC
#define ATT_STATIC 0
#endif
#ifndef EXP_ATT
#define EXP_ATT 0
#endif
#ifndef MK_MULTI
#define MK_MULTI 0
#endif

#define LAS __attribute__((address_space(3)))
#define DI __device__ __forceinline__
typedef unsigned short bf16_t;
typedef short bf16x8 __attribute__((ext_vector_type(8)));
typedef float f32x4 __attribute__((ext_vector_type(4)));
typedef float f32x2 __attribute__((ext_vector_type(2)));
typedef float f32x16 __attribute__((ext_vector_type(16)));
typedef unsigned u32x4 __attribute__((ext_vector_type(4)));
typedef unsigned u32x2 __attribute__((ext_vector_type(2)));
typedef __bf16 bf16v2 __attribute__((ext_vector_type(2)));

DI unsigned pk2(float lo, float hi) { f32x2 v = {lo, hi}; return __builtin_bit_cast(unsigned, __builtin_convertvector(v, bf16v2)); }
DI bf16_t f2bf(float x) { return (bf16_t)(pk2(x, 0.f) & 0xffffu); }
DI float bflo(unsigned w) { return __uint_as_float(w << 16); }
DI float bfhi(unsigned w) { return __uint_as_float(w & 0xffff0000u); }
DI float sigmoidf_(float x) { return 1.f / (1.f + __expf(-x)); }
DI float ex2(float x) { return __builtin_amdgcn_exp2f(x); }
DI int my_tid() { int t = threadIdx.x; asm volatile("" : "+v"(t)); return t; }

constexpr int NB = 8, S = 4096, D = 1024, NL = 4, M = NB * S, FF = 4096;
constexpr int NIN = 3840;
constexpr int IN_COLS = 3768;
constexpr float EPS = 1e-6f;
constexpr float LOG2E = 1.4426950408889634f;

constexpr size_t MiB = 1u << 20;
constexpr size_t WS_CTL = 0;
constexpr size_t WS_CB1 = 4096;
constexpr size_t WS_RSQ = 65536;
constexpr size_t WS_RSKV = 65536 + 131072;
constexpr size_t WS_CS64 = 1 * MiB;
constexpr size_t WS_CS32 = 2 * MiB;
constexpr size_t WS_WIN = 3 * MiB;
constexpr size_t WS_W1T = WS_WIN + (size_t)NIN * 1024 * 2;
constexpr size_t WS_W2T = WS_W1T + 2 * MiB;
constexpr size_t WS_WOAB = WS_W2T + 256 * 1024;
constexpr size_t WS_WUQ = WS_WOAB + 2 * MiB;
constexpr size_t WS_WUKV = WS_WUQ + 384 * 1024;
constexpr size_t WS_WOUT = 16 * MiB;
constexpr size_t WS_WUP = 18 * MiB;
constexpr size_t WS_WDN = 26 * MiB;
constexpr size_t WS_XN = 34 * MiB;
constexpr size_t WS_GA = 98 * MiB;
constexpr size_t WS_GB = 162 * MiB;
constexpr size_t WS_QN = 226 * MiB;
constexpr size_t WS_KCV = 258 * MiB;
constexpr size_t WS_KS = 274 * MiB, WS_KW = 282 * MiB, WS_VST = 290 * MiB, WS_VWT = 298 * MiB;
constexpr size_t WS_CQ = 306 * MiB, WS_T6 = 322 * MiB, WS_KPE = 338 * MiB, WS_GN = 340 * MiB;
constexpr size_t WS_QM = 343 * MiB, WS_KM = 391 * MiB, WS_VMT = 423 * MiB, WS_HC = 455 * MiB;
constexpr size_t WS_KCMP = 459 * MiB, WS_VCMPT = WS_KCMP + 512 * 1024;
constexpr size_t WS_MG = 226 * MiB;
constexpr size_t WS_HF = 98 * MiB;
constexpr size_t WS_PQ = 460 * MiB;
constexpr size_t WS_PKV = 461 * MiB;
constexpr size_t WS_END = 462 * MiB;
static_assert(WS_WUKV + 512 * 1024 <= WS_WOUT, "ws map");

constexpr int LDS_BYTES = 147456;
constexpr int MISC_OFF = 131072;
constexpr int AT_K = 0, AT_V = 13312, AT_IMP = 24576, AT_SEL = 40960, AT_LIST = 41472, AT_CNT = 41728, AT_ACC = 49152;

namespace pg8 {
constexpr int BM = 256, BK = 64, HALF = 128, HTB = HALF * BK * 2, NXCD = 8, WGM = 8;
__host__ __device__ __forceinline__ int lds_byte(int r, int c) { const int st = (r >> 4) * 2 + (c >> 5), rr = r & 15, cc = c & 31, ob = rr * 64 + cc * 2; return st * 1024 + (ob ^ (((ob >> 9) & 1) << 5)); }
__host__ __device__ __forceinline__ void stage_rc(int b, int& R, int& C) { const int st = b / 1024, sb = b % 1024, swz = sb ^ (((sb >> 9) & 1) << 5); R = (st >> 1) * 16 + swz / 64; C = (st & 1) * 32 + (swz % 64) / 2; }
__host__ __device__ __forceinline__ int perm32(int rho) { const int n = rho >> 4, i = rho & 15; return 8 * (i >> 2) + 4 * n + (i & 3); }

struct Unit { int pm, pn; };
struct Gemm { const bf16_t* A; const bf16_t* Bt; int lda; int K; };

struct StaticOrder {
    int nM, nN, nwg, G, c;
    __device__ void init(int M_, int N_, int G_, int c_) { nM = M_ / BM; nN = N_ / BM; nwg = nM * nN; G = G_; c = c_; }
    __device__ bool next(int i, Unit& u) const {
        const long L = (long)i * G + c; if (L >= nwg) return false;
        int wgid = (int)L; { const int q = nwg / NXCD, r = nwg % NXCD, xcd = wgid % NXCD, off = wgid / NXCD; wgid = (xcd < r ? xcd * (q + 1) : r * (q + 1) + (xcd - r) * q) + off; }
        const int nig = WGM * nN, gid = wgid / nig, fm = gid * WGM, gsz = (nM - fm) < WGM ? (nM - fm) : WGM;
        u.pm = fm + ((wgid % nig) % gsz); u.pn = (wgid % nig) / gsz; return true;
    }
};
struct CmpOrder {
    int G, c;
    __device__ bool next(int i, Unit& u) const { const int L = i * G + c; if (L >= 32) return false; u.pm = L; u.pn = L >> 4; return true; }
};

template <class Epi, class Sched>
__device__ __forceinline__ void gemm_phase(LAS unsigned char* lds, const Gemm g, const Sched& S, const Epi& E) {
    const int tid = my_tid(), wid = __builtin_amdgcn_readfirstlane(tid >> 6), lane = tid & 63, wr = wid >> 2, wc = wid & 3, fr = lane & 15, fq = lane >> 4;
    const int K = g.K, nt = K / BK, lda = g.lda;
    unsigned voffA, voffB;
    { int R, C; stage_rc(tid * 16, R, C); const int Rb = (R & ~31) + perm32(R & 31);
        voffA = (unsigned)(R * lda + C) * 2u; voffB = (unsigned)(Rb * K + C) * 2u; }
    const size_t qvoffA = (size_t)64 * lda * 2, qvoffB = (size_t)64 * K * 2;
    const size_t kstep = (size_t)(BK * 2);
    const size_t hstepA = (size_t)HALF * lda * 2, hstepB = (size_t)HALF * K * 2;
    const size_t tstepA = 2 * hstepA, tstepB = 2 * hstepB;
    const unsigned ldsw = (unsigned)wid * 1024u;
    const int aoff = lds_byte(wr * 64 + fr, fq * 8), boff = lds_byte(wc * 32 + fr, fq * 8);
#define PG8_SA(b, h) (((b) * 2 + (h)) * HTB)
#define PG8_SB(b, h) ((4 + (b) * 2 + (h)) * HTB)
#define PG8_STAGE(bufoff, gbase, voff) do { _Pragma("unroll") for (int _i = 0; _i < 2; ++_i) \
        __builtin_amdgcn_global_load_lds((const unsigned*)((const char*)(gbase) + (size_t)_i * q##voff + (voff)), (LAS unsigned*)(lds + (bufoff) + ldsw + _i * 8192), 16, 0, 0); } while (0)
#define PG8_LDA(dst, b, h) do { _Pragma("unroll") for (int m = 0; m < 4; ++m) _Pragma("unroll") for (int k = 0; k < 2; ++k) dst[m][k] = *(const LAS bf16x8*)(lds + PG8_SA(b, h) + aoff + m * 2048 + k * 1024); } while (0)
#define PG8_LDB(dst, b, h) do { _Pragma("unroll") for (int n = 0; n < 2; ++n) _Pragma("unroll") for (int k = 0; k < 2; ++k) dst[n][k] = *(const LAS bf16x8*)(lds + PG8_SB(b, h) + boff + n * 2048 + k * 1024); } while (0)
#define PG8_MMA(ai, bj, At, Bt) do { __builtin_amdgcn_s_setprio(1); _Pragma("unroll") for (int m = 0; m < 4; ++m) _Pragma("unroll") for (int n = 0; n < 2; ++n) _Pragma("unroll") for (int k = 0; k < 2; ++k) \
        acc[ai][bj][m][n] = __builtin_amdgcn_mfma_f32_16x16x32_bf16(Bt[n][k], At[m][k], acc[ai][bj][m][n], 0, 0, 0); __builtin_amdgcn_s_setprio(0); } while (0)
#define PG8_WAIT_V(n) asm volatile("s_waitcnt vmcnt(" #n ")" ::: "memory")
#define PG8_WAIT_L(n) asm volatile("s_waitcnt lgkmcnt(" #n ")" ::: "memory")
#define PG8_BAR __builtin_amdgcn_s_barrier()
#define PG8_SCHED __builtin_amdgcn_sched_barrier(0)
    Unit cur, nxt; int ui = 0;
    if (!S.next(0, cur)) return;
    f32x4 acc[2][2][4][2];
#pragma unroll
    for (int a = 0; a < 2; ++a)
#pragma unroll
        for (int b = 0; b < 2; ++b)
#pragma unroll
            for (int m = 0; m < 4; ++m)
#pragma unroll
                for (int n = 0; n < 2; ++n) acc[a][b][m][n] = (f32x4){0.f, 0.f, 0.f, 0.f};
    bf16x8 At[4][2], B0[2][2], B1[2][2];
    const char* cA = (const char*)g.A + (size_t)cur.pm * tstepA; const char* cB = (const char*)g.Bt + (size_t)cur.pn * tstepB;
    PG8_STAGE(PG8_SB(0, 0), cB, voffB); PG8_STAGE(PG8_SB(0, 1), cB + hstepB, voffB); PG8_STAGE(PG8_SA(0, 0), cA, voffA); PG8_STAGE(PG8_SA(0, 1), cA + hstepA, voffA);
    if (wr == 1) PG8_BAR;
    PG8_WAIT_V(2); PG8_BAR;
    PG8_STAGE(PG8_SB(1, 0), cB + kstep, voffB); PG8_STAGE(PG8_SA(1, 0), cA + kstep, voffA); PG8_STAGE(PG8_SB(1, 1), cB + hstepB + kstep, voffB);
    PG8_WAIT_V(6); PG8_BAR;
    for (;;) {
        const bool has_next = S.next(ui + 1, nxt);
        const char* nA = has_next ? (const char*)g.A + (size_t)nxt.pm * tstepA : cA; const char* nB = has_next ? (const char*)g.Bt + (size_t)nxt.pn * tstepB : cB;
        for (int t = 0; t < nt; t += 2) {
            const bool last = (t == nt - 2);
            const char* a1 = cA + (size_t)(t + 1) * kstep;
            const char* a2 = last ? nA : cA + (size_t)(t + 2) * kstep; const char* b2 = last ? nB : cB + (size_t)(t + 2) * kstep;
            const char* a3 = a2 + kstep; const char* b3 = b2 + kstep;
            PG8_LDB(B0, 0, 0); PG8_LDB(B1, 0, 1); PG8_SCHED; PG8_LDA(At, 0, 0); PG8_STAGE(PG8_SA(1, 1), a1 + hstepA, voffA);
            PG8_WAIT_V(8); PG8_WAIT_L(0); PG8_BAR; PG8_MMA(0, 0, At, B0); PG8_MMA(0, 1, At, B1); PG8_BAR; PG8_SCHED;
            PG8_LDA(At, 0, 1); PG8_STAGE(PG8_SB(0, 0), b2, voffB); PG8_STAGE(PG8_SB(0, 1), b2 + hstepB, voffB); PG8_STAGE(PG8_SA(0, 0), a2, voffA);
            PG8_WAIT_V(8); PG8_WAIT_L(0); PG8_BAR; PG8_MMA(1, 0, At, B0); PG8_MMA(1, 1, At, B1); PG8_BAR; PG8_SCHED;
            PG8_LDB(B0, 1, 0); PG8_LDB(B1, 1, 1); PG8_SCHED; PG8_LDA(At, 1, 0); PG8_STAGE(PG8_SA(0, 1), a2 + hstepA, voffA);
            PG8_WAIT_V(8); PG8_WAIT_L(0); PG8_BAR; PG8_MMA(0, 0, At, B0); PG8_MMA(0, 1, At, B1); PG8_BAR; PG8_SCHED;
            PG8_LDA(At, 1, 1); PG8_STAGE(PG8_SB(1, 0), b3, voffB); PG8_STAGE(PG8_SB(1, 1), b3 + hstepB, voffB); PG8_STAGE(PG8_SA(1, 0), a3, voffA);
            PG8_WAIT_V(8); PG8_WAIT_L(0); PG8_BAR; PG8_MMA(1, 0, At, B0); PG8_MMA(1, 1, At, B1); PG8_BAR; PG8_SCHED;
        }
        if (wr == 0) PG8_BAR;
        E(acc, cur, wr, wc, fr, fq);
        if (!has_next) break;
#pragma unroll
        for (int a = 0; a < 2; ++a)
#pragma unroll
            for (int b = 0; b < 2; ++b)
#pragma unroll
                for (int m = 0; m < 4; ++m)
#pragma unroll
                    for (int n = 0; n < 2; ++n) acc[a][b][m][n] = (f32x4){0.f, 0.f, 0.f, 0.f};
        cur = nxt; cA = nA; cB = nB; ++ui;
        if (wr == 1) PG8_BAR;
    }
    PG8_WAIT_V(0);
    PG8_BAR;
#undef PG8_SA
#undef PG8_SB
#undef PG8_STAGE
#undef PG8_LDA
#undef PG8_LDB
#undef PG8_MMA
#undef PG8_WAIT_V
#undef PG8_WAIT_L
#undef PG8_BAR
#undef PG8_SCHED
}
}
using pg8::Unit;

DI void store8(bf16_t* p, const float (&v)[8]) { u32x4 w = {pk2(v[0], v[1]), pk2(v[2], v[3]), pk2(v[4], v[5]), pk2(v[6], v[7])}; *(u32x4*)p = w; }
DI void rope8(float (&v)[8], const f32x2* cs) {
    const f32x4 c0 = *(const f32x4*)cs, c1 = *(const f32x4*)(cs + 2);
    const float co[4] = {c0[0], c0[2], c1[0], c1[2]}, si[4] = {c0[1], c0[3], c1[1], c1[3]};
#pragma unroll
    for (int k = 0; k < 4; ++k) { const float a = v[2 * k], b = v[2 * k + 1]; v[2 * k] = a * co[k] - b * si[k]; v[2 * k + 1] = a * si[k] + b * co[k]; }
}
DI float sumsq_fq(const float (&v)[8]) {
    float s = 0.f;
#pragma unroll
    for (int e = 0; e < 8; ++e) s += v[e] * v[e];
    s += __shfl_xor(s, 16); s += __shfl_xor(s, 32); return s;
}

template <class Impl> struct EpiWrap : Impl {
    static constexpr bool MID = false;
    DI void operator()(const f32x4 (&acc)[2][2][4][2], const Unit& u, int wr, int wc, int, int) const {
        const int t2 = my_tid(), fr = t2 & 15, fq = (t2 >> 4) & 3;
#pragma unroll
        for (int ai = 0; ai < 2; ++ai)
#pragma unroll
            for (int m = 0; m < 4; ++m)
#pragma unroll
                for (int bj = 0; bj < 2; ++bj) {
                    const f32x4 a0 = acc[ai][bj][m][0], a1 = acc[ai][bj][m][1];
                    float v[8] = {a0[0], a0[1], a0[2], a0[3], a1[0], a1[1], a1[2], a1[3]};
                    this->chunk(u.pm * 256 + ai * 128 + wr * 64 + m * 16 + fr, u.pn, bj * 128 + wc * 32 + 8 * fq, v);
                }
    }
};

#define WSP(T, off) ((T*)(ws + (off)))
struct EpiInImpl {
    unsigned char* ws;
    DI void chunk(int row, int pn, int cc, float (&v)[8]) const {
        const int pos = row & (S - 1), b = row >> 12;
        bf16_t* const QN = WSP(bf16_t, WS_QN); bf16_t* const KCV = WSP(bf16_t, WS_KCV); bf16_t* const CQ = WSP(bf16_t, WS_CQ); bf16_t* const T6 = WSP(bf16_t, WS_T6);
        bf16_t* const KPE = WSP(bf16_t, WS_KPE); float* const GN = WSP(float, WS_GN); float* const PQ = WSP(float, WS_PQ); float* const PKV = WSP(float, WS_PKV);
        const f32x2* const CS64 = WSP(const f32x2, WS_CS64); const f32x2* const CS32 = WSP(const f32x2, WS_CS32);
        if (pn < 2) {
            rope8(v, CS64 + pos * 32 + ((cc & 63) >> 1));
            store8(QN + (size_t)row * 512 + pn * 256 + cc, v);
        } else if (pn < 5) {
            const int kv = cc >> 7, g = (cc >> 6) & 1, p = cc & 63, bg = b * 2 + g;
            if (kv == 0) {
                rope8(v, CS64 + pos * 32 + (p >> 1));
                bf16_t* dst = WSP(bf16_t, pn == 2 ? WS_KCV : (pn == 3 ? WS_KS : WS_KW));
                store8(dst + ((size_t)bg * S + pos) * 64 + p, v);
            } else if (pn == 2) {
                store8(KCV + ((size_t)(16 + bg) * S + pos) * 64 + p, v);
            } else {
                bf16_t* dst = WSP(bf16_t, pn == 3 ? WS_VST : WS_VWT);
#pragma unroll
                for (int e = 0; e < 8; ++e) dst[((size_t)bg * 64 + p + e) * S + pos] = f2bf(v[e]);
            }
        } else if (pn == 5) {
            store8(CQ + (size_t)row * 256 + cc, v);
            const float s = sumsq_fq(v);
            if ((threadIdx.x & 48) == 0) PQ[(size_t)row * 8 + (cc >> 5)] = s;
        } else if (pn == 6) {
            store8(T6 + (size_t)row * 256 + cc, v);
            if (cc < 128) {
                const float s = sumsq_fq(v);
                if ((threadIdx.x & 48) == 0) PKV[(size_t)row * 4 + (cc >> 5)] = s;
            } else if (cc < 160) {
                rope8(v, CS32 + pos * 16 + ((cc - 128) >> 1));
                store8(KPE + (size_t)row * 32 + (cc - 128), v);
            } else if (cc < 184) {
#pragma unroll
                for (int e = 0; e < 8; ++e) GN[(size_t)row * 24 + (cc - 160) + e] = sigmoidf_(v[e]);
            }
        } else {
#pragma unroll
            for (int e = 0; e < 8; ++e) v[e] = sigmoidf_(v[e]);
            if (pn < 11) store8(WSP(bf16_t, WS_GA) + (size_t)row * 1024 + (pn - 7) * 256 + cc, v);
            else store8(WSP(bf16_t, WS_GB) + (size_t)row * 1024 + (pn - 11) * 256 + cc, v);
        }
    }
};
struct EpiC1Impl {
    unsigned char* ws;
    DI void chunk(int row, int pn, int cc, float (&v)[8]) const {
        bf16_t* const HC = WSP(bf16_t, WS_HC); const float* const CB1 = WSP(const float, WS_CB1);
        const f32x4 b0 = *(const f32x4*)(CB1 + pn * 256 + cc), b1 = *(const f32x4*)(CB1 + pn * 256 + cc + 4);
        const float bb[8] = {b0[0], b0[1], b0[2], b0[3], b1[0], b1[1], b1[2], b1[3]};
#pragma unroll
        for (int e = 0; e < 8; ++e) { const float x = v[e] + bb[e]; v[e] = x / (1.f + __expf(-x)); }
        store8(HC + (size_t)row * 256 + cc, v);
    }
};
struct EpiC2Impl {
    unsigned char* ws;
    DI void chunk(int row, int pn, int cc, float (&v)[8]) const {
        if (cc >= 64) return;
        bf16_t* const KCMP = WSP(bf16_t, WS_KCMP); bf16_t* const VCMPT = WSP(bf16_t, WS_VCMPT);
        const int bg = (row >> 8) & 15, n = row & 255;
        if (n == 255) {
#pragma unroll
            for (int e = 0; e < 8; ++e) v[e] = 0.f;
        }
        if (pn == 0) store8(KCMP + ((size_t)bg * 256 + n) * 64 + cc, v);
        else {
#pragma unroll
            for (int e = 0; e < 8; ++e) VCMPT[((size_t)bg * 64 + cc + e) * 256 + n] = f2bf(v[e]);
        }
    }
};
struct EpiUQImpl {
    unsigned char* ws;
    DI void chunk(int row, int pn, int cc, float (&v)[8]) const {
        bf16_t* const QM = WSP(bf16_t, WS_QM); const float* const PQ = WSP(const float, WS_PQ); const f32x2* const CS32 = WSP(const f32x2, WS_CS32);
        const int c = pn * 256 + cc, hh = c / 96, c96 = c - hh * 96, pos = row & (S - 1);
        const f32x4 p0 = *(const f32x4*)(PQ + (size_t)row * 8), p1 = *(const f32x4*)(PQ + (size_t)row * 8 + 4);
        const float rstd = rsqrtf((((p0[0] + p0[1]) + (p0[2] + p0[3])) + ((p1[0] + p1[1]) + (p1[2] + p1[3]))) * (1.f / 256.f) + EPS);
#pragma unroll
        for (int e = 0; e < 8; ++e) v[e] *= rstd;
        if (c96 >= 64) rope8(v, CS32 + pos * 16 + ((c96 - 64) >> 1));
        store8(QM + (size_t)row * 768 + c, v);
    }
};
struct EpiUKVImpl {
    unsigned char* ws;
    DI void chunk(int row, int pn, int cc, float (&v)[8]) const {
        bf16_t* const KM = WSP(bf16_t, WS_KM); bf16_t* const VMT = WSP(bf16_t, WS_VMT); const float* const PKV = WSP(const float, WS_PKV);
        const int c = pn * 256 + cc, hh = c >> 7, c128 = c & 127, pos = row & (S - 1), b = row >> 12;
        const f32x4 p0 = *(const f32x4*)(PKV + (size_t)row * 4);
        const float rstd = rsqrtf(((p0[0] + p0[1]) + (p0[2] + p0[3])) * (1.f / 128.f) + EPS);
#pragma unroll
        for (int e = 0; e < 8; ++e) v[e] *= rstd;
        if (c128 < 64) store8(KM + ((size_t)(b * 8 + hh) * S + pos) * 64 + c128, v);
        else {
#pragma unroll
            for (int e = 0; e < 8; ++e) VMT[((size_t)(b * 8 + hh) * 64 + (c128 - 64) + e) * S + pos] = f2bf(v[e]);
        }
    }
};
struct EpiD2Impl {
    const float* xin; float* X;
    DI void chunk(int row, int pn, int cc, float (&v)[8]) const {
        const size_t o = (size_t)row * 1024 + pn * 256 + cc;
        const f32x4 x0 = *(const f32x4*)(xin + o), x1 = *(const f32x4*)(xin + o + 4);
        *(f32x4*)(X + o) = (f32x4){x0[0] + v[0], x0[1] + v[1], x0[2] + v[2], x0[3] + v[3]};
        *(f32x4*)(X + o + 4) = (f32x4){x1[0] + v[4], x1[1] + v[5], x1[2] + v[6], x1[3] + v[7]};
    }
};
struct EpiUpImpl {
    unsigned char* ws;
    DI void chunk(int row, int pn, int cc, float (&v)[8]) const {
        bf16_t* const HF = WSP(bf16_t, WS_HF);
#pragma unroll
        for (int e = 0; e < 8; ++e) { const float r = fmaxf(v[e], 0.f); v[e] = r * r; }
        store8(HF + (size_t)row * FF + pn * 256 + cc, v);
    }
};
struct EpiD1aImpl {
    unsigned char* ws;
    DI void chunk(int row, int pn, int cc, float (&v)[8]) const {
        const size_t o = (size_t)row * 1024 + pn * 256 + cc;
        const u32x4 a = *(const u32x4*)(WSP(const bf16_t, WS_GA) + o);
        v[0] *= bflo(a[0]); v[1] *= bfhi(a[0]); v[2] *= bflo(a[1]); v[3] *= bfhi(a[1]); v[4] *= bflo(a[2]); v[5] *= bfhi(a[2]); v[6] *= bflo(a[3]); v[7] *= bfhi(a[3]);
        store8(WSP(bf16_t, WS_MG) + o, v);
    }
};
struct EpiD1bImpl {
    unsigned char* ws;
    DI void chunk(int row, int pn, int cc, float (&v)[8]) const {
        const size_t o = (size_t)row * 1024 + pn * 256 + cc;
        const u32x4 b = *(const u32x4*)(WSP(const bf16_t, WS_GB) + o), g = *(const u32x4*)(WSP(const bf16_t, WS_MG) + o);
        v[0] = bflo(g[0]) + v[0] * bflo(b[0]); v[1] = bfhi(g[0]) + v[1] * bfhi(b[0]); v[2] = bflo(g[1]) + v[2] * bflo(b[1]); v[3] = bfhi(g[1]) + v[3] * bfhi(b[1]);
        v[4] = bflo(g[2]) + v[4] * bflo(b[2]); v[5] = bfhi(g[2]) + v[5] * bfhi(b[2]); v[6] = bflo(g[3]) + v[6] * bflo(b[3]); v[7] = bfhi(g[3]) + v[7] * bfhi(b[3]);
        store8(WSP(bf16_t, WS_MG) + o, v);
    }
};

#define MFMA32(a, b, c) __builtin_amdgcn_mfma_f32_32x32x16_bf16((a), (b), (c), 0, 0, 0)

template <int DQK> DI void qk_tile(const LAS unsigned char* sK, const bf16x8 (&qf)[DQK / 16], f32x16 (&s)[2], int lane) {
    constexpr int KSTR = DQK * 2 + 16;
    const int r = lane & 31, h = lane >> 5;
    const int rp = (r & 0x13) | ((r & 4) << 1) | ((r & 8) >> 1);
#pragma unroll
    for (int kt = 0; kt < 2; ++kt) {
        f32x16 a;
#pragma unroll
        for (int i = 0; i < 16; ++i) a[i] = 0.f;
#pragma unroll
        for (int ks = 0; ks < DQK / 16; ++ks) {
            const bf16x8 kf = *(const LAS bf16x8*)(sK + (32 * kt + rp) * KSTR + ks * 32 + h * 16);
            a = MFMA32(kf, qf[ks], a);
        }
        s[kt] = a;
    }
}

template <class Mask> DI void softmax_pv(f32x16 (&s)[2], const LAS unsigned char* sV, int tile, const Mask& mask, float c, float& m, float& l, f32x16 (&o)[2], int lane) {
    const int h = lane >> 5, r = lane & 31;
    float mx = -1e30f;
#pragma unroll
    for (int kt = 0; kt < 2; ++kt)
#pragma unroll
        for (int reg = 0; reg < 16; ++reg) {
            const int key = 32 * kt + (reg & 7) + 8 * h + 16 * (reg >> 3);
            const float x = mask(tile, key) ? s[kt][reg] * c : -1e30f;
            s[kt][reg] = x; mx = fmaxf(mx, x);
        }
    mx = fmaxf(mx, __shfl_xor(mx, 32));
    const float mn = fmaxf(m, mx), alpha = ex2(m - mn);
    m = mn;
    float sum = 0.f;
#pragma unroll
    for (int kt = 0; kt < 2; ++kt)
#pragma unroll
        for (int reg = 0; reg < 16; ++reg) {
            const float x = s[kt][reg];
            const float p = (x > -5e29f) ? ex2(x - mn) : 0.f;
            s[kt][reg] = p; sum += p;
        }
    l = l * alpha + sum;
    o[0] *= alpha; o[1] *= alpha;
#pragma unroll
    for (int kt = 0; kt < 2; ++kt)
#pragma unroll
        for (int s2 = 0; s2 < 2; ++s2) {
            u32x4 pw = {pk2(s[kt][8 * s2 + 0], s[kt][8 * s2 + 1]), pk2(s[kt][8 * s2 + 2], s[kt][8 * s2 + 3]),
                        pk2(s[kt][8 * s2 + 4], s[kt][8 * s2 + 5]), pk2(s[kt][8 * s2 + 6], s[kt][8 * s2 + 7])};
            const bf16x8 pb = __builtin_bit_cast(bf16x8, pw);
#pragma unroll
            for (int dt = 0; dt < 2; ++dt) {
                const bf16x8 va = *(const LAS bf16x8*)(sV + (32 * dt + r) * 144 + (32 * kt + 16 * s2 + 8 * h) * 2);
                o[dt] = MFMA32(va, pb, o[dt]);
            }
        }
}

template <int DQK, class TileOf, class Mask, class Skip>
DI void attn_run(LAS unsigned char* lds, const bf16_t* Kg, const bf16_t* Kpe, const bf16_t* Vg, int ldv, int ntiles,
                 const TileOf& tile_of, const Mask& mask, const Skip& skip, float c, const bf16x8 (&qf)[DQK / 16], float& m, float& l, f32x16 (&o)[2]) {
    constexpr int KSTR = DQK * 2 + 16;
    const int tid = my_tid(), lane = tid & 63;
    LAS unsigned char* sK = lds + AT_K; LAS unsigned char* sV = lds + AT_V;
    const int krow = tid >> 3, kch = tid & 7, prow = (tid >> 2) & 63, pch = tid & 3;
    u32x4 kreg = {0, 0, 0, 0}, vreg = {0, 0, 0, 0}, preg = {0, 0, 0, 0};
    if (ntiles > 0) {
        const int t = tile_of(0);
        kreg = *(const u32x4*)(Kg + ((size_t)(t * 64 + krow)) * 64 + kch * 8);
        vreg = *(const u32x4*)(Vg + (size_t)krow * ldv + t * 64 + kch * 8);
        if constexpr (DQK == 96) { if (tid < 256) preg = *(const u32x4*)(Kpe + ((size_t)(t * 64 + prow)) * 32 + pch * 8); }
    }
    for (int i = 0; i < ntiles; ++i) {
        __syncthreads();
        *(LAS u32x4*)(sK + krow * KSTR + kch * 16) = kreg;
        *(LAS u32x4*)(sV + krow * 144 + kch * 16) = vreg;
        if constexpr (DQK == 96) { if (tid < 256) *(LAS u32x4*)(sK + prow * KSTR + 128 + pch * 16) = preg; }
        __syncthreads();
        const int t = tile_of(i);
        if (i + 1 < ntiles) {
            const int t2 = tile_of(i + 1);
            kreg = *(const u32x4*)(Kg + ((size_t)(t2 * 64 + krow)) * 64 + kch * 8);
            vreg = *(const u32x4*)(Vg + (size_t)krow * ldv + t2 * 64 + kch * 8);
            if constexpr (DQK == 96) { if (tid < 256) preg = *(const u32x4*)(Kpe + ((size_t)(t2 * 64 + prow)) * 32 + pch * 8); }
        }
        if (!skip(t)) {
            f32x16 s[2];
            qk_tile<DQK>(sK, qf, s, lane);
            softmax_pv(s, sV, t, mask, c, m, l, o, lane);
        }
    }
}

struct TileId { DI int operator()(int i) const { return i; } };
struct TileOff { int off; DI int operator()(int i) const { return off + i; } };
struct TileList { const LAS int* lst; DI int operator()(int i) const { return lst[i]; } };
struct NoSkip { DI bool operator()(int) const { return false; } };
struct SkipAbove { int tmax; DI bool operator()(int t) const { return t * 64 > tmax; } };
struct MaskCmp { int tq; DI bool operator()(int t, int key) const { return 16 * (64 * t + key) + 31 <= tq; } };
struct MaskSlc { int tq; unsigned lo, hi; DI bool operator()(int t, int key) const { const unsigned bit = t < 32 ? (lo >> t) : (hi >> (t - 32)); return (bit & 1u) && (64 * t + key <= tq); } };
struct MaskWin { int tq; DI bool operator()(int t, int key) const { const int d = tq - (64 * t + key); return d >= 0 && d < 512; } };
struct MaskCausal { int tq; DI bool operator()(int t, int key) const { return 64 * t + key <= tq; } };

struct Bufs {
    const bf16_t *QN, *KS, *KW, *VST, *VWT, *KCMP, *VCMPT, *QM, *KM, *KPE, *VMT; const float* GN; bf16_t* OAB;
};

DI void zero16(f32x16& v) {
#pragma unroll
    for (int i = 0; i < 16; ++i) v[i] = 0.f;
}

DI void nsa_unit(const Bufs& B, LAS unsigned char* lds, int b, int g, int qt) {
    const int tid = my_tid(), lane = tid & 63, w = tid >> 6, r = w >> 1, hh = lane >> 5;
    const int qs = (w & 1) * 32 + (lane & 31), bg = b * 2 + g, tq = qt * 64 + qs, head = g * 4 + r;
    const size_t row = (size_t)b * S + tq;
    LAS unsigned* sImp = (LAS unsigned*)(lds + AT_IMP);
    LAS unsigned* sSel = (LAS unsigned*)(lds + AT_SEL);
    LAS int* sList = (LAS int*)(lds + AT_LIST);
    LAS int* sCnt = (LAS int*)(lds + AT_CNT);
    bf16x8 qf[4];
#pragma unroll
    for (int ks = 0; ks < 4; ++ks) qf[ks] = *(const bf16x8*)(B.QN + row * 512 + head * 64 + ks * 16 + hh * 8);
    for (int i = tid; i < 4096; i += 512) sImp[i] = 0u;
    const float c = 0.125f * LOG2E;
    const f32x4 gt = {B.GN[row * 24 + head], B.GN[row * 24 + 8 + head], B.GN[row * 24 + 16 + head], 0.f};
    LAS float* stash = (LAS float*)(lds + AT_ACC + w * 8192) + lane;
    float m, l; f32x16 o[2];
    const int nct = (4 * qt + 2) / 64 + 1;
    m = -1e30f; l = 0.f; zero16(o[0]); zero16(o[1]);
    attn_run<64>(lds, B.KCMP + (size_t)bg * 256 * 64, nullptr, B.VCMPT + (size_t)bg * 64 * 256, 256, nct, TileId{}, MaskCmp{tq}, NoSkip{}, c, qf, m, l, o);
    float inv;
    { const float lt = l + __shfl_xor(l, 32); inv = lt > 0.f ? 1.f / lt : 0.f; }
#pragma unroll
    for (int dt = 0; dt < 2; ++dt)
#pragma unroll
        for (int e = 0; e < 16; ++e) stash[(dt * 16 + e) * 64] = o[dt][e] * (inv * gt[0]);
    for (int ct = 0; ct < nct; ++ct) {
        __syncthreads();
        { const int krow = tid >> 3, kch = tid & 7;
          *(LAS u32x4*)(lds + AT_K + krow * 144 + kch * 16) = *(const u32x4*)(B.KCMP + ((size_t)bg * 256 + ct * 64 + krow) * 64 + kch * 8); }
        __syncthreads();
        f32x16 s[2];
        qk_tile<64>(lds + AT_K, qf, s, lane);
#pragma unroll
        for (int kt = 0; kt < 2; ++kt)
#pragma unroll
            for (int a = 0; a < 4; ++a) {
                float pv[4];
#pragma unroll
                for (int bb = 0; bb < 4; ++bb) {
                    const int reg = 4 * a + bb;
                    const int n = 64 * ct + 32 * kt + (reg & 7) + 8 * hh + 16 * (reg >> 3);
                    pv[bb] = (16 * n + 31 <= tq) ? ex2(s[kt][reg] * c - m) * inv : 0.f;
                }
                const int j = 16 * ct + 8 * kt + (a & 1) + 2 * hh + 4 * (a >> 1);
                const float carry = 0.5f * pv[3], direct = (pv[0] + pv[1]) + (pv[2] + carry);
                if (direct > 0.f) __hip_atomic_fetch_add(sImp + qs * 64 + j, (unsigned)(direct * 268435456.f + 0.5f), __ATOMIC_RELAXED, __HIP_MEMORY_SCOPE_WORKGROUP);
                if (carry > 0.f && j < 63) __hip_atomic_fetch_add(sImp + qs * 64 + j + 1, (unsigned)(carry * 268435456.f + 0.5f), __ATOMIC_RELAXED, __HIP_MEMORY_SCOPE_WORKGROUP);
            }
    }
    __syncthreads();
    {
        const int q = tid >> 3, sub = tid & 7;
        unsigned bits = 0;
        if (qt < 16) {
#pragma unroll
            for (int k = 0; k < 8; ++k) if (sub * 8 + k <= qt) bits |= 1u << k;
        } else {
            unsigned v[8]; int cnt[8];
#pragma unroll
            for (int k = 0; k < 8; ++k) { v[k] = sImp[q * 64 + sub * 8 + k]; cnt[k] = 0; }
            for (int jp = 1; jp <= qt - 2; ++jp) {
                const unsigned vp = sImp[q * 64 + jp];
#pragma unroll
                for (int k = 0; k < 8; ++k) cnt[k] += (vp > v[k] || (vp == v[k] && jp < sub * 8 + k)) ? 1 : 0;
            }
#pragma unroll
            for (int k = 0; k < 8; ++k) {
                const int j = sub * 8 + k;
                const bool forced = (j == 0) || (j == qt) || (j == qt - 1), cand = (j >= 1) && (j <= qt - 2);
                if (forced || (cand && cnt[k] < 13)) bits |= 1u << k;
            }
        }
        unsigned lo = sub < 4 ? bits << (sub * 8) : 0u, hi = sub >= 4 ? bits << ((sub - 4) * 8) : 0u;
        lo |= __shfl_xor(lo, 1); hi |= __shfl_xor(hi, 1); lo |= __shfl_xor(lo, 2); hi |= __shfl_xor(hi, 2); lo |= __shfl_xor(lo, 4); hi |= __shfl_xor(hi, 4);
        if (sub == 0) { sSel[q * 2] = lo; sSel[q * 2 + 1] = hi; }
    }
    __syncthreads();
    if (w == 0) {
        unsigned lo = sSel[lane * 2], hi = sSel[lane * 2 + 1];
#pragma unroll
        for (int x = 1; x < 64; x <<= 1) { lo |= __shfl_xor(lo, x); hi |= __shfl_xor(hi, x); }
        if (lane == 0) {
            int n = 0;
            for (int j = 0; j <= qt; ++j) { const unsigned bit = j < 32 ? (lo >> j) : (hi >> (j - 32)); if (bit & 1u) sList[n++] = j; }
            *sCnt = n;
        }
    }
    __syncthreads();
    {
        const int nsel = *sCnt;
        const unsigned lo = sSel[qs * 2], hi = sSel[qs * 2 + 1];
        m = -1e30f; l = 0.f; zero16(o[0]); zero16(o[1]);
        attn_run<64>(lds, B.KS + (size_t)bg * S * 64, nullptr, B.VST + (size_t)bg * 64 * S, S, nsel, TileList{sList}, MaskSlc{tq, lo, hi}, NoSkip{}, c, qf, m, l, o);
        const float lt = l + __shfl_xor(l, 32); const float iv = (lt > 0.f ? 1.f / lt : 0.f) * gt[1];
#pragma unroll
        for (int dt = 0; dt < 2; ++dt)
#pragma unroll
            for (int e = 0; e < 16; ++e) stash[(dt * 16 + e) * 64] += o[dt][e] * iv;
    }
    {
        const int t0 = qt >= 8 ? qt - 8 : 0;
        m = -1e30f; l = 0.f; zero16(o[0]); zero16(o[1]);
        attn_run<64>(lds, B.KW + (size_t)bg * S * 64, nullptr, B.VWT + (size_t)bg * 64 * S, S, qt - t0 + 1, TileOff{t0}, MaskWin{tq}, NoSkip{}, c, qf, m, l, o);
        const float lt = l + __shfl_xor(l, 32); const float iv = (lt > 0.f ? 1.f / lt : 0.f) * gt[2];
#pragma unroll
        for (int dt = 0; dt < 2; ++dt)
#pragma unroll
            for (int e = 0; e < 16; ++e) o[dt][e] = stash[(dt * 16 + e) * 64] + o[dt][e] * iv;
    }
    bf16_t* orow = B.OAB + row * 1024 + head * 64;
#pragma unroll
    for (int dt = 0; dt < 2; ++dt)
#pragma unroll
        for (int a = 0; a < 4; ++a) {
            u32x2 w2 = {pk2(o[dt][4 * a], o[dt][4 * a + 1]), pk2(o[dt][4 * a + 2], o[dt][4 * a + 3])};
            *(u32x2*)(orow + 32 * dt + 8 * a + 4 * hh) = w2;
        }
}

DI void mla_unit(const Bufs& B, LAS unsigned char* lds, int b, int h, int qb) {
    const int tid = my_tid(), lane = tid & 63, w = tid >> 6, hh = lane >> 5;
    const int tq = qb * 256 + w * 32 + (lane & 31);
    const size_t row = (size_t)b * S + tq;
    bf16x8 qf[6];
#pragma unroll
    for (int ks = 0; ks < 6; ++ks) qf[ks] = *(const bf16x8*)(B.QM + row * 768 + h * 96 + ks * 16 + hh * 8);
    const float c = 0.10206207261596575f * LOG2E;
    float m = -1e30f, l = 0.f; f32x16 o[2]; zero16(o[0]); zero16(o[1]);
    attn_run<96>(lds, B.KM + (size_t)(b * 8 + h) * S * 64, B.KPE + (size_t)b * S * 32, B.VMT + (size_t)(b * 8 + h) * 64 * S, S, 4 * (qb + 1),
                 TileId{}, MaskCausal{tq}, SkipAbove{qb * 256 + w * 32 + 31}, c, qf, m, l, o);
    const float lt = l + __shfl_xor(l, 32); const float iv = lt > 0.f ? 1.f / lt : 0.f;
    bf16_t* orow = B.OAB + row * 1024 + 512 + h * 64;
#pragma unroll
    for (int dt = 0; dt < 2; ++dt)
#pragma unroll
        for (int a = 0; a < 4; ++a) {
            u32x2 w2 = {pk2(o[dt][4 * a] * iv, o[dt][4 * a + 1] * iv), pk2(o[dt][4 * a + 2] * iv, o[dt][4 * a + 3] * iv)};
            *(u32x2*)(orow + 32 * dt + 8 * a + 4 * hh) = w2;
        }
}

DI void attn_phase(const Bufs& B, LAS unsigned char* lds, unsigned* counter) {
    LAS int* sUnit = (LAS int*)(lds + MISC_OFF); int it_ = 0; (void)sUnit; (void)it_; (void)counter;
    for (;;) {
#if ATT_STATIC
        __syncthreads();
        const int u = (int)blockIdx.x + 256 * it_; ++it_;
        if (u >= 2048) break;
#else
        __syncthreads();
        if (threadIdx.x == 0) *sUnit = (int)atomicAdd(counter, 1u);
        __syncthreads();
        const int u = *sUnit;
        if (u >= 2048) break;
#endif
        const int i = u >> 1;
        if ((u & 1) == 0) {
#if EXP_ATT == 2
            { const int b = (i & 63) >> 3, h = i & 7, qb = 15 - (i >> 6);
              for (int e = threadIdx.x; e < 2048; e += 512) *(u32x4*)(B.OAB + ((size_t)b * S + qb * 256 + (e >> 3)) * 1024 + 512 + h * 64 + (e & 7) * 8) = (u32x4){0x3c003c00u, 0x3c003c00u, 0x3c003c00u, 0x3c003c00u}; }
#else
            mla_unit(B, lds, (i & 63) >> 3, i & 7, 15 - (i >> 6));
#endif
        } else {
#if EXP_ATT == 1
            { const int b = (i & 15) >> 1, g = i & 1, qt = 63 - (i >> 4);
              for (int e = threadIdx.x; e < 2048; e += 512) *(u32x4*)(B.OAB + ((size_t)b * S + qt * 64 + (e >> 5)) * 1024 + g * 256 + (e & 31) * 8) = (u32x4){0x3c003c00u, 0x3c003c00u, 0x3c003c00u, 0x3c003c00u}; }
#else
            nsa_unit(B, lds, (i & 15) >> 1, i & 1, 63 - (i >> 4));
#endif
        }
    }
}

DI float wave_sum(float v) {
#pragma unroll
    for (int o = 1; o < 64; o <<= 1) v += __shfl_xor(v, o);
    return v;
}
DI void norm_rows_bf16(const float* x, const float* g, bf16_t* xn) {
    const int tid_ = my_tid(), lane = tid_ & 63, gw = blockIdx.x * 8 + (tid_ >> 6), ngw = gridDim.x * 8;
    f32x4 gv[4];
#pragma unroll
    for (int j = 0; j < 4; ++j) gv[j] = ((const f32x4*)g)[lane + 64 * j];
    for (int r = gw; r < M; r += ngw) {
        const f32x4* xr = (const f32x4*)(x + (size_t)r * D) + lane;
        f32x4 v[4]; float s = 0.f;
#pragma unroll
        for (int j = 0; j < 4; ++j) { v[j] = xr[64 * j]; s += (v[j][0] * v[j][0] + v[j][1] * v[j][1]) + (v[j][2] * v[j][2] + v[j][3] * v[j][3]); }
        const float rstd = rsqrtf(wave_sum(s) * (1.f / D) + EPS);
        u32x2* o8 = (u32x2*)(xn + (size_t)r * D) + lane;
#pragma unroll
        for (int j = 0; j < 4; ++j) o8[64 * j] = (u32x2){pk2(v[j][0] * rstd * gv[j][0], v[j][1] * rstd * gv[j][1]), pk2(v[j][2] * rstd * gv[j][2], v[j][3] * rstd * gv[j][3])};
    }
}
DI void norm_rows_f32_inplace(float* x, const float* g) {
    const int tid_ = my_tid(), lane = tid_ & 63, gw = blockIdx.x * 8 + (tid_ >> 6), ngw = gridDim.x * 8;
    f32x4 gv[4];
#pragma unroll
    for (int j = 0; j < 4; ++j) gv[j] = ((const f32x4*)g)[lane + 64 * j];
    for (int r = gw; r < M; r += ngw) {
        f32x4* xr = (f32x4*)(x + (size_t)r * D) + lane;
        f32x4 v[4]; float s = 0.f;
#pragma unroll
        for (int j = 0; j < 4; ++j) { v[j] = xr[64 * j]; s += (v[j][0] * v[j][0] + v[j][1] * v[j][1]) + (v[j][2] * v[j][2] + v[j][3] * v[j][3]); }
        const float rstd = rsqrtf(wave_sum(s) * (1.f / D) + EPS);
#pragma unroll
        for (int j = 0; j < 4; ++j) xr[64 * j] = (f32x4){v[j][0] * rstd * gv[j][0], v[j][1] * rstd * gv[j][1], v[j][2] * rstd * gv[j][2], v[j][3] * rstd * gv[j][3]};
    }
}

DI int perm64(int p) { return (p >> 1) + 32 * (p & 1); }
DI int perm32r(int p) { return (p >> 1) + 16 * (p & 1); }
DI int map_in(int c) {
    if (c < 512) return (c & ~63) + perm64(c & 63);
    if (c < 1280) { const int t = (c - 512) >> 8, cc = (c - 512) & 255, kv = cc >> 7, g = (cc >> 6) & 1, p = cc & 63; return 512 + t * 256 + kv * 128 + g * 64 + (kv == 0 ? perm64(p) : p); }
    if (c < 1536) return 1304 + (c - 1280);
    if (c < 1792) { const int cc = c - 1536; if (cc < 128) return 1560 + cc; if (cc < 160) return 1688 + perm32r(cc - 128); if (cc < 184) return 1280 + (cc - 160); return -1; }
    if (c < 2816) return 1720 + (c - 1792);
    return 2744 + (c - 2816);
}
struct Wts {
    const float *w_in, *cmp_pe, *cmp_w1, *cmp_w2, *nsa_w_o, *q_norm, *kv_norm, *w_uq, *w_ukv, *mla_w_o, *w_out, *w_up, *w_down;
};
template <int JOB> DI float prep_get(const Wts& W, int n, int k) {
    if constexpr (JOB == 0) { const int c = map_in(n); return c >= 0 ? W.w_in[(size_t)k * IN_COLS + c] : 0.f; }
    if constexpr (JOB == 1) { const int j = n >> 8, h = n & 255, lp = k >> 6, p = k & 63, d = j == 0 ? perm64(p) : p; return W.cmp_w1[((size_t)j * 2048 + lp * 64 + d) * 256 + h]; }
    if constexpr (JOB == 2) { const int j = n >> 8, np = n & 255; return np < 64 ? W.cmp_w2[((size_t)j * 256 + k) * 64 + (j == 0 ? perm64(np) : np)] : 0.f; }
    if constexpr (JOB == 3) { return n < 1024 ? W.nsa_w_o[(size_t)k * 1024 + n] : W.mla_w_o[(size_t)k * 1024 + (n - 1024)]; }
    if constexpr (JOB == 4) { const int hh = n / 96, c = n - hh * 96; const int sc = c < 64 ? n : hh * 96 + 64 + perm32r(c - 64); return W.q_norm[k] * W.w_uq[(size_t)k * 768 + sc]; }
    if constexpr (JOB == 5) { return k < 128 ? W.kv_norm[k] * W.w_ukv[(size_t)k * 1024 + n] : 0.f; }
    if constexpr (JOB == 6) { return W.w_out[(size_t)k * 1024 + n]; }
    if constexpr (JOB == 7) { return W.w_up[(size_t)k * 4096 + n]; }
    if constexpr (JOB == 8) { return W.w_down[(size_t)k * 1024 + n]; }
    return 0.f;
}
template <int JOB> DI void prep_tile(const Wts& W, LAS float* scr, bf16_t* dst, int ldd, int n0, int k0) {
    const int tid = my_tid();
#pragma unroll
    for (int it = 0; it < 8; ++it) { const int kk = it * 8 + (tid >> 6), nn = tid & 63; scr[kk * 65 + nn] = prep_get<JOB>(W, n0 + nn, k0 + kk); }
    __syncthreads();
    { const int n = tid >> 3, kc = tid & 7; const LAS float* s = scr + (kc * 8) * 65 + n;
      u32x4 o = {pk2(s[0], s[65]), pk2(s[130], s[195]), pk2(s[260], s[325]), pk2(s[390], s[455])};
      *(u32x4*)(dst + (size_t)(n0 + n) * ldd + k0 + kc * 8) = o; }
    __syncthreads();
}
DI void prep_phase(const Wts& W, unsigned char* ws, LAS unsigned char* lds, int layer) {
    LAS float* scr = (LAS float*)lds;
    const int tid = my_tid();
    constexpr int T0 = 960, T1 = T0 + 256, T2 = T1 + 32, T3 = T2 + 256, T4 = T3 + 48, T5 = T4 + 64, T6_ = T5 + 256, T7 = T6_ + 1024, T8 = T7 + 1024, TB = T8 + 8;
    for (int job = blockIdx.x; job < TB; job += gridDim.x) {
        int r = job;
        if (r < T0) { prep_tile<0>(W, scr, (bf16_t*)(ws + WS_WIN), 1024, (r >> 4) * 64, (r & 15) * 64); continue; }
        if (r < T1) { r -= T0; prep_tile<1>(W, scr, (bf16_t*)(ws + WS_W1T), 2048, (r >> 5) * 64, (r & 31) * 64); continue; }
        if (r < T2) { r -= T1; prep_tile<2>(W, scr, (bf16_t*)(ws + WS_W2T), 256, (r >> 2) * 64, (r & 3) * 64); continue; }
        if (r < T3) { r -= T2; prep_tile<3>(W, scr, (bf16_t*)(ws + WS_WOAB), 512, (r >> 3) * 64, (r & 7) * 64); continue; }
        if (r < T4) { r -= T3; prep_tile<4>(W, scr, (bf16_t*)(ws + WS_WUQ), 256, (r >> 2) * 64, (r & 3) * 64); continue; }
        if (r < T5) { r -= T4; prep_tile<5>(W, scr, (bf16_t*)(ws + WS_WUKV), 256, (r >> 2) * 64, (r & 3) * 64); continue; }
        if (r < T6_) { r -= T5; prep_tile<6>(W, scr, (bf16_t*)(ws + WS_WOUT), 1024, (r >> 4) * 64, (r & 15) * 64); continue; }
        if (r < T7) { r -= T6_; prep_tile<7>(W, scr, (bf16_t*)(ws + WS_WUP), 1024, (r >> 4) * 64, (r & 15) * 64); continue; }
        if (r < T8) { r -= T7; prep_tile<8>(W, scr, (bf16_t*)(ws + WS_WDN), 4096, (r >> 6) * 64, (r & 63) * 64); continue; }
        {
            r -= T8; const int j = r >> 2, hc = r & 3, kk = tid >> 6, hx = tid & 63, h = hc * 64 + hx;
            float a = 0.f;
            for (int i = 0; i < 256; ++i) { const int k = kk + 8 * i; a += W.cmp_pe[j * 2048 + k] * W.cmp_w1[((size_t)j * 2048 + k) * 256 + h]; }
            scr[kk * 64 + hx] = a;
            __syncthreads();
            if (tid < 64) { float s = 0.f; for (int q = 0; q < 8; ++q) s += scr[q * 64 + tid]; ((float*)(ws + WS_CB1))[j * 256 + hc * 64 + tid] = s; }
            __syncthreads();
        }
    }
    if (layer == 0) {
        f32x2* cs64 = (f32x2*)(ws + WS_CS64); f32x2* cs32 = (f32x2*)(ws + WS_CS32);
        for (int idx = blockIdx.x * 512 + tid; idx < S * 48; idx += gridDim.x * 512) {
            int pos, i; float inv;
            if (idx < S * 32) { pos = idx >> 5; i = idx & 31; inv = (float)exp2(-(double)i * (13.287712379549449 / 32.0)); }
            else { const int e = idx - S * 32; pos = e >> 4; i = e & 15; inv = (float)exp2(-(double)i * (13.287712379549449 / 16.0)); }
            const float ang = (float)pos * inv;
            const double rev = (double)ang * 0.15915494309189535; const float fr = (float)(rev - floor(rev));
            const f32x2 v = {__builtin_amdgcn_cosf(fr), __builtin_amdgcn_sinf(fr)};
            if (idx < S * 32) cs64[idx] = v; else cs32[idx - S * 32] = v;
        }
    }
}

struct Params { const float* in[17]; float* out; unsigned char* ws; int ph_lo, ph_hi; };
typedef const __attribute__((address_space(4))) unsigned char* kaptr_t;
DI const float* karg_ptr(int byte_off) { kaptr_t ka = (kaptr_t)__builtin_amdgcn_kernarg_segment_ptr(); asm volatile("" : "+s"(ka)); return *(const float* const __attribute__((address_space(4)))*)(ka + byte_off); }
#define KIN(i) karg_ptr(8 * (i))

DI void grid_barrier(cg::grid_group& grid) {
    asm volatile("s_waitcnt vmcnt(0) lgkmcnt(0)" ::: "memory");
    __syncthreads();
    if (threadIdx.x < 64) asm volatile("buffer_wbl2 sc1\n\ts_waitcnt vmcnt(0)" ::: "memory");
    __syncthreads();
    grid.sync();
    asm volatile("buffer_inv sc1\n\ts_waitcnt vmcnt(0)" ::: "memory");
}

#define PH_IN(k) (lo <= (k) && (k) < hi)
#define PH_SEAM(k) do { if (PH_IN(k) && PH_IN((k) + 1)) grid_barrier(grid); } while (0)
#define PH_ENV() int G = gridDim.x, bx = blockIdx.x; asm volatile("" : "+s"(G), "+s"(bx)); unsigned char* ws = (unsigned char*)karg_ptr(144); float* X = (float*)karg_ptr(136); \
                 const int tid = my_tid(); bf16_t* XN = (bf16_t*)(ws + WS_XN); (void)tid; (void)X; (void)XN; (void)G; (void)bx

template <int L> DI void run_layer(LAS unsigned char* lds, cg::grid_group& grid, int lo, int hi) {
    constexpr int P0 = 10 * L;
    if (PH_IN(P0 + 0)) {
        PH_ENV();
        Wts W;
        W.w_in = KIN(2) + (size_t)L * 1024 * IN_COLS; W.cmp_pe = KIN(3) + (size_t)L * 2 * 2048; W.cmp_w1 = KIN(4) + (size_t)L * 2 * 2048 * 256;
        W.cmp_w2 = KIN(5) + (size_t)L * 2 * 256 * 64; W.nsa_w_o = KIN(6) + (size_t)L * 512 * 1024; W.q_norm = KIN(7) + L * 256; W.kv_norm = KIN(8) + L * 128;
        W.w_uq = KIN(9) + (size_t)L * 256 * 768; W.w_ukv = KIN(10) + (size_t)L * 128 * 1024; W.mla_w_o = KIN(11) + (size_t)L * 512 * 1024;
        W.w_out = KIN(12) + (size_t)L * 1024 * 1024; W.w_up = KIN(14) + (size_t)L * 1024 * 4096; W.w_down = KIN(15) + (size_t)L * 4096 * 1024;
        prep_phase(W, ws, lds, L);
        unsigned* ctl = (unsigned*)(ws + WS_CTL);
        if (L == 0 && bx == 0 && tid < NL) atomicExch(ctl + tid * 64, 0u);
        norm_rows_bf16(L == 0 ? KIN(0) : X, KIN(1) + L * D, XN);
    }
    PH_SEAM(P0 + 0);
    if (PH_IN(P0 + 1)) {
        PH_ENV();
        pg8::Gemm g{XN, (const bf16_t*)(ws + WS_WIN), 1024, 1024}; pg8::StaticOrder So; So.init(M, NIN, G, bx);
        EpiWrap<EpiInImpl> E; E.ws = ws;
        pg8::gemm_phase(lds, g, So, E);
    }
    PH_SEAM(P0 + 1);
    if (PH_IN(P0 + 2)) {
        PH_ENV();
        { pg8::Gemm g{(const bf16_t*)(ws + WS_KCV), (const bf16_t*)(ws + WS_W1T), 1024, 2048}; pg8::CmpOrder So{G, bx};
          EpiWrap<EpiC1Impl> E; E.ws = ws;
          pg8::gemm_phase(lds, g, So, E); }
        const int crot = (bx + G - 32) % G;
        { pg8::Gemm g{(const bf16_t*)(ws + WS_CQ), (const bf16_t*)(ws + WS_WUQ), 256, 256}; pg8::StaticOrder So; So.init(M, 768, G, crot);
          EpiWrap<EpiUQImpl> E; E.ws = ws;
          pg8::gemm_phase(lds, g, So, E); }
        { pg8::Gemm g{(const bf16_t*)(ws + WS_T6), (const bf16_t*)(ws + WS_WUKV), 256, 256}; pg8::StaticOrder So; So.init(M, 1024, G, crot);
          EpiWrap<EpiUKVImpl> E; E.ws = ws;
          pg8::gemm_phase(lds, g, So, E); }
    }
    PH_SEAM(P0 + 2);
    if (PH_IN(P0 + 3)) {
        PH_ENV();
        pg8::Gemm g{(const bf16_t*)(ws + WS_HC), (const bf16_t*)(ws + WS_W2T), 256, 256}; pg8::CmpOrder So{G, bx};
        EpiWrap<EpiC2Impl> E; E.ws = ws;
        pg8::gemm_phase(lds, g, So, E);
    }
    PH_SEAM(P0 + 3);
    if (PH_IN(P0 + 4)) {
        PH_ENV();
        Bufs B; B.QN = (const bf16_t*)(ws + WS_QN); B.KS = (const bf16_t*)(ws + WS_KS); B.KW = (const bf16_t*)(ws + WS_KW); B.VST = (const bf16_t*)(ws + WS_VST);
        B.VWT = (const bf16_t*)(ws + WS_VWT); B.KCMP = (const bf16_t*)(ws + WS_KCMP); B.VCMPT = (const bf16_t*)(ws + WS_VCMPT); B.QM = (const bf16_t*)(ws + WS_QM);
        B.KM = (const bf16_t*)(ws + WS_KM); B.KPE = (const bf16_t*)(ws + WS_KPE); B.VMT = (const bf16_t*)(ws + WS_VMT); B.GN = (const float*)(ws + WS_GN); B.OAB = XN;
#if EXP_NOATTN
        { u32x4* o = (u32x4*)XN; for (size_t i = (size_t)bx * 512 + tid; i < (size_t)M * 1024 / 8; i += (size_t)G * 512) o[i] = (u32x4){0x3c003c00u, 0x3c003c00u, 0x3c003c00u, 0x3c003c00u}; (void)B; }
#else
        attn_phase(B, lds, (unsigned*)(ws + WS_CTL) + L * 64);
#endif
    }
    PH_SEAM(P0 + 4);
    if (PH_IN(P0 + 5)) {
        PH_ENV();
        pg8::StaticOrder So; So.init(M, 1024, G, bx);
        { pg8::Gemm g{XN, (const bf16_t*)(ws + WS_WOAB), 1024, 512}; EpiWrap<EpiD1aImpl> E; E.ws = ws; pg8::gemm_phase(lds, g, So, E); }
        { pg8::Gemm g{XN + 512, (const bf16_t*)(ws + WS_WOAB) + 1024 * 512, 1024, 512}; EpiWrap<EpiD1bImpl> E; E.ws = ws; pg8::gemm_phase(lds, g, So, E); }
    }
    PH_SEAM(P0 + 5);
    if (PH_IN(P0 + 6)) {
        PH_ENV();
        pg8::Gemm g{(const bf16_t*)(ws + WS_MG), (const bf16_t*)(ws + WS_WOUT), 1024, 1024}; pg8::StaticOrder So; So.init(M, 1024, G, bx);
        EpiWrap<EpiD2Impl> E; E.xin = (L == 0 ? KIN(0) : X); E.X = X;
        pg8::gemm_phase(lds, g, So, E);
    }
    PH_SEAM(P0 + 6);
    if (PH_IN(P0 + 7)) {
        PH_ENV();
        norm_rows_bf16(X, KIN(13) + L * D, XN);
    }
    PH_SEAM(P0 + 7);
    if (PH_IN(P0 + 8)) {
        PH_ENV();
        pg8::Gemm g{XN, (const bf16_t*)(ws + WS_WUP), 1024, 1024}; pg8::StaticOrder So; So.init(M, FF, G, bx);
        EpiWrap<EpiUpImpl> E; E.ws = ws;
        pg8::gemm_phase(lds, g, So, E);
    }
    PH_SEAM(P0 + 8);
    if (PH_IN(P0 + 9)) {
        PH_ENV();
        pg8::Gemm g{(const bf16_t*)(ws + WS_HF), (const bf16_t*)(ws + WS_WDN), 4096, 4096}; pg8::StaticOrder So; So.init(M, 1024, G, bx);
        EpiWrap<EpiD2Impl> E; E.xin = X; E.X = X;
        pg8::gemm_phase(lds, g, So, E);
    }
    PH_SEAM(P0 + 9);
}

__global__ void __launch_bounds__(512, 2) mega(Params P) {
    extern __shared__ __attribute__((aligned(16))) unsigned char lds_raw[];
    LAS unsigned char* lds = (LAS unsigned char*)lds_raw;
    cg::grid_group grid = cg::this_grid();
    const int lo = P.ph_lo, hi = P.ph_hi;
    run_layer<0>(lds, grid, lo, hi);
    run_layer<1>(lds, grid, lo, hi);
    run_layer<2>(lds, grid, lo, hi);
    run_layer<3>(lds, grid, lo, hi);
    if (PH_IN(40)) { float* X = (float*)karg_ptr(136); norm_rows_f32_inplace(X, KIN(16)); }
}

extern "C" void kernel_launch(void* const* d_in, const int* in_sizes, int n_in, void* d_out, int out_size, void* d_ws, size_t ws_size, hipStream_t stream) {
    static int grid = 0;
    if (grid == 0) {
        if (n_in != 17 || out_size != M * D || ws_size < WS_END) { fprintf(stderr, "kernel_launch: unexpected shapes (n_in %d out %d ws %zu)\n", n_in, out_size, ws_size); grid = -1; return; }
        int dev = 0, cus = 0, per_cu = 0;
        hipGetDevice(&dev);
        hipDeviceGetAttribute(&cus, hipDeviceAttributeMultiprocessorCount, dev);
        if (hipFuncSetAttribute((const void*)mega, hipFuncAttributeMaxDynamicSharedMemorySize, LDS_BYTES) != hipSuccess) { fprintf(stderr, "kernel_launch: hipFuncSetAttribute failed\n"); grid = -1; return; }
        if (hipOccupancyMaxActiveBlocksPerMultiprocessor(&per_cu, (const void*)mega, 512, LDS_BYTES) != hipSuccess || per_cu < 1) { fprintf(stderr, "kernel_launch: occupancy query gave %d\n", per_cu); per_cu = 1; }
        (void)hipGetLastError();
        grid = cus * per_cu;
    }
    if (grid < 0) return;
    Params p{};
    for (int i = 0; i < 17; ++i) p.in[i] = (const float*)d_in[i];
    p.out = (float*)d_out; p.ws = (unsigned char*)d_ws;
#if MK_MULTI
    for (int ph = 0; ph <= 40; ++ph) {
        p.ph_lo = ph; p.ph_hi = ph + 1;
        hipLaunchKernelGGL(mega, dim3(grid), dim3(512), LDS_BYTES, stream, p);
    }
#else
    p.ph_lo = 0; p.ph_hi = 41;
    void* args[] = {&p};
    hipError_t e = hipLaunchCooperativeKernel((const void*)mega, dim3(grid), dim3(512), args, LDS_BYTES, stream);
    if (e != hipSuccess) fprintf(stderr, "kernel_launch: cooperative launch failed: %s (grid %d)\n", hipGetErrorString(e), grid);
#endif
}
```

```cpp
#include <hip/hip_runtime.h>
#include <hip/hip_cooperative_groups.h>
#include <cstdio>
#include <cstdint>
namespace cg = cooperative_groups;

#ifndef EXP_NOATTN
#define EXP_NOATTN 0
#endif
#ifndef ATT_STATIC
#define ATT_STATIC 0
#endif
#ifndef EXP_ATT
#define EXP_ATT 0
#endif
#ifndef DUP_MASK
#define DUP_MASK 0
#endif
#ifndef MK_MULTI
#define MK_MULTI 0
#endif

#define LAS __attribute__((address_space(3)))
#define DI __device__ __forceinline__
typedef unsigned short bf16_t;
typedef short bf16x8 __attribute__((ext_vector_type(8)));
typedef float f32x4 __attribute__((ext_vector_type(4)));
typedef float f32x2 __attribute__((ext_vector_type(2)));
typedef float f32x16 __attribute__((ext_vector_type(16)));
typedef unsigned u32x4 __attribute__((ext_vector_type(4)));
typedef unsigned u32x2 __attribute__((ext_vector_type(2)));
typedef __bf16 bf16v2 __attribute__((ext_vector_type(2)));

DI unsigned pk2(float lo, float hi) { f32x2 v = {lo, hi}; return __builtin_bit_cast(unsigned, __builtin_convertvector(v, bf16v2)); }
DI bf16_t f2bf(float x) { return (bf16_t)(pk2(x, 0.f) & 0xffffu); }
DI float bflo(unsigned w) { return __uint_as_float(w << 16); }
DI float bfhi(unsigned w) { return __uint_as_float(w & 0xffff0000u); }
DI float sigmoidf_(float x) { return 1.f / (1.f + __expf(-x)); }
DI float ex2(float x) { return __builtin_amdgcn_exp2f(x); }
DI int my_tid() { int t = threadIdx.x; asm volatile("" : "+v"(t)); return t; }

constexpr int NB = 8, S = 4096, D = 1024, NL = 4, M = NB * S, FF = 4096;
constexpr int NIN = 3840;
constexpr int IN_COLS = 3768;
constexpr float EPS = 1e-6f;
constexpr float LOG2E = 1.4426950408889634f;

constexpr size_t MiB = 1u << 20;
constexpr size_t WS_CTL = 0;
constexpr size_t WS_BAR = 16384;
constexpr size_t WS_CB1 = 4096;
constexpr size_t WS_RSQ = 65536;
constexpr size_t WS_RSKV = 65536 + 131072;
constexpr size_t WS_CS64 = 1 * MiB;
constexpr size_t WS_CS32 = 2 * MiB;
constexpr size_t WS_WIN = 3 * MiB;
constexpr size_t WS_W1T = WS_WIN + (size_t)NIN * 1024 * 2;
constexpr size_t WS_W2T = WS_W1T + 2 * MiB;
constexpr size_t WS_WOAB = WS_W2T + 256 * 1024;
constexpr size_t WS_WUQ = WS_WOAB + 2 * MiB;
constexpr size_t WS_WUKV = WS_WUQ + 384 * 1024;
constexpr size_t WS_WOUT = 16 * MiB;
constexpr size_t WS_WUP = 18 * MiB;
constexpr size_t WS_WDN = 26 * MiB;
constexpr size_t WS_XN = 34 * MiB;
constexpr size_t WS_GA = 98 * MiB;
constexpr size_t WS_GB = 162 * MiB;
constexpr size_t WS_QN = 226 * MiB;
constexpr size_t WS_KCV = 258 * MiB;
constexpr size_t WS_KS = 274 * MiB, WS_KW = 282 * MiB, WS_VST = 290 * MiB, WS_VWT = 298 * MiB;
constexpr size_t WS_CQ = 306 * MiB, WS_T6 = 322 * MiB, WS_KPE = 338 * MiB, WS_GN = 340 * MiB;
constexpr size_t WS_QM = 343 * MiB, WS_KM = 391 * MiB, WS_VMT = 423 * MiB, WS_HC = 455 * MiB;
constexpr size_t WS_KCMP = 459 * MiB, WS_VCMPT = WS_KCMP + 512 * 1024;
constexpr size_t WS_MG = 226 * MiB;
constexpr size_t WS_HF = 98 * MiB;
constexpr size_t WS_PQ = 460 * MiB;
constexpr size_t WS_PKV = 461 * MiB;
constexpr size_t WS_END = 462 * MiB;
static_assert(WS_WUKV + 512 * 1024 <= WS_WOUT, "ws map");

constexpr int LDS_BYTES = 147456;
constexpr int MISC_OFF = 131072;
constexpr int AT_K = 0, AT_V = 13312, AT_BUF = 22528  , AT_IMP = 45056, AT_SEL = 61440, AT_LIST = 61952, AT_CNT = 62208, AT_ACC = 65536;

namespace pg8 {
constexpr int BM = 256, BK = 64, HALF = 128, HTB = HALF * BK * 2, NXCD = 8, WGM = 8;
__host__ __device__ __forceinline__ int lds_byte(int r, int c) { const int st = (r >> 4) * 2 + (c >> 5), rr = r & 15, cc = c & 31, ob = rr * 64 + cc * 2; return st * 1024 + (ob ^ (((ob >> 9) & 1) << 5)); }
__host__ __device__ __forceinline__ void stage_rc(int b, int& R, int& C) { const int st = b / 1024, sb = b % 1024, swz = sb ^ (((sb >> 9) & 1) << 5); R = (st >> 1) * 16 + swz / 64; C = (st & 1) * 32 + (swz % 64) / 2; }
__host__ __device__ __forceinline__ int perm32(int rho) { const int n = rho >> 4, i = rho & 15; return 8 * (i >> 2) + 4 * n + (i & 3); }

struct Unit { int pm, pn; };
struct Gemm { const bf16_t* A; const bf16_t* Bt; int lda; int K; };

struct StaticOrder {
    int nM, nN, nwg, G, c;
    __device__ void init(int M_, int N_, int G_, int c_) { nM = M_ / BM; nN = N_ / BM; nwg = nM * nN; G = G_; c = c_; }
    __device__ bool next(int i, Unit& u) const {
        const long L = (long)i * G + c; if (L >= nwg) return false;
        int wgid = (int)L; { const int q = nwg / NXCD, r = nwg % NXCD, xcd = wgid % NXCD, off = wgid / NXCD; wgid = (xcd < r ? xcd * (q + 1) : r * (q + 1) + (xcd - r) * q) + off; }
        const int nig = WGM * nN, gid = wgid / nig, fm = gid * WGM, gsz = (nM - fm) < WGM ? (nM - fm) : WGM;
        u.pm = fm + ((wgid % nig) % gsz); u.pn = (wgid % nig) / gsz; return true;
    }
};
struct CmpOrder {
    int G, c;
    __device__ bool next(int i, Unit& u) const { const int L = i * G + c; if (L >= 32) return false; u.pm = L; u.pn = L >> 4; return true; }
};

template <class Epi, class Sched>
__device__ __forceinline__ void gemm_phase(LAS unsigned char* lds, const Gemm g, const Sched& S, const Epi& E) {
    const int tid = my_tid(), wid = __builtin_amdgcn_readfirstlane(tid >> 6), lane = tid & 63, wr = wid >> 2, wc = wid & 3, fr = lane & 15, fq = lane >> 4;
    const int K = g.K, nt = K / BK, lda = g.lda;
    unsigned voffA, voffB;
    { int R, C; stage_rc(tid * 16, R, C); const int Rb = (R & ~31) + perm32(R & 31);
        voffA = (unsigned)(R * lda + C) * 2u; voffB = (unsigned)(Rb * K + C) * 2u; }
    const size_t qvoffA = (size_t)64 * lda * 2, qvoffB = (size_t)64 * K * 2;
    const size_t kstep = (size_t)(BK * 2);
    const size_t hstepA = (size_t)HALF * lda * 2, hstepB = (size_t)HALF * K * 2;
    const size_t tstepA = 2 * hstepA, tstepB = 2 * hstepB;
    const unsigned ldsw = (unsigned)wid * 1024u;
    const int aoff = lds_byte(wr * 64 + fr, fq * 8), boff = lds_byte(wc * 32 + fr, fq * 8);
#define PG8_SA(b, h) (((b) * 2 + (h)) * HTB)
#define PG8_SB(b, h) ((4 + (b) * 2 + (h)) * HTB)
#define PG8_STAGE(bufoff, gbase, voff) do { _Pragma("unroll") for (int _i = 0; _i < 2; ++_i) \
        __builtin_amdgcn_global_load_lds((const unsigned*)((const char*)(gbase) + (size_t)_i * q##voff + (voff)), (LAS unsigned*)(lds + (bufoff) + ldsw + _i * 8192), 16, 0, 0); } while (0)
#define PG8_LDA(dst, b, h) do { _Pragma("unroll") for (int m = 0; m < 4; ++m) _Pragma("unroll") for (int k = 0; k < 2; ++k) dst[m][k] = *(const LAS bf16x8*)(lds + PG8_SA(b, h) + aoff + m * 2048 + k * 1024); } while (0)
#define PG8_LDB(dst, b, h) do { _Pragma("unroll") for (int n = 0; n < 2; ++n) _Pragma("unroll") for (int k = 0; k < 2; ++k) dst[n][k] = *(const LAS bf16x8*)(lds + PG8_SB(b, h) + boff + n * 2048 + k * 1024); } while (0)
#define PG8_MMA(ai, bj, At, Bt) do { __builtin_amdgcn_s_setprio(1); _Pragma("unroll") for (int m = 0; m < 4; ++m) _Pragma("unroll") for (int n = 0; n < 2; ++n) _Pragma("unroll") for (int k = 0; k < 2; ++k) \
        acc[ai][bj][m][n] = __builtin_amdgcn_mfma_f32_16x16x32_bf16(Bt[n][k], At[m][k], acc[ai][bj][m][n], 0, 0, 0); __builtin_amdgcn_s_setprio(0); } while (0)
#define PG8_WAIT_V(n) asm volatile("s_waitcnt vmcnt(" #n ")" ::: "memory")
#define PG8_WAIT_L(n) asm volatile("s_waitcnt lgkmcnt(" #n ")" ::: "memory")
#define PG8_BAR __builtin_amdgcn_s_barrier()
#define PG8_SCHED __builtin_amdgcn_sched_barrier(0)
    Unit cur, nxt; int ui = 0;
    if (!S.next(0, cur)) return;
    f32x4 acc[2][2][4][2];
#pragma unroll
    for (int a = 0; a < 2; ++a)
#pragma unroll
        for (int b = 0; b < 2; ++b)
#pragma unroll
            for (int m = 0; m < 4; ++m)
#pragma unroll
                for (int n = 0; n < 2; ++n) acc[a][b][m][n] = (f32x4){0.f, 0.f, 0.f, 0.f};
    bf16x8 At[4][2], B0[2][2], B1[2][2];
    const char* cA = (const char*)g.A + (size_t)cur.pm * tstepA; const char* cB = (const char*)g.Bt + (size_t)cur.pn * tstepB;
    PG8_STAGE(PG8_SB(0, 0), cB, voffB); PG8_STAGE(PG8_SB(0, 1), cB + hstepB, voffB); PG8_STAGE(PG8_SA(0, 0), cA, voffA); PG8_STAGE(PG8_SA(0, 1), cA + hstepA, voffA);
    if (wr == 1) PG8_BAR;
    PG8_WAIT_V(2); PG8_BAR;
    PG8_STAGE(PG8_SB(1, 0), cB + kstep, voffB); PG8_STAGE(PG8_SA(1, 0), cA + kstep, voffA); PG8_STAGE(PG8_SB(1, 1), cB + hstepB + kstep, voffB);
    PG8_WAIT_V(6); PG8_BAR;
    for (;;) {
        const bool has_next = S.next(ui + 1, nxt);
        const char* nA = has_next ? (const char*)g.A + (size_t)nxt.pm * tstepA : cA; const char* nB = has_next ? (const char*)g.Bt + (size_t)nxt.pn * tstepB : cB;
        for (int t = 0; t < nt; t += 2) {
            const bool last = (t == nt - 2);
            const char* a1 = cA + (size_t)(t + 1) * kstep;
            const char* a2 = last ? nA : cA + (size_t)(t + 2) * kstep; const char* b2 = last ? nB : cB + (size_t)(t + 2) * kstep;
            const char* a3 = a2 + kstep; const char* b3 = b2 + kstep;
            PG8_LDB(B0, 0, 0); PG8_LDB(B1, 0, 1); PG8_SCHED; PG8_LDA(At, 0, 0); PG8_STAGE(PG8_SA(1, 1), a1 + hstepA, voffA);
            PG8_WAIT_V(8); PG8_WAIT_L(0); PG8_BAR; PG8_MMA(0, 0, At, B0); PG8_MMA(0, 1, At, B1); PG8_BAR; PG8_SCHED;
            PG8_LDA(At, 0, 1); PG8_STAGE(PG8_SB(0, 0), b2, voffB); PG8_STAGE(PG8_SB(0, 1), b2 + hstepB, voffB); PG8_STAGE(PG8_SA(0, 0), a2, voffA);
            PG8_WAIT_V(8); PG8_WAIT_L(0); PG8_BAR; PG8_MMA(1, 0, At, B0); PG8_MMA(1, 1, At, B1); PG8_BAR; PG8_SCHED;
            PG8_LDB(B0, 1, 0); PG8_LDB(B1, 1, 1); PG8_SCHED; PG8_LDA(At, 1, 0); PG8_STAGE(PG8_SA(0, 1), a2 + hstepA, voffA);
            PG8_WAIT_V(8); PG8_WAIT_L(0); PG8_BAR; PG8_MMA(0, 0, At, B0); PG8_MMA(0, 1, At, B1); PG8_BAR; PG8_SCHED;
            PG8_LDA(At, 1, 1); PG8_STAGE(PG8_SB(1, 0), b3, voffB); PG8_STAGE(PG8_SB(1, 1), b3 + hstepB, voffB); PG8_STAGE(PG8_SA(1, 0), a3, voffA);
            PG8_WAIT_V(8); PG8_WAIT_L(0); PG8_BAR; PG8_MMA(1, 0, At, B0); PG8_MMA(1, 1, At, B1); PG8_BAR; PG8_SCHED;
        }
        if (wr == 0) PG8_BAR;
        E(acc, cur, wr, wc, fr, fq);
        if (!has_next) break;
#pragma unroll
        for (int a = 0; a < 2; ++a)
#pragma unroll
            for (int b = 0; b < 2; ++b)
#pragma unroll
                for (int m = 0; m < 4; ++m)
#pragma unroll
                    for (int n = 0; n < 2; ++n) acc[a][b][m][n] = (f32x4){0.f, 0.f, 0.f, 0.f};
        cur = nxt; cA = nA; cB = nB; ++ui;
        if (wr == 1) PG8_BAR;
    }
    PG8_WAIT_V(0);
    PG8_BAR;
#undef PG8_SA
#undef PG8_SB
#undef PG8_STAGE
#undef PG8_LDA
#undef PG8_LDB
#undef PG8_MMA
#undef PG8_WAIT_V
#undef PG8_WAIT_L
#undef PG8_BAR
#undef PG8_SCHED
}
}
using pg8::Unit;

DI void store8(bf16_t* p, const float (&v)[8]) { u32x4 w = {pk2(v[0], v[1]), pk2(v[2], v[3]), pk2(v[4], v[5]), pk2(v[6], v[7])}; *(u32x4*)p = w; }
DI void rope8(float (&v)[8], const f32x2* cs) {
    const f32x4 c0 = *(const f32x4*)cs, c1 = *(const f32x4*)(cs + 2);
    const float co[4] = {c0[0], c0[2], c1[0], c1[2]}, si[4] = {c0[1], c0[3], c1[1], c1[3]};
#pragma unroll
    for (int k = 0; k < 4; ++k) { const float a = v[2 * k], b = v[2 * k + 1]; v[2 * k] = a * co[k] - b * si[k]; v[2 * k + 1] = a * si[k] + b * co[k]; }
}
DI float sumsq_fq(const float (&v)[8]) {
    float s = 0.f;
#pragma unroll
    for (int e = 0; e < 8; ++e) s += v[e] * v[e];
    s += __shfl_xor(s, 16); s += __shfl_xor(s, 32); return s;
}

template <class Impl> struct EpiWrap : Impl {
    static constexpr bool MID = false;
    DI void operator()(const f32x4 (&acc)[2][2][4][2], const Unit& u, int wr, int wc, int, int) const {
        const int t2 = my_tid(), fr = t2 & 15, fq = (t2 >> 4) & 3;
#pragma unroll
        for (int ai = 0; ai < 2; ++ai)
#pragma unroll
            for (int m = 0; m < 4; ++m)
#pragma unroll
                for (int bj = 0; bj < 2; ++bj) {
                    const f32x4 a0 = acc[ai][bj][m][0], a1 = acc[ai][bj][m][1];
                    float v[8] = {a0[0], a0[1], a0[2], a0[3], a1[0], a1[1], a1[2], a1[3]};
                    this->chunk(u.pm * 256 + ai * 128 + wr * 64 + m * 16 + fr, u.pn, bj * 128 + wc * 32 + 8 * fq, v);
                }
    }
};

#define WSP(T, off) ((T*)(ws + (off)))
struct EpiInImpl {
    unsigned char* ws;
    DI void chunk(int row, int pn, int cc, float (&v)[8]) const {
        const int pos = row & (S - 1), b = row >> 12;
        bf16_t* const QN = WSP(bf16_t, WS_QN); bf16_t* const KCV = WSP(bf16_t, WS_KCV); bf16_t* const CQ = WSP(bf16_t, WS_CQ); bf16_t* const T6 = WSP(bf16_t, WS_T6);
        bf16_t* const KPE = WSP(bf16_t, WS_KPE); float* const GN = WSP(float, WS_GN); float* const PQ = WSP(float, WS_PQ); float* const PKV = WSP(float, WS_PKV);
        const f32x2* const CS64 = WSP(const f32x2, WS_CS64); const f32x2* const CS32 = WSP(const f32x2, WS_CS32);
        if (pn < 2) {
            rope8(v, CS64 + pos * 32 + ((cc & 63) >> 1));
            store8(QN + (size_t)row * 512 + pn * 256 + cc, v);
        } else if (pn < 5) {
            const int kv = cc >> 7, g = (cc >> 6) & 1, p = cc & 63, bg = b * 2 + g;
            if (kv == 0) {
                rope8(v, CS64 + pos * 32 + (p >> 1));
                bf16_t* dst = WSP(bf16_t, pn == 2 ? WS_KCV : (pn == 3 ? WS_KS : WS_KW));
                store8(dst + ((size_t)bg * S + pos) * 64 + p, v);
            } else if (pn == 2) {
                store8(KCV + ((size_t)(16 + bg) * S + pos) * 64 + p, v);
            } else {
                bf16_t* dst = WSP(bf16_t, pn == 3 ? WS_VST : WS_VWT);
#pragma unroll
                for (int e = 0; e < 8; ++e) dst[((size_t)bg * 64 + p + e) * S + pos] = f2bf(v[e]);
            }
        } else if (pn == 5) {
            store8(CQ + (size_t)row * 256 + cc, v);
            const float s = sumsq_fq(v);
            if ((threadIdx.x & 48) == 0) PQ[(size_t)row * 8 + (cc >> 5)] = s;
        } else if (pn == 6) {
            store8(T6 + (size_t)row * 256 + cc, v);
            if (cc < 128) {
                const float s = sumsq_fq(v);
                if ((threadIdx.x & 48) == 0) PKV[(size_t)row * 4 + (cc >> 5)] = s;
            } else if (cc < 160) {
                rope8(v, CS32 + pos * 16 + ((cc - 128) >> 1));
                store8(KPE + (size_t)row * 32 + (cc - 128), v);
            } else if (cc < 184) {
#pragma unroll
                for (int e = 0; e < 8; ++e) GN[(size_t)row * 24 + (cc - 160) + e] = sigmoidf_(v[e]);
            }
        } else {
#pragma unroll
            for (int e = 0; e < 8; ++e) v[e] = sigmoidf_(v[e]);
            if (pn < 11) store8(WSP(bf16_t, WS_GA) + (size_t)row * 1024 + (pn - 7) * 256 + cc, v);
            else store8(WSP(bf16_t, WS_GB) + (size_t)row * 1024 + (pn - 11) * 256 + cc, v);
        }
    }
};
struct EpiC1Impl {
    unsigned char* ws;
    DI void chunk(int row, int pn, int cc, float (&v)[8]) const {
        bf16_t* const HC = WSP(bf16_t, WS_HC); const float* const CB1 = WSP(const float, WS_CB1);
        const f32x4 b0 = *(const f32x4*)(CB1 + pn * 256 + cc), b1 = *(const f32x4*)(CB1 + pn * 256 + cc + 4);
        const float bb[8] = {b0[0], b0[1], b0[2], b0[3], b1[0], b1[1], b1[2], b1[3]};
#pragma unroll
        for (int e = 0; e < 8; ++e) { const float x = v[e] + bb[e]; v[e] = x / (1.f + __expf(-x)); }
        store8(HC + (size_t)row * 256 + cc, v);
    }
};
struct EpiC2Impl {
    unsigned char* ws;
    DI void chunk(int row, int pn, int cc, float (&v)[8]) const {
        if (cc >= 64) return;
        bf16_t* const KCMP = WSP(bf16_t, WS_KCMP); bf16_t* const VCMPT = WSP(bf16_t, WS_VCMPT);
        const int bg = (row >> 8) & 15, n = row & 255;
        if (n == 255) {
#pragma unroll
            for (int e = 0; e < 8; ++e) v[e] = 0.f;
        }
        if (pn == 0) store8(KCMP + ((size_t)bg * 256 + n) * 64 + cc, v);
        else {
#pragma unroll
            for (int e = 0; e < 8; ++e) VCMPT[((size_t)bg * 64 + cc + e) * 256 + n] = f2bf(v[e]);
        }
    }
};
struct EpiUQImpl {
    unsigned char* ws;
    DI void chunk(int row, int pn, int cc, float (&v)[8]) const {
        bf16_t* const QM = WSP(bf16_t, WS_QM); const float* const PQ = WSP(const float, WS_PQ); const f32x2* const CS32 = WSP(const f32x2, WS_CS32);
        const int c = pn * 256 + cc, hh = c / 96, c96 = c - hh * 96, pos = row & (S - 1);
        const f32x4 p0 = *(const f32x4*)(PQ + (size_t)row * 8), p1 = *(const f32x4*)(PQ + (size_t)row * 8 + 4);
        const float rstd = rsqrtf((((p0[0] + p0[1]) + (p0[2] + p0[3])) + ((p1[0] + p1[1]) + (p1[2] + p1[3]))) * (1.f / 256.f) + EPS);
#pragma unroll
        for (int e = 0; e < 8; ++e) v[e] *= rstd;
        if (c96 >= 64) rope8(v, CS32 + pos * 16 + ((c96 - 64) >> 1));
        store8(QM + (size_t)row * 768 + c, v);
    }
};
struct EpiUKVImpl {
    unsigned char* ws;
    DI void chunk(int row, int pn, int cc, float (&v)[8]) const {
        bf16_t* const KM = WSP(bf16_t, WS_KM); bf16_t* const VMT = WSP(bf16_t, WS_VMT); const float* const PKV = WSP(const float, WS_PKV);
        const int c = pn * 256 + cc, hh = c >> 7, c128 = c & 127, pos = row & (S - 1), b = row >> 12;
        const f32x4 p0 = *(const f32x4*)(PKV + (size_t)row * 4);
        const float rstd = rsqrtf(((p0[0] + p0[1]) + (p0[2] + p0[3])) * (1.f / 128.f) + EPS);
#pragma unroll
        for (int e = 0; e < 8; ++e) v[e] *= rstd;
        if (c128 < 64) store8(KM + ((size_t)(b * 8 + hh) * S + pos) * 64 + c128, v);
        else {
#pragma unroll
            for (int e = 0; e < 8; ++e) VMT[((size_t)(b * 8 + hh) * 64 + (c128 - 64) + e) * S + pos] = f2bf(v[e]);
        }
    }
};
struct EpiD2Impl {
    const float* xin; float* X;
    DI void chunk(int row, int pn, int cc, float (&v)[8]) const {
        const size_t o = (size_t)row * 1024 + pn * 256 + cc;
        const f32x4 x0 = *(const f32x4*)(xin + o), x1 = *(const f32x4*)(xin + o + 4);
        *(f32x4*)(X + o) = (f32x4){x0[0] + v[0], x0[1] + v[1], x0[2] + v[2], x0[3] + v[3]};
        *(f32x4*)(X + o + 4) = (f32x4){x1[0] + v[4], x1[1] + v[5], x1[2] + v[6], x1[3] + v[7]};
    }
};
struct EpiUpImpl {
    unsigned char* ws;
    DI void chunk(int row, int pn, int cc, float (&v)[8]) const {
        bf16_t* const HF = WSP(bf16_t, WS_HF);
#pragma unroll
        for (int e = 0; e < 8; ++e) { const float r = fmaxf(v[e], 0.f); v[e] = r * r; }
        store8(HF + (size_t)row * FF + pn * 256 + cc, v);
    }
};
struct EpiD1aImpl {
    unsigned char* ws;
    DI void chunk(int row, int pn, int cc, float (&v)[8]) const {
        const size_t o = (size_t)row * 1024 + pn * 256 + cc;
        const u32x4 a = *(const u32x4*)(WSP(const bf16_t, WS_GA) + o);
        v[0] *= bflo(a[0]); v[1] *= bfhi(a[0]); v[2] *= bflo(a[1]); v[3] *= bfhi(a[1]); v[4] *= bflo(a[2]); v[5] *= bfhi(a[2]); v[6] *= bflo(a[3]); v[7] *= bfhi(a[3]);
        store8(WSP(bf16_t, WS_MG) + o, v);
    }
};
struct EpiD1bImpl {
    unsigned char* ws;
    DI void chunk(int row, int pn, int cc, float (&v)[8]) const {
        const size_t o = (size_t)row * 1024 + pn * 256 + cc;
        const u32x4 b = *(const u32x4*)(WSP(const bf16_t, WS_GB) + o), g = *(const u32x4*)(WSP(const bf16_t, WS_MG) + o);
        v[0] = bflo(g[0]) + v[0] * bflo(b[0]); v[1] = bfhi(g[0]) + v[1] * bfhi(b[0]); v[2] = bflo(g[1]) + v[2] * bflo(b[1]); v[3] = bfhi(g[1]) + v[3] * bfhi(b[1]);
        v[4] = bflo(g[2]) + v[4] * bflo(b[2]); v[5] = bfhi(g[2]) + v[5] * bfhi(b[2]); v[6] = bflo(g[3]) + v[6] * bflo(b[3]); v[7] = bfhi(g[3]) + v[7] * bfhi(b[3]);
        store8(WSP(bf16_t, WS_MG) + o, v);
    }
};

#define MFMA32(a, b, c) __builtin_amdgcn_mfma_f32_32x32x16_bf16((a), (b), (c), 0, 0, 0)

template <int DQK> DI void qk_tile(const LAS unsigned char* sK, const bf16x8 (&qf)[DQK / 16], f32x16 (&s)[2], int lane) {
    constexpr int KSTR = DQK * 2 + 16;
    const int r = lane & 31, h = lane >> 5;
    const int rp = (r & 0x13) | ((r & 4) << 1) | ((r & 8) >> 1);
#pragma unroll
    for (int kt = 0; kt < 2; ++kt) {
        f32x16 a;
#pragma unroll
        for (int i = 0; i < 16; ++i) a[i] = 0.f;
#pragma unroll
        for (int ks = 0; ks < DQK / 16; ++ks) {
            const bf16x8 kf = *(const LAS bf16x8*)(sK + (32 * kt + rp) * KSTR + ks * 32 + h * 16);
            a = MFMA32(kf, qf[ks], a);
        }
        s[kt] = a;
    }
}

template <bool LANEOFF> DI void pv_step(const f32x16 (&s)[2], const LAS unsigned char* sV, unsigned keep, f32x16 (&o)[2], int lane) {
    const int h = lane >> 5, r = lane & 31;
#pragma unroll
    for (int kt = 0; kt < 2; ++kt)
#pragma unroll
        for (int s2 = 0; s2 < 2; ++s2) {
            u32x4 pw = {pk2(s[kt][8 * s2 + 0], s[kt][8 * s2 + 1]), pk2(s[kt][8 * s2 + 2], s[kt][8 * s2 + 3]),
                        pk2(s[kt][8 * s2 + 4], s[kt][8 * s2 + 5]), pk2(s[kt][8 * s2 + 6], s[kt][8 * s2 + 7])};
            if constexpr (LANEOFF) { pw[0] &= keep; pw[1] &= keep; pw[2] &= keep; pw[3] &= keep; }
            const bf16x8 pb = __builtin_bit_cast(bf16x8, pw);
#pragma unroll
            for (int dt = 0; dt < 2; ++dt) {
                const bf16x8 va = *(const LAS bf16x8*)(sV + (32 * dt + r) * 144 + (32 * kt + 16 * s2 + 8 * h) * 2);
                o[dt] = MFMA32(va, pb, o[dt]);
            }
        }
}
template <class Mask> DI void softmax_masked(f32x16 (&s)[2], int tile, const Mask& mask, float c, float& m, float& l, f32x16 (&o)[2], int lane) {
    const int h = lane >> 5;
    float mx = -1e30f;
#pragma unroll
    for (int kt = 0; kt < 2; ++kt)
#pragma unroll
        for (int reg = 0; reg < 16; ++reg) {
            const int key = 32 * kt + (reg & 7) + 8 * h + 16 * (reg >> 3);
            const float x = mask(tile, key) ? s[kt][reg] : -1e30f;
            s[kt][reg] = x; mx = fmaxf(mx, x);
        }
    mx = fmaxf(mx, __shfl_xor(mx, 32));
    const float mn = fmaxf(m, mx), alpha = ex2((m - mn) * c), nmc = -mn * c;
    m = mn;
    float sum = 0.f;
#pragma unroll
    for (int kt = 0; kt < 2; ++kt)
#pragma unroll
        for (int reg = 0; reg < 16; ++reg) {
            const float x = s[kt][reg];
            const float p = (x > -5e29f) ? ex2(__builtin_fmaf(x, c, nmc)) : 0.f;
            s[kt][reg] = p; sum += p;
        }
    l = l * alpha + sum;
    o[0] *= alpha; o[1] *= alpha;
}
template <bool LANEOFF> DI void softmax_full(f32x16 (&s)[2], bool lane_on, float c, float& m, float& l, f32x16 (&o)[2]) {
    float mx0 = fmaxf(s[0][0], s[1][0]), mx1 = fmaxf(s[0][1], s[1][1]);
#pragma unroll
    for (int reg = 2; reg < 16; reg += 2) { mx0 = fmaxf(mx0, fmaxf(s[0][reg], s[1][reg])); mx1 = fmaxf(mx1, fmaxf(s[0][reg + 1], s[1][reg + 1])); }
    float mx = fmaxf(mx0, mx1);
    mx = fmaxf(mx, __shfl_xor(mx, 32));
    if constexpr (LANEOFF) mx = lane_on ? mx : -1e30f;
    const float mn = fmaxf(m, mx);
    if (__any(mn > m)) { const float alpha = ex2((m - mn) * c); l *= alpha; o[0] *= alpha; o[1] *= alpha; }
    m = mn;
    const float nmc = -mn * c;
    float sum0 = 0.f, sum1 = 0.f;
#pragma unroll
    for (int kt = 0; kt < 2; ++kt)
#pragma unroll
        for (int reg = 0; reg < 16; reg += 2) {
            const float p0 = ex2(__builtin_fmaf(s[kt][reg], c, nmc)), p1 = ex2(__builtin_fmaf(s[kt][reg + 1], c, nmc));
            s[kt][reg] = p0; s[kt][reg + 1] = p1; sum0 += p0; sum1 += p1;
        }
    float sum = sum0 + sum1;
    if constexpr (LANEOFF) sum = lane_on ? sum : 0.f;
    l += sum;
}

template <int DQK, bool LANEOFF, class TileOf, class Mask, class Skip>
DI void attn_run(LAS unsigned char* lds, const bf16_t* Kg, const bf16_t* Kpe, const bf16_t* Vg, int ldv, int ntiles,
                 const TileOf& tile_of, const Mask& mask, const Skip& skip, float c, const bf16x8 (&qf)[DQK / 16], float& m, float& l, f32x16 (&o)[2]) {
    constexpr int KSTR = DQK * 2 + 16;
    const int tid = my_tid(), lane = tid & 63;
    const int krow = tid >> 3, kch = tid & 7, prow = (tid >> 2) & 63, pch = tid & 3;
    u32x4 kreg = {0, 0, 0, 0}, vreg = {0, 0, 0, 0}, preg = {0, 0, 0, 0};
    __syncthreads();
    if (ntiles > 0) {
        const int t = tile_of(0);
        kreg = *(const u32x4*)(Kg + ((size_t)(t * 64 + krow)) * 64 + kch * 8);
        vreg = *(const u32x4*)(Vg + (size_t)krow * ldv + t * 64 + kch * 8);
        if constexpr (DQK == 96) { if (tid < 256) preg = *(const u32x4*)(Kpe + ((size_t)(t * 64 + prow)) * 32 + pch * 8); }
        *(LAS u32x4*)(lds + AT_K + krow * KSTR + kch * 16) = kreg;
        *(LAS u32x4*)(lds + AT_V + krow * 144 + kch * 16) = vreg;
        if constexpr (DQK == 96) { if (tid < 256) *(LAS u32x4*)(lds + AT_K + prow * KSTR + 128 + pch * 16) = preg; }
    }
    __syncthreads();
    for (int i = 0; i < ntiles; ++i) {
        const int t = tile_of(i);
        const int cb = (i & 1) * AT_BUF, nb = AT_BUF - cb;
        const bool more = i + 1 < ntiles;
        if (more) {
            const int t2 = tile_of(i + 1);
            kreg = *(const u32x4*)(Kg + ((size_t)(t2 * 64 + krow)) * 64 + kch * 8);
            vreg = *(const u32x4*)(Vg + (size_t)krow * ldv + t2 * 64 + kch * 8);
            if constexpr (DQK == 96) { if (tid < 256) preg = *(const u32x4*)(Kpe + ((size_t)(t2 * 64 + prow)) * 32 + pch * 8); }
        }
        if (!skip(t)) {
            f32x16 s[2];
            qk_tile<DQK>(lds + AT_K + cb, qf, s, lane);
            if (mask.full(t)) {
                const bool on = mask.lane_on(t);
                softmax_full<LANEOFF>(s, on, c, m, l, o);
                pv_step<LANEOFF>(s, lds + AT_V + cb, on ? 0xffffffffu : 0u, o, lane);
            } else {
                softmax_masked(s, t, mask, c, m, l, o, lane);
                pv_step<false>(s, lds + AT_V + cb, 0xffffffffu, o, lane);
            }
        }
        if (more) {
            *(LAS u32x4*)(lds + AT_K + nb + krow * KSTR + kch * 16) = kreg;
            *(LAS u32x4*)(lds + AT_V + nb + krow * 144 + kch * 16) = vreg;
            if constexpr (DQK == 96) { if (tid < 256) *(LAS u32x4*)(lds + AT_K + nb + prow * KSTR + 128 + pch * 16) = preg; }
        }
        __syncthreads();
    }
}

struct TileId { DI int operator()(int i) const { return i; } };
struct TileOff { int off; DI int operator()(int i) const { return off + i; } };
struct TileList { const LAS int* lst; DI int operator()(int i) const { return lst[i]; } };
struct NoSkip { DI bool operator()(int) const { return false; } };
struct SkipAbove { int tmax; DI bool operator()(int t) const { return t * 64 > tmax; } };
struct MaskCmp { int tq;
    DI bool operator()(int t, int key) const { return 16 * (64 * t + key) + 31 <= tq; }
    DI bool full(int) const { return false; } DI bool lane_on(int) const { return true; } };
struct MaskSlc { int tq; unsigned lo, hi; int qt;
    DI bool bit(int t) const { return ((t < 32 ? (lo >> t) : (hi >> (t - 32))) & 1u) != 0u; }
    DI bool operator()(int t, int key) const { return bit(t) && (64 * t + key <= tq); }
    DI bool full(int t) const { return t < qt; } DI bool lane_on(int t) const { return bit(t); } };
struct MaskWin { int tq, tq0w;
    DI bool operator()(int t, int key) const { const int d = tq - (64 * t + key); return d >= 0 && d < 512; }
    DI bool full(int t) const { return (64 * t + 63 <= tq0w) && (tq0w + 31 - 64 * t <= 511); } DI bool lane_on(int) const { return true; } };
struct MaskCausal { int tq, tq0w;
    DI bool operator()(int t, int key) const { return 64 * t + key <= tq; }
    DI bool full(int t) const { return 64 * t + 63 <= tq0w; } DI bool lane_on(int) const { return true; } };

struct Bufs {
    const bf16_t *QN, *KS, *KW, *VST, *VWT, *KCMP, *VCMPT, *QM, *KM, *KPE, *VMT; const float* GN; bf16_t* OAB;
};

DI void zero16(f32x16& v) {
#pragma unroll
    for (int i = 0; i < 16; ++i) v[i] = 0.f;
}

DI void nsa_unit(const Bufs& B, LAS unsigned char* lds, int b, int g, int qt) {
    const int tid = my_tid(), lane = tid & 63, w = __builtin_amdgcn_readfirstlane(tid >> 6), r = w >> 1, hh = lane >> 5;
    const int qs = (w & 1) * 32 + (lane & 31), bg = b * 2 + g, tq = qt * 64 + qs, head = g * 4 + r;
    const size_t row = (size_t)b * S + tq;
    LAS unsigned* sImp = (LAS unsigned*)(lds + AT_IMP);
    LAS unsigned* sSel = (LAS unsigned*)(lds + AT_SEL);
    LAS int* sList = (LAS int*)(lds + AT_LIST);
    LAS int* sCnt = (LAS int*)(lds + AT_CNT);
    bf16x8 qf[4];
#pragma unroll
    for (int ks = 0; ks < 4; ++ks) qf[ks] = *(const bf16x8*)(B.QN + row * 512 + head * 64 + ks * 16 + hh * 8);
    for (int i = tid; i < 4096; i += 512) sImp[i] = 0u;
    const float c = 0.125f * LOG2E;
    const f32x4 gt = {B.GN[row * 24 + head], B.GN[row * 24 + 8 + head], B.GN[row * 24 + 16 + head], 0.f};
    LAS float* stash = (LAS float*)(lds + AT_ACC + w * 8192) + lane;
    float m, l; f32x16 o[2];
    const int nct = (4 * qt + 2) / 64 + 1;
    m = -1e30f; l = 0.f; zero16(o[0]); zero16(o[1]);
    attn_run<64, false>(lds, B.KCMP + (size_t)bg * 256 * 64, nullptr, B.VCMPT + (size_t)bg * 64 * 256, 256, nct, TileId{}, MaskCmp{tq}, NoSkip{}, c, qf, m, l, o);
    const float nmc = -m * c;
    float inv;
    { const float lt = l + __shfl_xor(l, 32); inv = lt > 0.f ? 1.f / lt : 0.f; }
#pragma unroll
    for (int dt = 0; dt < 2; ++dt)
#pragma unroll
        for (int e = 0; e < 16; ++e) stash[(dt * 16 + e) * 64] = o[dt][e] * (inv * gt[0]);
    for (int ct = 0; ct < nct; ++ct) {
        __syncthreads();
        { const int krow = tid >> 3, kch = tid & 7;
          *(LAS u32x4*)(lds + AT_K + krow * 144 + kch * 16) = *(const u32x4*)(B.KCMP + ((size_t)bg * 256 + ct * 64 + krow) * 64 + kch * 8); }
        __syncthreads();
        f32x16 s[2];
        qk_tile<64>(lds + AT_K, qf, s, lane);
#pragma unroll
        for (int kt = 0; kt < 2; ++kt)
#pragma unroll
            for (int a = 0; a < 4; ++a) {
                float pv[4];
#pragma unroll
                for (int bb = 0; bb < 4; ++bb) {
                    const int reg = 4 * a + bb;
                    const int n = 64 * ct + 32 * kt + (reg & 7) + 8 * hh + 16 * (reg >> 3);
                    pv[bb] = (16 * n + 31 <= tq) ? ex2(__builtin_fmaf(s[kt][reg], c, nmc)) * inv : 0.f;
                }
                const int j = 16 * ct + 8 * kt + (a & 1) + 2 * hh + 4 * (a >> 1);
                const float carry = 0.5f * pv[3], direct = (pv[0] + pv[1]) + (pv[2] + carry);
                if (direct > 0.f) __hip_atomic_fetch_add(sImp + qs * 64 + j, (unsigned)(direct * 268435456.f + 0.5f), __ATOMIC_RELAXED, __HIP_MEMORY_SCOPE_WORKGROUP);
                if (carry > 0.f && j < 63) __hip_atomic_fetch_add(sImp + qs * 64 + j + 1, (unsigned)(carry * 268435456.f + 0.5f), __ATOMIC_RELAXED, __HIP_MEMORY_SCOPE_WORKGROUP);
            }
    }
    __syncthreads();
    {
        const int q = tid >> 3, sub = tid & 7;
        unsigned bits = 0;
        if (qt < 16) {
#pragma unroll
            for (int k = 0; k < 8; ++k) if (sub * 8 + k <= qt) bits |= 1u << k;
        } else {
            unsigned v[8]; int cnt[8];
#pragma unroll
            for (int k = 0; k < 8; ++k) { v[k] = sImp[q * 64 + sub * 8 + k]; cnt[k] = 0; }
            for (int jp = 1; jp <= qt - 2; ++jp) {
                const unsigned vp = sImp[q * 64 + jp];
#pragma unroll
                for (int k = 0; k < 8; ++k) cnt[k] += (vp > v[k] || (vp == v[k] && jp < sub * 8 + k)) ? 1 : 0;
            }
#pragma unroll
            for (int k = 0; k < 8; ++k) {
                const int j = sub * 8 + k;
                const bool forced = (j == 0) || (j == qt) || (j == qt - 1), cand = (j >= 1) && (j <= qt - 2);
                if (forced || (cand && cnt[k] < 13)) bits |= 1u << k;
            }
        }
        unsigned lo = sub < 4 ? bits << (sub * 8) : 0u, hi = sub >= 4 ? bits << ((sub - 4) * 8) : 0u;
        lo |= __shfl_xor(lo, 1); hi |= __shfl_xor(hi, 1); lo |= __shfl_xor(lo, 2); hi |= __shfl_xor(hi, 2); lo |= __shfl_xor(lo, 4); hi |= __shfl_xor(hi, 4);
        if (sub == 0) { sSel[q * 2] = lo; sSel[q * 2 + 1] = hi; }
    }
    __syncthreads();
    if (w == 0) {
        unsigned lo = sSel[lane * 2], hi = sSel[lane * 2 + 1];
#pragma unroll
        for (int x = 1; x < 64; x <<= 1) { lo |= __shfl_xor(lo, x); hi |= __shfl_xor(hi, x); }
        if (lane == 0) {
            int n = 0;
            for (int j = 0; j <= qt; ++j) { const unsigned bit = j < 32 ? (lo >> j) : (hi >> (j - 32)); if (bit & 1u) sList[n++] = j; }
            *sCnt = n;
        }
    }
    __syncthreads();
    {
        const int nsel = *sCnt;
        const unsigned lo = sSel[qs * 2], hi = sSel[qs * 2 + 1];
        m = -1e30f; l = 0.f; zero16(o[0]); zero16(o[1]);
        attn_run<64, true>(lds, B.KS + (size_t)bg * S * 64, nullptr, B.VST + (size_t)bg * 64 * S, S, nsel, TileList{sList}, MaskSlc{tq, lo, hi, qt}, NoSkip{}, c, qf, m, l, o);
        const float lt = l + __shfl_xor(l, 32); const float iv = (lt > 0.f ? 1.f / lt : 0.f) * gt[1];
#pragma unroll
        for (int dt = 0; dt < 2; ++dt)
#pragma unroll
            for (int e = 0; e < 16; ++e) stash[(dt * 16 + e) * 64] += o[dt][e] * iv;
    }
    {
        const int t0 = qt >= 8 ? qt - 8 : 0;
        m = -1e30f; l = 0.f; zero16(o[0]); zero16(o[1]);
        attn_run<64, false>(lds, B.KW + (size_t)bg * S * 64, nullptr, B.VWT + (size_t)bg * 64 * S, S, qt - t0 + 1, TileOff{t0}, MaskWin{tq, qt * 64 + (w & 1) * 32}, NoSkip{}, c, qf, m, l, o);
        const float lt = l + __shfl_xor(l, 32); const float iv = (lt > 0.f ? 1.f / lt : 0.f) * gt[2];
#pragma unroll
        for (int dt = 0; dt < 2; ++dt)
#pragma unroll
            for (int e = 0; e < 16; ++e) o[dt][e] = stash[(dt * 16 + e) * 64] + o[dt][e] * iv;
    }
    bf16_t* orow = B.OAB + row * 1024 + head * 64;
#pragma unroll
    for (int dt = 0; dt < 2; ++dt)
#pragma unroll
        for (int a = 0; a < 4; ++a) {
            u32x2 w2 = {pk2(o[dt][4 * a], o[dt][4 * a + 1]), pk2(o[dt][4 * a + 2], o[dt][4 * a + 3])};
            *(u32x2*)(orow + 32 * dt + 8 * a + 4 * hh) = w2;
        }
}

DI void mla_unit(const Bufs& B, LAS unsigned char* lds, int b, int h, int qb) {
    const int tid = my_tid(), lane = tid & 63, w = __builtin_amdgcn_readfirstlane(tid >> 6), hh = lane >> 5;
    const int tq = qb * 256 + w * 32 + (lane & 31);
    const size_t row = (size_t)b * S + tq;
    bf16x8 qf[6];
#pragma unroll
    for (int ks = 0; ks < 6; ++ks) qf[ks] = *(const bf16x8*)(B.QM + row * 768 + h * 96 + ks * 16 + hh * 8);
    const float c = 0.10206207261596575f * LOG2E;
    float m = -1e30f, l = 0.f; f32x16 o[2]; zero16(o[0]); zero16(o[1]);
    attn_run<96, false>(lds, B.KM + (size_t)(b * 8 + h) * S * 64, B.KPE + (size_t)b * S * 32, B.VMT + (size_t)(b * 8 + h) * 64 * S, S, 4 * (qb + 1),
                 TileId{}, MaskCausal{tq, qb * 256 + w * 32}, SkipAbove{qb * 256 + w * 32 + 31}, c, qf, m, l, o);
    const float lt = l + __shfl_xor(l, 32); const float iv = lt > 0.f ? 1.f / lt : 0.f;
    bf16_t* orow = B.OAB + row * 1024 + 512 + h * 64;
#pragma unroll
    for (int dt = 0; dt < 2; ++dt)
#pragma unroll
        for (int a = 0; a < 4; ++a) {
            u32x2 w2 = {pk2(o[dt][4 * a] * iv, o[dt][4 * a + 1] * iv), pk2(o[dt][4 * a + 2] * iv, o[dt][4 * a + 3] * iv)};
            *(u32x2*)(orow + 32 * dt + 8 * a + 4 * hh) = w2;
        }
}

DI void attn_phase(const Bufs& B, LAS unsigned char* lds, unsigned* counter) {
    LAS int* sUnit = (LAS int*)(lds + MISC_OFF); int it_ = 0; (void)sUnit; (void)it_; (void)counter;
    for (;;) {
#if ATT_STATIC
        __syncthreads();
        const int u = (int)blockIdx.x + 256 * it_; ++it_;
        if (u >= 2048) break;
#else
        __syncthreads();
        if (threadIdx.x == 0) *sUnit = (int)atomicAdd(counter, 1u);
        __syncthreads();
        const int u = *sUnit;
        if (u >= 2048) break;
#endif
        const int i = u >> 1;
        if ((u & 1) == 0) {
#if EXP_ATT == 2
            { const int b = (i & 63) >> 3, h = i & 7, qb = 15 - (i >> 6);
              for (int e = threadIdx.x; e < 2048; e += 512) *(u32x4*)(B.OAB + ((size_t)b * S + qb * 256 + (e >> 3)) * 1024 + 512 + h * 64 + (e & 7) * 8) = (u32x4){0x3c003c00u, 0x3c003c00u, 0x3c003c00u, 0x3c003c00u}; }
#else
            mla_unit(B, lds, (i & 63) >> 3, i & 7, 15 - (i >> 6));
#endif
        } else {
#if EXP_ATT == 1
            { const int b = (i & 15) >> 1, g = i & 1, qt = 63 - (i >> 4);
              for (int e = threadIdx.x; e < 2048; e += 512) *(u32x4*)(B.OAB + ((size_t)b * S + qt * 64 + (e >> 5)) * 1024 + g * 256 + (e & 31) * 8) = (u32x4){0x3c003c00u, 0x3c003c00u, 0x3c003c00u, 0x3c003c00u}; }
#else
            nsa_unit(B, lds, (i & 15) >> 1, i & 1, 63 - (i >> 4));
#endif
        }
    }
}

DI float wave_sum(float v) {
#pragma unroll
    for (int o = 1; o < 64; o <<= 1) v += __shfl_xor(v, o);
    return v;
}
DI void norm_rows_bf16(const float* x, const float* g, bf16_t* xn) {
    const int tid_ = my_tid(), lane = tid_ & 63, gw = blockIdx.x * 8 + (tid_ >> 6), ngw = gridDim.x * 8;
    f32x4 gv[4];
#pragma unroll
    for (int j = 0; j < 4; ++j) gv[j] = ((const f32x4*)g)[lane + 64 * j];
    for (int r = gw; r < M; r += ngw) {
        const f32x4* xr = (const f32x4*)(x + (size_t)r * D) + lane;
        f32x4 v[4]; float s = 0.f;
#pragma unroll
        for (int j = 0; j < 4; ++j) { v[j] = xr[64 * j]; s += (v[j][0] * v[j][0] + v[j][1] * v[j][1]) + (v[j][2] * v[j][2] + v[j][3] * v[j][3]); }
        const float rstd = rsqrtf(wave_sum(s) * (1.f / D) + EPS);
        u32x2* o8 = (u32x2*)(xn + (size_t)r * D) + lane;
#pragma unroll
        for (int j = 0; j < 4; ++j) o8[64 * j] = (u32x2){pk2(v[j][0] * rstd * gv[j][0], v[j][1] * rstd * gv[j][1]), pk2(v[j][2] * rstd * gv[j][2], v[j][3] * rstd * gv[j][3])};
    }
}
DI void norm_rows_f32_inplace(float* x, const float* g) {
    const int tid_ = my_tid(), lane = tid_ & 63, gw = blockIdx.x * 8 + (tid_ >> 6), ngw = gridDim.x * 8;
    f32x4 gv[4];
#pragma unroll
    for (int j = 0; j < 4; ++j) gv[j] = ((const f32x4*)g)[lane + 64 * j];
    for (int r = gw; r < M; r += ngw) {
        f32x4* xr = (f32x4*)(x + (size_t)r * D) + lane;
        f32x4 v[4]; float s = 0.f;
#pragma unroll
        for (int j = 0; j < 4; ++j) { v[j] = xr[64 * j]; s += (v[j][0] * v[j][0] + v[j][1] * v[j][1]) + (v[j][2] * v[j][2] + v[j][3] * v[j][3]); }
        const float rstd = rsqrtf(wave_sum(s) * (1.f / D) + EPS);
#pragma unroll
        for (int j = 0; j < 4; ++j) xr[64 * j] = (f32x4){v[j][0] * rstd * gv[j][0], v[j][1] * rstd * gv[j][1], v[j][2] * rstd * gv[j][2], v[j][3] * rstd * gv[j][3]};
    }
}

DI int perm64(int p) { return (p >> 1) + 32 * (p & 1); }
DI int perm32r(int p) { return (p >> 1) + 16 * (p & 1); }
DI int map_in(int c) {
    if (c < 512) return (c & ~63) + perm64(c & 63);
    if (c < 1280) { const int t = (c - 512) >> 8, cc = (c - 512) & 255, kv = cc >> 7, g = (cc >> 6) & 1, p = cc & 63; return 512 + t * 256 + kv * 128 + g * 64 + (kv == 0 ? perm64(p) : p); }
    if (c < 1536) return 1304 + (c - 1280);
    if (c < 1792) { const int cc = c - 1536; if (cc < 128) return 1560 + cc; if (cc < 160) return 1688 + perm32r(cc - 128); if (cc < 184) return 1280 + (cc - 160); return -1; }
    if (c < 2816) return 1720 + (c - 1792);
    return 2744 + (c - 2816);
}
struct Wts {
    const float *w_in, *cmp_pe, *cmp_w1, *cmp_w2, *nsa_w_o, *q_norm, *kv_norm, *w_uq, *w_ukv, *mla_w_o, *w_out, *w_up, *w_down;
};
template <int JOB> DI float prep_get(const Wts& W, int n, int k) {
    if constexpr (JOB == 0) { const int c = map_in(n); return c >= 0 ? W.w_in[(size_t)k * IN_COLS + c] : 0.f; }
    if constexpr (JOB == 1) { const int j = n >> 8, h = n & 255, lp = k >> 6, p = k & 63, d = j == 0 ? perm64(p) : p; return W.cmp_w1[((size_t)j * 2048 + lp * 64 + d) * 256 + h]; }
    if constexpr (JOB == 2) { const int j = n >> 8, np = n & 255; return np < 64 ? W.cmp_w2[((size_t)j * 256 + k) * 64 + (j == 0 ? perm64(np) : np)] : 0.f; }
    if constexpr (JOB == 3) { return n < 1024 ? W.nsa_w_o[(size_t)k * 1024 + n] : W.mla_w_o[(size_t)k * 1024 + (n - 1024)]; }
    if constexpr (JOB == 4) { const int hh = n / 96, c = n - hh * 96; const int sc = c < 64 ? n : hh * 96 + 64 + perm32r(c - 64); return W.q_norm[k] * W.w_uq[(size_t)k * 768 + sc]; }
    if constexpr (JOB == 5) { return k < 128 ? W.kv_norm[k] * W.w_ukv[(size_t)k * 1024 + n] : 0.f; }
    if constexpr (JOB == 6) { return W.w_out[(size_t)k * 1024 + n]; }
    if constexpr (JOB == 7) { return W.w_up[(size_t)k * 4096 + n]; }
    if constexpr (JOB == 8) { return W.w_down[(size_t)k * 1024 + n]; }
    return 0.f;
}
template <int JOB> DI void prep_tile(const Wts& W, LAS float* scr, bf16_t* dst, int ldd, int n0, int k0) {
    const int tid = my_tid();
#pragma unroll
    for (int it = 0; it < 8; ++it) { const int kk = it * 8 + (tid >> 6), nn = tid & 63; scr[kk * 65 + nn] = prep_get<JOB>(W, n0 + nn, k0 + kk); }
    __syncthreads();
    { const int n = tid >> 3, kc = tid & 7; const LAS float* s = scr + (kc * 8) * 65 + n;
      u32x4 o = {pk2(s[0], s[65]), pk2(s[130], s[195]), pk2(s[260], s[325]), pk2(s[390], s[455])};
      *(u32x4*)(dst + (size_t)(n0 + n) * ldd + k0 + kc * 8) = o; }
    __syncthreads();
}
DI void prep_phase(const Wts& W, unsigned char* ws, LAS unsigned char* lds, int layer) {
    LAS float* scr = (LAS float*)lds;
    const int tid = my_tid();
    constexpr int T0 = 960, T1 = T0 + 256, T2 = T1 + 32, T3 = T2 + 256, T4 = T3 + 48, T5 = T4 + 64, T6_ = T5 + 256, T7 = T6_ + 1024, T8 = T7 + 1024, TB = T8 + 8;
    for (int job = blockIdx.x; job < TB; job += gridDim.x) {
        int r = job;
        if (r < T0) { prep_tile<0>(W, scr, (bf16_t*)(ws + WS_WIN), 1024, (r >> 4) * 64, (r & 15) * 64); continue; }
        if (r < T1) { r -= T0; prep_tile<1>(W, scr, (bf16_t*)(ws + WS_W1T), 2048, (r >> 5) * 64, (r & 31) * 64); continue; }
        if (r < T2) { r -= T1; prep_tile<2>(W, scr, (bf16_t*)(ws + WS_W2T), 256, (r >> 2) * 64, (r & 3) * 64); continue; }
        if (r < T3) { r -= T2; prep_tile<3>(W, scr, (bf16_t*)(ws + WS_WOAB), 512, (r >> 3) * 64, (r & 7) * 64); continue; }
        if (r < T4) { r -= T3; prep_tile<4>(W, scr, (bf16_t*)(ws + WS_WUQ), 256, (r >> 2) * 64, (r & 3) * 64); continue; }
        if (r < T5) { r -= T4; prep_tile<5>(W, scr, (bf16_t*)(ws + WS_WUKV), 256, (r >> 2) * 64, (r & 3) * 64); continue; }
        if (r < T6_) { r -= T5; prep_tile<6>(W, scr, (bf16_t*)(ws + WS_WOUT), 1024, (r >> 4) * 64, (r & 15) * 64); continue; }
        if (r < T7) { r -= T6_; prep_tile<7>(W, scr, (bf16_t*)(ws + WS_WUP), 1024, (r >> 4) * 64, (r & 15) * 64); continue; }
        if (r < T8) { r -= T7; prep_tile<8>(W, scr, (bf16_t*)(ws + WS_WDN), 4096, (r >> 6) * 64, (r & 63) * 64); continue; }
        {
            r -= T8; const int j = r >> 2, hc = r & 3, kk = tid >> 6, hx = tid & 63, h = hc * 64 + hx;
            float a = 0.f;
            for (int i = 0; i < 256; ++i) { const int k = kk + 8 * i; a += W.cmp_pe[j * 2048 + k] * W.cmp_w1[((size_t)j * 2048 + k) * 256 + h]; }
            scr[kk * 64 + hx] = a;
            __syncthreads();
            if (tid < 64) { float s = 0.f; for (int q = 0; q < 8; ++q) s += scr[q * 64 + tid]; ((float*)(ws + WS_CB1))[j * 256 + hc * 64 + tid] = s; }
            __syncthreads();
        }
    }
    if (layer == 0) {
        f32x2* cs64 = (f32x2*)(ws + WS_CS64); f32x2* cs32 = (f32x2*)(ws + WS_CS32);
        for (int idx = blockIdx.x * 512 + tid; idx < S * 48; idx += gridDim.x * 512) {
            int pos, i; float inv;
            if (idx < S * 32) { pos = idx >> 5; i = idx & 31; inv = (float)exp2(-(double)i * (13.287712379549449 / 32.0)); }
            else { const int e = idx - S * 32; pos = e >> 4; i = e & 15; inv = (float)exp2(-(double)i * (13.287712379549449 / 16.0)); }
            const float ang = (float)pos * inv;
            const double rev = (double)ang * 0.15915494309189535; const float fr = (float)(rev - floor(rev));
            const f32x2 v = {__builtin_amdgcn_cosf(fr), __builtin_amdgcn_sinf(fr)};
            if (idx < S * 32) cs64[idx] = v; else cs32[idx - S * 32] = v;
        }
    }
}

struct Params { const float* in[17]; float* out; unsigned char* ws; int ph_lo, ph_hi; };
typedef const __attribute__((address_space(4))) unsigned char* kaptr_t;
DI const float* karg_ptr(int byte_off) { kaptr_t ka = (kaptr_t)__builtin_amdgcn_kernarg_segment_ptr(); asm volatile("" : "+s"(ka)); return *(const float* const __attribute__((address_space(4)))*)(ka + byte_off); }
#define KIN(i) karg_ptr(8 * (i))

DI void grid_barrier_cg(cg::grid_group& grid) {
    asm volatile("s_waitcnt vmcnt(0) lgkmcnt(0)" ::: "memory");
    __syncthreads();
    if (threadIdx.x < 64) asm volatile("buffer_wbl2 sc1\n\ts_waitcnt vmcnt(0)" ::: "memory");
    __syncthreads();
    grid.sync();
    asm volatile("buffer_inv sc1\n\ts_waitcnt vmcnt(0)" ::: "memory");
}

#define XB_TMO      128
#define XB_XCNT(j)  (256  + 64 * (j))
#define XB_XSUB(j)  (1280 + 64 * (j))
#define XB_XGEN(j)  (2304 + 64 * (j))
#define XB_TOP      3328
#define XB_TOPGEN   3392
#define XCD_BAR_WORDS 3456
#define XB_SPIN_CAP (1u << 18)
DI unsigned xb_ld(unsigned* p)              { return __hip_atomic_load(p, __ATOMIC_RELAXED, __HIP_MEMORY_SCOPE_AGENT); }
DI unsigned xb_add(unsigned* p, unsigned v) { return __hip_atomic_fetch_add(p, v, __ATOMIC_RELAXED, __HIP_MEMORY_SCOPE_AGENT); }
DI unsigned xb_xcc_id() { return (unsigned)__builtin_amdgcn_s_getreg((3 << 11) | 20) & 0xFu; }
#define XB_SPIN(cond, bar) do { unsigned _sp = 0; while (cond) { __builtin_amdgcn_s_sleep(1); \
    if ((++_sp & 255u) == 0u) { if (xb_ld(&(bar)[XB_TMO])) break; if (_sp > XB_SPIN_CAP) { atomicAdd(&(bar)[XB_TMO], 1u); break; } } } } while (0)
DI void xcd_barrier_complete(unsigned* bar, unsigned x, unsigned& nloc, unsigned& nx) {
    const unsigned G = gridDim.x * gridDim.y * gridDim.z;
    unsigned sum, cnt, mine, sp = 0u;
    for (;;) {
        sum = 0u; cnt = 0u; mine = 0u;
#pragma unroll
        for (unsigned j = 0; j < 16; ++j) { const unsigned c = xb_ld(&bar[XB_XCNT(j)]); sum += c; cnt += (c > 0u) ? 1u : 0u; mine = (j == x) ? c : mine; }
        if (sum == G) break;
        __builtin_amdgcn_s_sleep(1);
        if ((++sp & 255u) == 0u) { if (xb_ld(&bar[XB_TMO])) break; if (sp > XB_SPIN_CAP) { atomicAdd(&bar[XB_TMO], 1u); break; } }
    }
    nloc = mine > 0u ? mine : 1u; nx = cnt > 0u ? cnt : 1u;
}
DI void xcd_barrier(unsigned* bar, volatile LAS unsigned* st) {
    asm volatile("s_waitcnt vmcnt(0)" ::: "memory");
    __syncthreads();
    if (threadIdx.x == 0) {
        const unsigned x = xb_xcc_id();
        __builtin_amdgcn_s_waitcnt(0);
        unsigned nloc = st[0], nx = st[1];
        if (nloc == 0u) { xcd_barrier_complete(bar, x, nloc, nx); st[0] = nloc; st[1] = nx; }
        const unsigned old = xb_add(&bar[XB_XSUB(x)], 1u);
        const unsigned gen = old / nloc;
        if (old + 1u == (gen + 1u) * nloc) {
            __builtin_amdgcn_fence(__ATOMIC_RELEASE, "agent");
            asm volatile("s_waitcnt vmcnt(0)" ::: "memory");
            const unsigned og = xb_add(&bar[XB_TOP], 1u);
            const unsigned tg = og / nx;
            if (og + 1u == (tg + 1u) * nx) xb_add(&bar[XB_TOPGEN], 1u);
            else XB_SPIN(xb_ld(&bar[XB_TOPGEN]) == tg, bar);
            __builtin_amdgcn_fence(__ATOMIC_ACQUIRE, "agent");
            xb_add(&bar[XB_XGEN(x)], 1u);
            asm volatile("s_waitcnt vmcnt(0)" ::: "memory");
        } else {
            XB_SPIN(xb_ld(&bar[XB_XGEN(x)]) == gen, bar);
            __builtin_amdgcn_fence(__ATOMIC_ACQUIRE, "agent");
            asm volatile("s_waitcnt vmcnt(0)" ::: "memory");
        }
    }
    __syncthreads();
}
DI void grid_barrier(cg::grid_group& grid, LAS unsigned char* lds, bool first) {
    unsigned* bar = (unsigned*)((unsigned char*)karg_ptr(144) + WS_BAR);
    if (first) {
        grid_barrier_cg(grid);
        if (threadIdx.x == 0) (void)xb_add(&bar[XB_XCNT(xb_xcc_id())], 1u);
    } else {
        xcd_barrier(bar, (volatile LAS unsigned*)(lds + MISC_OFF + 64));
    }
}

#define PH_IN(k) (lo <= (k) && (k) < hi)
#define PH_SEAM(k) do { if (PH_IN(k) && PH_IN((k) + 1)) grid_barrier(grid, lds, (k) == lo); } while (0)
#define PH_ENV() int G = gridDim.x, bx = blockIdx.x; asm volatile("" : "+s"(G), "+s"(bx)); unsigned char* ws = (unsigned char*)karg_ptr(144); float* X = (float*)karg_ptr(136); \
                 const int tid = my_tid(); bf16_t* XN = (bf16_t*)(ws + WS_XN); (void)tid; (void)X; (void)XN; (void)G; (void)bx

template <int L> DI void run_layer(LAS unsigned char* lds, cg::grid_group& grid, int lo, int hi) {
    constexpr int P0 = 10 * L;
    if (PH_IN(P0 + 0)) for (int rep_ = 0; rep_ < (((DUP_MASK >> 0) & 1) ? 2 : 1); ++rep_) { if (rep_) grid_barrier(grid, lds, false);
        PH_ENV();
        Wts W;
        W.w_in = KIN(2) + (size_t)L * 1024 * IN_COLS; W.cmp_pe = KIN(3) + (size_t)L * 2 * 2048; W.cmp_w1 = KIN(4) + (size_t)L * 2 * 2048 * 256;
        W.cmp_w2 = KIN(5) + (size_t)L * 2 * 256 * 64; W.nsa_w_o = KIN(6) + (size_t)L * 512 * 1024; W.q_norm = KIN(7) + L * 256; W.kv_norm = KIN(8) + L * 128;
        W.w_uq = KIN(9) + (size_t)L * 256 * 768; W.w_ukv = KIN(10) + (size_t)L * 128 * 1024; W.mla_w_o = KIN(11) + (size_t)L * 512 * 1024;
        W.w_out = KIN(12) + (size_t)L * 1024 * 1024; W.w_up = KIN(14) + (size_t)L * 1024 * 4096; W.w_down = KIN(15) + (size_t)L * 4096 * 1024;
        prep_phase(W, ws, lds, L);
        unsigned* ctl = (unsigned*)(ws + WS_CTL);
        if (L == 0 && bx == 0 && tid < 2 * NL) atomicExch(ctl + tid * 64, 0u);
        norm_rows_bf16(L == 0 ? KIN(0) : X, KIN(1) + L * D, XN);
    }
    PH_SEAM(P0 + 0);
    if (PH_IN(P0 + 1)) for (int rep_ = 0; rep_ < (((DUP_MASK >> 1) & 1) ? 2 : 1); ++rep_) { if (rep_) grid_barrier(grid, lds, false);
        PH_ENV();
        pg8::Gemm g{XN, (const bf16_t*)(ws + WS_WIN), 1024, 1024}; pg8::StaticOrder So; So.init(M, NIN, G, bx);
        EpiWrap<EpiInImpl> E; E.ws = ws;
        pg8::gemm_phase(lds, g, So, E);
    }
    PH_SEAM(P0 + 1);
    if (PH_IN(P0 + 2)) for (int rep_ = 0; rep_ < (((DUP_MASK >> 2) & 1) ? 2 : 1); ++rep_) { if (rep_) grid_barrier(grid, lds, false);
        PH_ENV();
        { pg8::Gemm g{(const bf16_t*)(ws + WS_KCV), (const bf16_t*)(ws + WS_W1T), 1024, 2048}; pg8::CmpOrder So{G, bx};
          EpiWrap<EpiC1Impl> E; E.ws = ws;
          pg8::gemm_phase(lds, g, So, E); }
        const int crot = (bx + G - 32) % G;
        { pg8::Gemm g{(const bf16_t*)(ws + WS_CQ), (const bf16_t*)(ws + WS_WUQ), 256, 256}; pg8::StaticOrder So; So.init(M, 768, G, crot);
          EpiWrap<EpiUQImpl> E; E.ws = ws;
          pg8::gemm_phase(lds, g, So, E); }
        { pg8::Gemm g{(const bf16_t*)(ws + WS_T6), (const bf16_t*)(ws + WS_WUKV), 256, 256}; pg8::StaticOrder So; So.init(M, 1024, G, crot);
          EpiWrap<EpiUKVImpl> E; E.ws = ws;
          pg8::gemm_phase(lds, g, So, E); }
    }
    PH_SEAM(P0 + 2);
    if (PH_IN(P0 + 3)) for (int rep_ = 0; rep_ < (((DUP_MASK >> 3) & 1) ? 2 : 1); ++rep_) { if (rep_) grid_barrier(grid, lds, false);
        PH_ENV();
        pg8::Gemm g{(const bf16_t*)(ws + WS_HC), (const bf16_t*)(ws + WS_W2T), 256, 256}; pg8::CmpOrder So{G, bx};
        EpiWrap<EpiC2Impl> E; E.ws = ws;
        pg8::gemm_phase(lds, g, So, E);
    }
    PH_SEAM(P0 + 3);
    if (PH_IN(P0 + 4)) for (int rep_ = 0; rep_ < (((DUP_MASK >> 4) & 1) ? 2 : 1); ++rep_) { if (rep_) grid_barrier(grid, lds, false);
        PH_ENV();
        Bufs B; B.QN = (const bf16_t*)(ws + WS_QN); B.KS = (const bf16_t*)(ws + WS_KS); B.KW = (const bf16_t*)(ws + WS_KW); B.VST = (const bf16_t*)(ws + WS_VST);
        B.VWT = (const bf16_t*)(ws + WS_VWT); B.KCMP = (const bf16_t*)(ws + WS_KCMP); B.VCMPT = (const bf16_t*)(ws + WS_VCMPT); B.QM = (const bf16_t*)(ws + WS_QM);
        B.KM = (const bf16_t*)(ws + WS_KM); B.KPE = (const bf16_t*)(ws + WS_KPE); B.VMT = (const bf16_t*)(ws + WS_VMT); B.GN = (const float*)(ws + WS_GN); B.OAB = XN;
#if EXP_NOATTN
        { u32x4* o = (u32x4*)XN; for (size_t i = (size_t)bx * 512 + tid; i < (size_t)M * 1024 / 8; i += (size_t)G * 512) o[i] = (u32x4){0x3c003c00u, 0x3c003c00u, 0x3c003c00u, 0x3c003c00u}; (void)B; }
#else
        attn_phase(B, lds, (unsigned*)(ws + WS_CTL) + (L * 2 + rep_) * 64);
#endif
    }
    PH_SEAM(P0 + 4);
    if (PH_IN(P0 + 5)) for (int rep_ = 0; rep_ < (((DUP_MASK >> 5) & 1) ? 2 : 1); ++rep_) { if (rep_) grid_barrier(grid, lds, false);
        PH_ENV();
        pg8::StaticOrder So; So.init(M, 1024, G, bx);
        { pg8::Gemm g{XN, (const bf16_t*)(ws + WS_WOAB), 1024, 512}; EpiWrap<EpiD1aImpl> E; E.ws = ws; pg8::gemm_phase(lds, g, So, E); }
        { pg8::Gemm g{XN + 512, (const bf16_t*)(ws + WS_WOAB) + 1024 * 512, 1024, 512}; EpiWrap<EpiD1bImpl> E; E.ws = ws; pg8::gemm_phase(lds, g, So, E); }
    }
    PH_SEAM(P0 + 5);
    if (PH_IN(P0 + 6)) for (int rep_ = 0; rep_ < (((DUP_MASK >> 6) & 1) ? 2 : 1); ++rep_) { if (rep_) grid_barrier(grid, lds, false);
        PH_ENV();
        pg8::Gemm g{(const bf16_t*)(ws + WS_MG), (const bf16_t*)(ws + WS_WOUT), 1024, 1024}; pg8::StaticOrder So; So.init(M, 1024, G, bx);
        EpiWrap<EpiD2Impl> E; E.xin = (L == 0 ? KIN(0) : X); E.X = X;
        pg8::gemm_phase(lds, g, So, E);
    }
    PH_SEAM(P0 + 6);
    if (PH_IN(P0 + 7)) for (int rep_ = 0; rep_ < (((DUP_MASK >> 7) & 1) ? 2 : 1); ++rep_) { if (rep_) grid_barrier(grid, lds, false);
        PH_ENV();
        norm_rows_bf16(X, KIN(13) + L * D, XN);
    }
    PH_SEAM(P0 + 7);
    if (PH_IN(P0 + 8)) for (int rep_ = 0; rep_ < (((DUP_MASK >> 8) & 1) ? 2 : 1); ++rep_) { if (rep_) grid_barrier(grid, lds, false);
        PH_ENV();
        pg8::Gemm g{XN, (const bf16_t*)(ws + WS_WUP), 1024, 1024}; pg8::StaticOrder So; So.init(M, FF, G, bx);
        EpiWrap<EpiUpImpl> E; E.ws = ws;
        pg8::gemm_phase(lds, g, So, E);
    }
    PH_SEAM(P0 + 8);
    if (PH_IN(P0 + 9)) for (int rep_ = 0; rep_ < (((DUP_MASK >> 9) & 1) ? 2 : 1); ++rep_) { if (rep_) grid_barrier(grid, lds, false);
        PH_ENV();
        pg8::Gemm g{(const bf16_t*)(ws + WS_HF), (const bf16_t*)(ws + WS_WDN), 4096, 4096}; pg8::StaticOrder So; So.init(M, 1024, G, bx);
        EpiWrap<EpiD2Impl> E; E.xin = X; E.X = X;
        pg8::gemm_phase(lds, g, So, E);
    }
    PH_SEAM(P0 + 9);
}

__global__ void __launch_bounds__(512, 2) mega(Params P) {
    extern __shared__ __attribute__((aligned(16))) unsigned char lds_raw[];
    LAS unsigned char* lds = (LAS unsigned char*)lds_raw;
    cg::grid_group grid = cg::this_grid();
    const int lo = P.ph_lo, hi = P.ph_hi;
    if (threadIdx.x < 2) ((volatile LAS unsigned*)(lds + MISC_OFF + 64))[threadIdx.x] = 0u;
    if (blockIdx.x == 0 && hi - lo > 1) { unsigned* bar = (unsigned*)((unsigned char*)karg_ptr(144) + WS_BAR);
        for (int i = threadIdx.x; i < XCD_BAR_WORDS; i += 512) __hip_atomic_store(bar + i, 0u, __ATOMIC_RELAXED, __HIP_MEMORY_SCOPE_AGENT); }
    __syncthreads();
    run_layer<0>(lds, grid, lo, hi);
    run_layer<1>(lds, grid, lo, hi);
    run_layer<2>(lds, grid, lo, hi);
    run_layer<3>(lds, grid, lo, hi);
    if (PH_IN(39) && PH_IN(40)) {   }
    if (PH_IN(40)) { float* X = (float*)karg_ptr(136); norm_rows_f32_inplace(X, KIN(16)); }
}

extern "C" void kernel_launch(void* const* d_in, const int* in_sizes, int n_in, void* d_out, int out_size, void* d_ws, size_t ws_size, hipStream_t stream) {
    static int grid = 0;
    if (grid == 0) {
        if (n_in != 17 || out_size != M * D || ws_size < WS_END) { fprintf(stderr, "kernel_launch: unexpected shapes (n_in %d out %d ws %zu)\n", n_in, out_size, ws_size); grid = -1; return; }
        int dev = 0, cus = 0, per_cu = 0;
        hipGetDevice(&dev);
        hipDeviceGetAttribute(&cus, hipDeviceAttributeMultiprocessorCount, dev);
        if (hipFuncSetAttribute((const void*)mega, hipFuncAttributeMaxDynamicSharedMemorySize, LDS_BYTES) != hipSuccess) { fprintf(stderr, "kernel_launch: hipFuncSetAttribute failed\n"); grid = -1; return; }
        if (hipOccupancyMaxActiveBlocksPerMultiprocessor(&per_cu, (const void*)mega, 512, LDS_BYTES) != hipSuccess || per_cu < 1) { fprintf(stderr, "kernel_launch: occupancy query gave %d\n", per_cu); per_cu = 1; }
        (void)hipGetLastError();
        grid = cus * per_cu;
    }
    if (grid < 0) return;
    Params p{};
    for (int i = 0; i < 17; ++i) p.in[i] = (const float*)d_in[i];
    p.out = (float*)d_out; p.ws = (unsigned char*)d_ws;
#if MK_MULTI
    for (int ph = 0; ph <= 40; ++ph) {
        p.ph_lo = ph; p.ph_hi = ph + 1;
        hipLaunchKernelGGL(mega, dim3(grid), dim3(512), LDS_BYTES, stream, p);
    }
#else
    p.ph_lo = 0; p.ph_hi = 41;
    void* args[] = {&p};
    hipError_t e = hipLaunchCooperativeKernel((const void*)mega, dim3(grid), dim3(512), args, LDS_BYTES, stream);
    if (e != hipSuccess) fprintf(stderr, "kernel_launch: cooperative launch failed: %s (grid %d)\n", hipGetErrorString(e), grid);
#endif
}
```

```cpp
#include <hip/hip_runtime.h>
#include <hip/hip_cooperative_groups.h>
#include <cstdio>
#include <cstdint>
namespace cg = cooperative_groups;

#ifndef EXP_NOATTN
#define EXP_NOATTN 0
#endif
#ifndef ATT_STATIC
#define ATT_STATIC 0
#endif
#ifndef EXP_ATT
#define EXP_ATT 0
#endif
#ifndef DUP_MASK
#define DUP_MASK 0
#endif
#ifndef ATT_DUP
#define ATT_DUP 0
#endif
#ifndef STAG_CMP
#define STAG_CMP false
#define STAG_SLC false
#define STAG_WIN true
#define STAG_MLA true
#endif
#ifndef MK_MULTI
#define MK_MULTI 0
#endif

#define LAS __attribute__((address_space(3)))
#define DI __device__ __forceinline__
typedef unsigned short bf16_t;
typedef short bf16x8 __attribute__((ext_vector_type(8)));
typedef float f32x4 __attribute__((ext_vector_type(4)));
typedef float f32x2 __attribute__((ext_vector_type(2)));
typedef float f32x16 __attribute__((ext_vector_type(16)));
typedef unsigned u32x4 __attribute__((ext_vector_type(4)));
typedef unsigned u32x2 __attribute__((ext_vector_type(2)));
typedef __bf16 bf16v2 __attribute__((ext_vector_type(2)));

DI unsigned pk2(float lo, float hi) { f32x2 v = {lo, hi}; return __builtin_bit_cast(unsigned, __builtin_convertvector(v, bf16v2)); }
DI bf16_t f2bf(float x) { return (bf16_t)(pk2(x, 0.f) & 0xffffu); }
DI float bflo(unsigned w) { return __uint_as_float(w << 16); }
DI float bfhi(unsigned w) { return __uint_as_float(w & 0xffff0000u); }
DI float sigmoidf_(float x) { return 1.f / (1.f + __expf(-x)); }
DI float ex2(float x) { return __builtin_amdgcn_exp2f(x); }
DI int my_tid() { int t = threadIdx.x; asm volatile("" : "+v"(t)); return t; }

constexpr int NB = 8, S = 4096, D = 1024, NL = 4, M = NB * S, FF = 4096;
constexpr int NIN = 3840;
constexpr int IN_COLS = 3768;
constexpr float EPS = 1e-6f;
constexpr float LOG2E = 1.4426950408889634f;

constexpr size_t MiB = 1u << 20;
constexpr size_t WS_CTL = 0;
constexpr size_t WS_BAR = 16384;
constexpr size_t WS_CB1 = 4096;
constexpr size_t WS_RSQ = 65536;
constexpr size_t WS_RSKV = 65536 + 131072;
constexpr size_t WS_CS64 = 1 * MiB;
constexpr size_t WS_CS32 = 2 * MiB;
constexpr size_t WS_WIN = 3 * MiB;
constexpr size_t WS_W1T = WS_WIN + (size_t)NIN * 1024 * 2;
constexpr size_t WS_W2T = WS_W1T + 2 * MiB;
constexpr size_t WS_WOAB = WS_W2T + 256 * 1024;
constexpr size_t WS_WUQ = WS_WOAB + 2 * MiB;
constexpr size_t WS_WUKV = WS_WUQ + 384 * 1024;
constexpr size_t WS_WOUT = 16 * MiB;
constexpr size_t WS_WUP = 18 * MiB;
constexpr size_t WS_WDN = 26 * MiB;
constexpr size_t WS_XN = 34 * MiB;
constexpr size_t WS_GA = 98 * MiB;
constexpr size_t WS_GB = 162 * MiB;
constexpr size_t WS_QN = 226 * MiB;
constexpr size_t WS_KCV = 258 * MiB;
constexpr size_t WS_KS = 274 * MiB, WS_KW = 282 * MiB, WS_VST = 290 * MiB, WS_VWT = 298 * MiB;
constexpr size_t WS_CQ = 306 * MiB, WS_T6 = 322 * MiB, WS_KPE = 338 * MiB, WS_GN = 340 * MiB;
constexpr size_t WS_QM = 343 * MiB, WS_KM = 391 * MiB, WS_VMT = 423 * MiB, WS_HC = 455 * MiB;
constexpr size_t WS_KCMP = 459 * MiB, WS_VCMPT = WS_KCMP + 512 * 1024;
constexpr size_t WS_MG = 226 * MiB;
constexpr size_t WS_HF = 98 * MiB;
constexpr size_t WS_PQ = 460 * MiB;
constexpr size_t WS_PKV = 461 * MiB;
constexpr size_t WS_END = 462 * MiB;
static_assert(WS_WUKV + 512 * 1024 <= WS_WOUT, "ws map");

constexpr int LDS_BYTES = 147456;
constexpr int MISC_OFF = 147200;
constexpr int AT_K = 0, AT_KB = 13312  , AT_V = 26624, AT_VB = 9216  , AT_IMP = 54272, AT_SEL = 70656, AT_LIST = 71168, AT_CNT = 71424, AT_ACC = 71680;

namespace pg8 {
constexpr int BM = 256, BK = 64, HALF = 128, HTB = HALF * BK * 2, NXCD = 8, WGM = 8;
__host__ __device__ __forceinline__ int lds_byte(int r, int c) { const int st = (r >> 4) * 2 + (c >> 5), rr = r & 15, cc = c & 31, ob = rr * 64 + cc * 2; return st * 1024 + (ob ^ (((ob >> 9) & 1) << 5)); }
__host__ __device__ __forceinline__ void stage_rc(int b, int& R, int& C) { const int st = b / 1024, sb = b % 1024, swz = sb ^ (((sb >> 9) & 1) << 5); R = (st >> 1) * 16 + swz / 64; C = (st & 1) * 32 + (swz % 64) / 2; }
__host__ __device__ __forceinline__ int perm32(int rho) { const int n = rho >> 4, i = rho & 15; return 8 * (i >> 2) + 4 * n + (i & 3); }

struct Unit { int pm, pn; };
struct Gemm { const bf16_t* A; const bf16_t* Bt; int lda; int K; };

struct StaticOrder {
    int nM, nN, nwg, G, c;
    __device__ void init(int M_, int N_, int G_, int c_) { nM = M_ / BM; nN = N_ / BM; nwg = nM * nN; G = G_; c = c_; }
    __device__ bool next(int i, Unit& u) const {
        const long L = (long)i * G + c; if (L >= nwg) return false;
        int wgid = (int)L; { const int q = nwg / NXCD, r = nwg % NXCD, xcd = wgid % NXCD, off = wgid / NXCD; wgid = (xcd < r ? xcd * (q + 1) : r * (q + 1) + (xcd - r) * q) + off; }
        const int nig = WGM * nN, gid = wgid / nig, fm = gid * WGM, gsz = (nM - fm) < WGM ? (nM - fm) : WGM;
        u.pm = fm + ((wgid % nig) % gsz); u.pn = (wgid % nig) / gsz; return true;
    }
};
struct CmpOrder {
    int G, c;
    __device__ bool next(int i, Unit& u) const { const int L = i * G + c; if (L >= 32) return false; u.pm = L; u.pn = L >> 4; return true; }
};

template <class Epi, class Sched>
__device__ __forceinline__ void gemm_phase(LAS unsigned char* lds, const Gemm g, const Sched& S, const Epi& E) {
    const int tid = my_tid(), wid = __builtin_amdgcn_readfirstlane(tid >> 6), lane = tid & 63, wr = wid >> 2, wc = wid & 3, fr = lane & 15, fq = lane >> 4;
    const int K = g.K, nt = K / BK, lda = g.lda;
    unsigned voffA, voffB;
    { int R, C; stage_rc(tid * 16, R, C); const int Rb = (R & ~31) + perm32(R & 31);
        voffA = (unsigned)(R * lda + C) * 2u; voffB = (unsigned)(Rb * K + C) * 2u; }
    const size_t qvoffA = (size_t)64 * lda * 2, qvoffB = (size_t)64 * K * 2;
    const size_t kstep = (size_t)(BK * 2);
    const size_t hstepA = (size_t)HALF * lda * 2, hstepB = (size_t)HALF * K * 2;
    const size_t tstepA = 2 * hstepA, tstepB = 2 * hstepB;
    const unsigned ldsw = (unsigned)wid * 1024u;
    const int aoff = lds_byte(wr * 64 + fr, fq * 8), boff = lds_byte(wc * 32 + fr, fq * 8);
#define PG8_SA(b, h) (((b) * 2 + (h)) * HTB)
#define PG8_SB(b, h) ((4 + (b) * 2 + (h)) * HTB)
#define PG8_STAGE(bufoff, gbase, voff) do { _Pragma("unroll") for (int _i = 0; _i < 2; ++_i) \
        __builtin_amdgcn_global_load_lds((const unsigned*)((const char*)(gbase) + (size_t)_i * q##voff + (voff)), (LAS unsigned*)(lds + (bufoff) + ldsw + _i * 8192), 16, 0, 0); } while (0)
#define PG8_LDA(dst, b, h) do { _Pragma("unroll") for (int m = 0; m < 4; ++m) _Pragma("unroll") for (int k = 0; k < 2; ++k) dst[m][k] = *(const LAS bf16x8*)(lds + PG8_SA(b, h) + aoff + m * 2048 + k * 1024); } while (0)
#define PG8_LDB(dst, b, h) do { _Pragma("unroll") for (int n = 0; n < 2; ++n) _Pragma("unroll") for (int k = 0; k < 2; ++k) dst[n][k] = *(const LAS bf16x8*)(lds + PG8_SB(b, h) + boff + n * 2048 + k * 1024); } while (0)
#define PG8_MMA(ai, bj, At, Bt) do { __builtin_amdgcn_s_setprio(1); _Pragma("unroll") for (int m = 0; m < 4; ++m) _Pragma("unroll") for (int n = 0; n < 2; ++n) _Pragma("unroll") for (int k = 0; k < 2; ++k) \
        acc[ai][bj][m][n] = __builtin_amdgcn_mfma_f32_16x16x32_bf16(Bt[n][k], At[m][k], acc[ai][bj][m][n], 0, 0, 0); __builtin_amdgcn_s_setprio(0); } while (0)
#define PG8_WAIT_V(n) asm volatile("s_waitcnt vmcnt(" #n ")" ::: "memory")
#define PG8_WAIT_L(n) asm volatile("s_waitcnt lgkmcnt(" #n ")" ::: "memory")
#define PG8_BAR __builtin_amdgcn_s_barrier()
#define PG8_SCHED __builtin_amdgcn_sched_barrier(0)
    Unit cur, nxt; int ui = 0;
    if (!S.next(0, cur)) return;
    f32x4 acc[2][2][4][2];
#pragma unroll
    for (int a = 0; a < 2; ++a)
#pragma unroll
        for (int b = 0; b < 2; ++b)
#pragma unroll
            for (int m = 0; m < 4; ++m)
#pragma unroll
                for (int n = 0; n < 2; ++n) acc[a][b][m][n] = (f32x4){0.f, 0.f, 0.f, 0.f};
    bf16x8 At[4][2], B0[2][2], B1[2][2];
    const char* cA = (const char*)g.A + (size_t)cur.pm * tstepA; const char* cB = (const char*)g.Bt + (size_t)cur.pn * tstepB;
    PG8_STAGE(PG8_SB(0, 0), cB, voffB); PG8_STAGE(PG8_SB(0, 1), cB + hstepB, voffB); PG8_STAGE(PG8_SA(0, 0), cA, voffA); PG8_STAGE(PG8_SA(0, 1), cA + hstepA, voffA);
    if (wr == 1) PG8_BAR;
    PG8_WAIT_V(2); PG8_BAR;
    PG8_STAGE(PG8_SB(1, 0), cB + kstep, voffB); PG8_STAGE(PG8_SA(1, 0), cA + kstep, voffA); PG8_STAGE(PG8_SB(1, 1), cB + hstepB + kstep, voffB);
    PG8_WAIT_V(6); PG8_BAR;
    for (;;) {
        const bool has_next = S.next(ui + 1, nxt);
        const char* nA = has_next ? (const char*)g.A + (size_t)nxt.pm * tstepA : cA; const char* nB = has_next ? (const char*)g.Bt + (size_t)nxt.pn * tstepB : cB;
        for (int t = 0; t < nt; t += 2) {
            const bool last = (t == nt - 2);
            const char* a1 = cA + (size_t)(t + 1) * kstep;
            const char* a2 = last ? nA : cA + (size_t)(t + 2) * kstep; const char* b2 = last ? nB : cB + (size_t)(t + 2) * kstep;
            const char* a3 = a2 + kstep; const char* b3 = b2 + kstep;
            PG8_LDB(B0, 0, 0); PG8_LDB(B1, 0, 1); PG8_SCHED; PG8_LDA(At, 0, 0); PG8_STAGE(PG8_SA(1, 1), a1 + hstepA, voffA);
            PG8_WAIT_V(8); PG8_WAIT_L(0); PG8_BAR; PG8_MMA(0, 0, At, B0); PG8_MMA(0, 1, At, B1); PG8_BAR; PG8_SCHED;
            PG8_LDA(At, 0, 1); PG8_STAGE(PG8_SB(0, 0), b2, voffB); PG8_STAGE(PG8_SB(0, 1), b2 + hstepB, voffB); PG8_STAGE(PG8_SA(0, 0), a2, voffA);
            PG8_WAIT_V(8); PG8_WAIT_L(0); PG8_BAR; PG8_MMA(1, 0, At, B0); PG8_MMA(1, 1, At, B1); PG8_BAR; PG8_SCHED;
            PG8_LDB(B0, 1, 0); PG8_LDB(B1, 1, 1); PG8_SCHED; PG8_LDA(At, 1, 0); PG8_STAGE(PG8_SA(0, 1), a2 + hstepA, voffA);
            PG8_WAIT_V(8); PG8_WAIT_L(0); PG8_BAR; PG8_MMA(0, 0, At, B0); PG8_MMA(0, 1, At, B1); PG8_BAR; PG8_SCHED;
            PG8_LDA(At, 1, 1); PG8_STAGE(PG8_SB(1, 0), b3, voffB); PG8_STAGE(PG8_SB(1, 1), b3 + hstepB, voffB); PG8_STAGE(PG8_SA(1, 0), a3, voffA);
            PG8_WAIT_V(8); PG8_WAIT_L(0); PG8_BAR; PG8_MMA(1, 0, At, B0); PG8_MMA(1, 1, At, B1); PG8_BAR; PG8_SCHED;
        }
        if (wr == 0) PG8_BAR;
        E(acc, cur, wr, wc, fr, fq);
        if (!has_next) break;
#pragma unroll
        for (int a = 0; a < 2; ++a)
#pragma unroll
            for (int b = 0; b < 2; ++b)
#pragma unroll
                for (int m = 0; m < 4; ++m)
#pragma unroll
                    for (int n = 0; n < 2; ++n) acc[a][b][m][n] = (f32x4){0.f, 0.f, 0.f, 0.f};
        cur = nxt; cA = nA; cB = nB; ++ui;
        if (wr == 1) PG8_BAR;
    }
    PG8_WAIT_V(0);
    PG8_BAR;
#undef PG8_SA
#undef PG8_SB
#undef PG8_STAGE
#undef PG8_LDA
#undef PG8_LDB
#undef PG8_MMA
#undef PG8_WAIT_V
#undef PG8_WAIT_L
#undef PG8_BAR
#undef PG8_SCHED
}
}
using pg8::Unit;

DI void store8(bf16_t* p, const float (&v)[8]) { u32x4 w = {pk2(v[0], v[1]), pk2(v[2], v[3]), pk2(v[4], v[5]), pk2(v[6], v[7])}; *(u32x4*)p = w; }
DI void rope8(float (&v)[8], const f32x2* cs) {
    const f32x4 c0 = *(const f32x4*)cs, c1 = *(const f32x4*)(cs + 2);
    const float co[4] = {c0[0], c0[2], c1[0], c1[2]}, si[4] = {c0[1], c0[3], c1[1], c1[3]};
#pragma unroll
    for (int k = 0; k < 4; ++k) { const float a = v[2 * k], b = v[2 * k + 1]; v[2 * k] = a * co[k] - b * si[k]; v[2 * k + 1] = a * si[k] + b * co[k]; }
}
DI float sumsq_fq(const float (&v)[8]) {
    float s = 0.f;
#pragma unroll
    for (int e = 0; e < 8; ++e) s += v[e] * v[e];
    s += __shfl_xor(s, 16); s += __shfl_xor(s, 32); return s;
}

template <class Impl> struct EpiWrap : Impl {
    static constexpr bool MID = false;
    DI void operator()(const f32x4 (&acc)[2][2][4][2], const Unit& u, int wr, int wc, int, int) const {
        const int t2 = my_tid(), fr = t2 & 15, fq = (t2 >> 4) & 3;
#pragma unroll
        for (int ai = 0; ai < 2; ++ai)
#pragma unroll
            for (int m = 0; m < 4; ++m)
#pragma unroll
                for (int bj = 0; bj < 2; ++bj) {
                    const f32x4 a0 = acc[ai][bj][m][0], a1 = acc[ai][bj][m][1];
                    float v[8] = {a0[0], a0[1], a0[2], a0[3], a1[0], a1[1], a1[2], a1[3]};
                    this->chunk(u.pm * 256 + ai * 128 + wr * 64 + m * 16 + fr, u.pn, bj * 128 + wc * 32 + 8 * fq, v);
                }
    }
};

#define WSP(T, off) ((T*)(ws + (off)))
struct EpiInImpl {
    unsigned char* ws;
    DI void chunk(int row, int pn, int cc, float (&v)[8]) const {
        const int pos = row & (S - 1), b = row >> 12;
        bf16_t* const QN = WSP(bf16_t, WS_QN); bf16_t* const KCV = WSP(bf16_t, WS_KCV); bf16_t* const CQ = WSP(bf16_t, WS_CQ); bf16_t* const T6 = WSP(bf16_t, WS_T6);
        bf16_t* const KPE = WSP(bf16_t, WS_KPE); float* const GN = WSP(float, WS_GN); float* const PQ = WSP(float, WS_PQ); float* const PKV = WSP(float, WS_PKV);
        const f32x2* const CS64 = WSP(const f32x2, WS_CS64); const f32x2* const CS32 = WSP(const f32x2, WS_CS32);
        if (pn < 2) {
            rope8(v, CS64 + pos * 32 + ((cc & 63) >> 1));
            store8(QN + (size_t)row * 512 + pn * 256 + cc, v);
        } else if (pn < 5) {
            const int kv = cc >> 7, g = (cc >> 6) & 1, p = cc & 63, bg = b * 2 + g;
            if (kv == 0) {
                rope8(v, CS64 + pos * 32 + (p >> 1));
                bf16_t* dst = WSP(bf16_t, pn == 2 ? WS_KCV : (pn == 3 ? WS_KS : WS_KW));
                store8(dst + ((size_t)bg * S + pos) * 64 + p, v);
            } else if (pn == 2) {
                store8(KCV + ((size_t)(16 + bg) * S + pos) * 64 + p, v);
            } else {
                bf16_t* dst = WSP(bf16_t, pn == 3 ? WS_VST : WS_VWT);
#pragma unroll
                for (int e = 0; e < 8; ++e) dst[((size_t)bg * 64 + p + e) * S + pos] = f2bf(v[e]);
            }
        } else if (pn == 5) {
            store8(CQ + (size_t)row * 256 + cc, v);
            const float s = sumsq_fq(v);
            if ((threadIdx.x & 48) == 0) PQ[(size_t)row * 8 + (cc >> 5)] = s;
        } else if (pn == 6) {
            store8(T6 + (size_t)row * 256 + cc, v);
            if (cc < 128) {
                const float s = sumsq_fq(v);
                if ((threadIdx.x & 48) == 0) PKV[(size_t)row * 4 + (cc >> 5)] = s;
            } else if (cc < 160) {
                rope8(v, CS32 + pos * 16 + ((cc - 128) >> 1));
                store8(KPE + (size_t)row * 32 + (cc - 128), v);
            } else if (cc < 184) {
#pragma unroll
                for (int e = 0; e < 8; ++e) GN[(size_t)row * 24 + (cc - 160) + e] = sigmoidf_(v[e]);
            }
        } else {
#pragma unroll
            for (int e = 0; e < 8; ++e) v[e] = sigmoidf_(v[e]);
            if (pn < 11) store8(WSP(bf16_t, WS_GA) + (size_t)row * 1024 + (pn - 7) * 256 + cc, v);
            else store8(WSP(bf16_t, WS_GB) + (size_t)row * 1024 + (pn - 11) * 256 + cc, v);
        }
    }
};
struct EpiC1Impl {
    unsigned char* ws;
    DI void chunk(int row, int pn, int cc, float (&v)[8]) const {
        bf16_t* const HC = WSP(bf16_t, WS_HC); const float* const CB1 = WSP(const float, WS_CB1);
        const f32x4 b0 = *(const f32x4*)(CB1 + pn * 256 + cc), b1 = *(const f32x4*)(CB1 + pn * 256 + cc + 4);
        const float bb[8] = {b0[0], b0[1], b0[2], b0[3], b1[0], b1[1], b1[2], b1[3]};
#pragma unroll
        for (int e = 0; e < 8; ++e) { const float x = v[e] + bb[e]; v[e] = x / (1.f + __expf(-x)); }
        store8(HC + (size_t)row * 256 + cc, v);
    }
};
struct EpiC2Impl {
    unsigned char* ws;
    DI void chunk(int row, int pn, int cc, float (&v)[8]) const {
        if (cc >= 64) return;
        bf16_t* const KCMP = WSP(bf16_t, WS_KCMP); bf16_t* const VCMPT = WSP(bf16_t, WS_VCMPT);
        const int bg = (row >> 8) & 15, n = row & 255;
        if (n == 255) {
#pragma unroll
            for (int e = 0; e < 8; ++e) v[e] = 0.f;
        }
        if (pn == 0) store8(KCMP + ((size_t)bg * 256 + n) * 64 + cc, v);
        else {
#pragma unroll
            for (int e = 0; e < 8; ++e) VCMPT[((size_t)bg * 64 + cc + e) * 256 + n] = f2bf(v[e]);
        }
    }
};
struct EpiUQImpl {
    unsigned char* ws;
    DI void chunk(int row, int pn, int cc, float (&v)[8]) const {
        bf16_t* const QM = WSP(bf16_t, WS_QM); const float* const PQ = WSP(const float, WS_PQ); const f32x2* const CS32 = WSP(const f32x2, WS_CS32);
        const int c = pn * 256 + cc, hh = c / 96, c96 = c - hh * 96, pos = row & (S - 1);
        const f32x4 p0 = *(const f32x4*)(PQ + (size_t)row * 8), p1 = *(const f32x4*)(PQ + (size_t)row * 8 + 4);
        const float rstd = rsqrtf((((p0[0] + p0[1]) + (p0[2] + p0[3])) + ((p1[0] + p1[1]) + (p1[2] + p1[3]))) * (1.f / 256.f) + EPS);
#pragma unroll
        for (int e = 0; e < 8; ++e) v[e] *= rstd;
        if (c96 >= 64) rope8(v, CS32 + pos * 16 + ((c96 - 64) >> 1));
        store8(QM + (size_t)row * 768 + c, v);
    }
};
struct EpiUKVImpl {
    unsigned char* ws;
    DI void chunk(int row, int pn, int cc, float (&v)[8]) const {
        bf16_t* const KM = WSP(bf16_t, WS_KM); bf16_t* const VMT = WSP(bf16_t, WS_VMT); const float* const PKV = WSP(const float, WS_PKV);
        const int c = pn * 256 + cc, hh = c >> 7, c128 = c & 127, pos = row & (S - 1), b = row >> 12;
        const f32x4 p0 = *(const f32x4*)(PKV + (size_t)row * 4);
        const float rstd = rsqrtf(((p0[0] + p0[1]) + (p0[2] + p0[3])) * (1.f / 128.f) + EPS);
#pragma unroll
        for (int e = 0; e < 8; ++e) v[e] *= rstd;
        if (c128 < 64) store8(KM + ((size_t)(b * 8 + hh) * S + pos) * 64 + c128, v);
        else {
#pragma unroll
            for (int e = 0; e < 8; ++e) VMT[((size_t)(b * 8 + hh) * 64 + (c128 - 64) + e) * S + pos] = f2bf(v[e]);
        }
    }
};
struct EpiD2Impl {
    const float* xin; float* X;
    DI void chunk(int row, int pn, int cc, float (&v)[8]) const {
        const size_t o = (size_t)row * 1024 + pn * 256 + cc;
        const f32x4 x0 = *(const f32x4*)(xin + o), x1 = *(const f32x4*)(xin + o + 4);
        *(f32x4*)(X + o) = (f32x4){x0[0] + v[0], x0[1] + v[1], x0[2] + v[2], x0[3] + v[3]};
        *(f32x4*)(X + o + 4) = (f32x4){x1[0] + v[4], x1[1] + v[5], x1[2] + v[6], x1[3] + v[7]};
    }
};
struct EpiUpImpl {
    unsigned char* ws;
    DI void chunk(int row, int pn, int cc, float (&v)[8]) const {
        bf16_t* const HF = WSP(bf16_t, WS_HF);
#pragma unroll
        for (int e = 0; e < 8; ++e) { const float r = fmaxf(v[e], 0.f); v[e] = r * r; }
        store8(HF + (size_t)row * FF + pn * 256 + cc, v);
    }
};
struct EpiD1aImpl {
    unsigned char* ws;
    DI void chunk(int row, int pn, int cc, float (&v)[8]) const {
        const size_t o = (size_t)row * 1024 + pn * 256 + cc;
        const u32x4 a = *(const u32x4*)(WSP(const bf16_t, WS_GA) + o);
        v[0] *= bflo(a[0]); v[1] *= bfhi(a[0]); v[2] *= bflo(a[1]); v[3] *= bfhi(a[1]); v[4] *= bflo(a[2]); v[5] *= bfhi(a[2]); v[6] *= bflo(a[3]); v[7] *= bfhi(a[3]);
        store8(WSP(bf16_t, WS_MG) + o, v);
    }
};
struct EpiD1bImpl {
    unsigned char* ws;
    DI void chunk(int row, int pn, int cc, float (&v)[8]) const {
        const size_t o = (size_t)row * 1024 + pn * 256 + cc;
        const u32x4 b = *(const u32x4*)(WSP(const bf16_t, WS_GB) + o), g = *(const u32x4*)(WSP(const bf16_t, WS_MG) + o);
        v[0] = bflo(g[0]) + v[0] * bflo(b[0]); v[1] = bfhi(g[0]) + v[1] * bfhi(b[0]); v[2] = bflo(g[1]) + v[2] * bflo(b[1]); v[3] = bfhi(g[1]) + v[3] * bfhi(b[1]);
        v[4] = bflo(g[2]) + v[4] * bflo(b[2]); v[5] = bfhi(g[2]) + v[5] * bfhi(b[2]); v[6] = bflo(g[3]) + v[6] * bflo(b[3]); v[7] = bfhi(g[3]) + v[7] * bfhi(b[3]);
        store8(WSP(bf16_t, WS_MG) + o, v);
    }
};

#define MFMA32(a, b, c) __builtin_amdgcn_mfma_f32_32x32x16_bf16((a), (b), (c), 0, 0, 0)

template <int DQK> DI void qk_tile(const LAS unsigned char* sK, const bf16x8 (&qf)[DQK / 16], f32x16 (&s)[2], int lane) {
    constexpr int KSTR = DQK * 2 + 16;
    const int r = lane & 31, h = lane >> 5;
    const int rp = (r & 0x13) | ((r & 4) << 1) | ((r & 8) >> 1);
    bf16x8 kf[2][DQK / 16];
#pragma unroll
    for (int kt = 0; kt < 2; ++kt)
#pragma unroll
        for (int ks = 0; ks < DQK / 16; ++ks) kf[kt][ks] = *(const LAS bf16x8*)(sK + (32 * kt + rp) * KSTR + ks * 32 + h * 16);
    __builtin_amdgcn_sched_barrier(0);
    __builtin_amdgcn_s_setprio(1);
#pragma unroll
    for (int kt = 0; kt < 2; ++kt) {
        f32x16 a;
#pragma unroll
        for (int i = 0; i < 16; ++i) a[i] = 0.f;
#pragma unroll
        for (int ks = 0; ks < DQK / 16; ++ks) a = MFMA32(kf[kt][ks], qf[ks], a);
        s[kt] = a;
    }
    __builtin_amdgcn_s_setprio(0);
}
DI void v_load(bf16x8 (&vf)[2][2][2], const LAS unsigned char* sV, int lane) {
    const int h = lane >> 5, r = lane & 31;
#pragma unroll
    for (int kt = 0; kt < 2; ++kt)
#pragma unroll
        for (int s2 = 0; s2 < 2; ++s2)
#pragma unroll
            for (int dt = 0; dt < 2; ++dt) vf[kt][s2][dt] = *(const LAS bf16x8*)(sV + (32 * dt + r) * 144 + (32 * kt + 16 * s2 + 8 * h) * 2);
}

template <bool LANEOFF> DI void pack_p(const f32x16 (&s)[2], unsigned keep, u32x4 (&pp)[4]) {
#pragma unroll
    for (int kt = 0; kt < 2; ++kt)
#pragma unroll
        for (int s2 = 0; s2 < 2; ++s2) {
            u32x4 pw = {pk2(s[kt][8 * s2 + 0], s[kt][8 * s2 + 1]), pk2(s[kt][8 * s2 + 2], s[kt][8 * s2 + 3]),
                        pk2(s[kt][8 * s2 + 4], s[kt][8 * s2 + 5]), pk2(s[kt][8 * s2 + 6], s[kt][8 * s2 + 7])};
            if constexpr (LANEOFF) { pw[0] &= keep; pw[1] &= keep; pw[2] &= keep; pw[3] &= keep; }
            pp[kt * 2 + s2] = pw;
        }
}
DI void pv_packed(const u32x4 (&pp)[4], const bf16x8 (&vf)[2][2][2], f32x16 (&o)[2]) {
    __builtin_amdgcn_s_setprio(1);
#pragma unroll
    for (int kt = 0; kt < 2; ++kt)
#pragma unroll
        for (int s2 = 0; s2 < 2; ++s2) {
            const bf16x8 pb = __builtin_bit_cast(bf16x8, pp[kt * 2 + s2]);
#pragma unroll
            for (int dt = 0; dt < 2; ++dt) o[dt] = MFMA32(vf[kt][s2][dt], pb, o[dt]);
        }
    __builtin_amdgcn_s_setprio(0);
}
template <class Mask> DI void softmax_masked(f32x16 (&s)[2], int tile, const Mask& mask, float c, float& m, float& l, f32x16 (&o)[2], int lane) {
    const int h = lane >> 5;
    float mx = -1e30f;
#pragma unroll
    for (int kt = 0; kt < 2; ++kt)
#pragma unroll
        for (int reg = 0; reg < 16; ++reg) {
            const int key = 32 * kt + (reg & 7) + 8 * h + 16 * (reg >> 3);
            const float x = mask(tile, key) ? s[kt][reg] : -1e30f;
            s[kt][reg] = x; mx = fmaxf(mx, x);
        }
    mx = fmaxf(mx, __shfl_xor(mx, 32));
    const float mn = fmaxf(m, mx), alpha = ex2((m - mn) * c), nmc = -mn * c;
    m = mn;
    float sum = 0.f;
#pragma unroll
    for (int kt = 0; kt < 2; ++kt)
#pragma unroll
        for (int reg = 0; reg < 16; ++reg) {
            const float x = s[kt][reg];
            const float p = (x > -5e29f) ? ex2(__builtin_fmaf(x, c, nmc)) : 0.f;
            s[kt][reg] = p; sum += p;
        }
    l = l * alpha + sum;
    o[0] *= alpha; o[1] *= alpha;
}
template <bool LANEOFF> DI void softmax_full(f32x16 (&s)[2], bool lane_on, float c, float& m, float& l, f32x16 (&o)[2]) {
    float mx0 = fmaxf(s[0][0], s[1][0]), mx1 = fmaxf(s[0][1], s[1][1]);
#pragma unroll
    for (int reg = 2; reg < 16; reg += 2) { mx0 = fmaxf(mx0, fmaxf(s[0][reg], s[1][reg])); mx1 = fmaxf(mx1, fmaxf(s[0][reg + 1], s[1][reg + 1])); }
    float mx = fmaxf(mx0, mx1);
    mx = fmaxf(mx, __shfl_xor(mx, 32));
    if constexpr (LANEOFF) mx = lane_on ? mx : -1e30f;
    const float mn = fmaxf(m, mx);
    if (__any(mn > m)) { const float alpha = ex2((m - mn) * c); l *= alpha; o[0] *= alpha; o[1] *= alpha; }
    m = mn;
    const float nmc = -mn * c;
    float sum0 = 0.f, sum1 = 0.f;
#pragma unroll
    for (int kt = 0; kt < 2; ++kt)
#pragma unroll
        for (int reg = 0; reg < 16; reg += 2) {
            const float p0 = ex2(__builtin_fmaf(s[kt][reg], c, nmc)), p1 = ex2(__builtin_fmaf(s[kt][reg + 1], c, nmc));
            s[kt][reg] = p0; s[kt][reg + 1] = p1; sum0 += p0; sum1 += p1;
        }
    float sum = sum0 + sum1;
    if constexpr (LANEOFF) sum = lane_on ? sum : 0.f;
    l += sum;
}

struct TileRegs { u32x4 k, v, p; };
template <int DQK, bool LANEOFF, bool STAG, class TileOf, class Mask, class Skip>
DI void attn_run(LAS unsigned char* lds, const bf16_t* Kg, const bf16_t* Kpe, const bf16_t* Vg, int ldv, int ntiles,
                 const TileOf& tile_of, const Mask& mask, const Skip& skip, float c, const bf16x8 (&qf)[DQK / 16], float& m, float& l, f32x16 (&o)[2]) {
    constexpr int KSTR = DQK * 2 + 16;
    const int tid = my_tid(), lane = tid & 63;
    const int krow = tid >> 3, kch = tid & 7, prow = (tid >> 2) & 63, pch = tid & 3;
    TileRegs RA, RB;
    asm volatile("" : "=v"(RA.k), "=v"(RA.v), "=v"(RA.p), "=v"(RB.k), "=v"(RB.v), "=v"(RB.p));
#define ATT_LOAD(R, tt) do { const int t_ = (tt); (R).k = *(const u32x4*)(Kg + ((size_t)(t_ * 64 + krow)) * 64 + kch * 8); (R).v = *(const u32x4*)(Vg + (size_t)krow * ldv + t_ * 64 + kch * 8); \
        if constexpr (DQK == 96) { if (tid < 256) (R).p = *(const u32x4*)(Kpe + ((size_t)(t_ * 64 + prow)) * 32 + pch * 8); } } while (0)
#define ATT_WRITE(R, kb_, vb_) do { *(LAS u32x4*)(lds + AT_K + (kb_) + krow * KSTR + kch * 16) = (R).k; *(LAS u32x4*)(lds + AT_V + (vb_) + krow * 144 + kch * 16) = (R).v; \
        if constexpr (DQK == 96) { if (tid < 256) *(LAS u32x4*)(lds + AT_K + (kb_) + prow * KSTR + 128 + pch * 16) = (R).p; } } while (0)
#define ATT_ITER(i_, RL, RW) do { const int t = tile_of(i_); const int kb = ((i_) & 1) * AT_KB, vb = ((i_) & 1) * AT_VB; \
        if ((i_) + 2 < ntiles) ATT_LOAD(RL, tile_of((i_) + 2)); \
        if (!skip(t)) { \
            f32x16 s[2]; \
            qk_tile<DQK>(lds + AT_K + kb, qf, s, lane); \
            bf16x8 vf[2][2][2]; v_load(vf, lds + AT_V + vb, lane); \
            unsigned keep = 0xffffffffu; \
            if (mask.full(t)) { const bool on = mask.lane_on(t); softmax_full<LANEOFF>(s, on, c, m, l, o); if constexpr (LANEOFF) keep = on ? 0xffffffffu : 0u; } \
            else softmax_masked(s, t, mask, c, m, l, o, lane); \
            u32x4 pp[4]; pack_p<LANEOFF>(s, keep, pp); pv_packed(pp, vf, o); \
        } \
        if ((i_) + 1 < ntiles) ATT_WRITE(RW, AT_KB - kb, AT_VB - vb); \
        __syncthreads(); } while (0)
    __syncthreads();
    if (ntiles > 0) { ATT_LOAD(RA, tile_of(0)); ATT_WRITE(RA, 0, 0); }
    if (ntiles > 1) ATT_LOAD(RB, tile_of(1));
    __syncthreads();
    for (int i = 0; i < ntiles; i += 2) {
        ATT_ITER(i, RA, RB);
        if (i + 1 < ntiles) ATT_ITER(i + 1, RB, RA);
    }
#undef ATT_LOAD
#undef ATT_WRITE
#undef ATT_ITER
}

struct TileId { DI int operator()(int i) const { return i; } };
struct TileOff { int off; DI int operator()(int i) const { return off + i; } };
struct TileList { const LAS int* lst; DI int operator()(int i) const { return lst[i]; } };
struct NoSkip { DI bool operator()(int) const { return false; } };
struct SkipAbove { int tmax; DI bool operator()(int t) const { return t * 64 > tmax; } };
struct MaskCmp { int tq;
    DI bool operator()(int t, int key) const { return 16 * (64 * t + key) + 31 <= tq; }
    DI bool full(int) const { return false; } DI bool lane_on(int) const { return true; } };
struct MaskSlc { int tq; unsigned lo, hi; int qt;
    DI bool bit(int t) const { return ((t < 32 ? (lo >> t) : (hi >> (t - 32))) & 1u) != 0u; }
    DI bool operator()(int t, int key) const { return bit(t) && (64 * t + key <= tq); }
    DI bool full(int t) const { return t < qt; } DI bool lane_on(int t) const { return bit(t); } };
struct MaskWin { int tq, tq0w;
    DI bool operator()(int t, int key) const { const int d = tq - (64 * t + key); return d >= 0 && d < 512; }
    DI bool full(int t) const { return (64 * t + 63 <= tq0w) && (tq0w + 31 - 64 * t <= 511); } DI bool lane_on(int) const { return true; } };
struct MaskCausal { int tq, tq0w;
    DI bool operator()(int t, int key) const { return 64 * t + key <= tq; }
    DI bool full(int t) const { return 64 * t + 63 <= tq0w; } DI bool lane_on(int) const { return true; } };

struct Bufs {
    const bf16_t *QN, *KS, *KW, *VST, *VWT, *KCMP, *VCMPT, *QM, *KM, *KPE, *VMT; const float* GN; bf16_t* OAB;
};

DI void zero16(f32x16& v) {
#pragma unroll
    for (int i = 0; i < 16; ++i) v[i] = 0.f;
}

DI void nsa_unit(const Bufs& B, LAS unsigned char* lds, int b, int g, int qt) {
    const int tid = my_tid(), lane = tid & 63, w = __builtin_amdgcn_readfirstlane(tid >> 6), r = w >> 1, hh = lane >> 5;
    const int qs = (w & 1) * 32 + (lane & 31), bg = b * 2 + g, tq = qt * 64 + qs, head = g * 4 + r;
    const size_t row = (size_t)b * S + tq;
    LAS unsigned* sImp = (LAS unsigned*)(lds + AT_IMP);
    LAS unsigned* sSel = (LAS unsigned*)(lds + AT_SEL);
    LAS int* sList = (LAS int*)(lds + AT_LIST);
    LAS int* sCnt = (LAS int*)(lds + AT_CNT);
    bf16x8 qf[4];
#pragma unroll
    for (int ks = 0; ks < 4; ++ks) qf[ks] = *(const bf16x8*)(B.QN + row * 512 + head * 64 + ks * 16 + hh * 8);
    for (int i = tid; i < 4096; i += 512) sImp[i] = 0u;
    const float c = 0.125f * LOG2E;
    LAS float* stash = (LAS float*)(lds + AT_ACC + w * 8192) + lane;
    float m, l; f32x16 o[2];
    const int nct = (4 * qt + 2) / 64 + 1;
    m = -1e30f; l = 0.f; zero16(o[0]); zero16(o[1]);
    attn_run<64, false, STAG_CMP>(lds, B.KCMP + (size_t)bg * 256 * 64, nullptr, B.VCMPT + (size_t)bg * 64 * 256, 256, nct, TileId{}, MaskCmp{tq}, NoSkip{}, c, qf, m, l, o);
    const float nmc = -m * c;
    float inv;
    { const float lt = l + __shfl_xor(l, 32); inv = lt > 0.f ? 1.f / lt : 0.f; }
    { const float ig0 = inv * B.GN[row * 24 + head];
#pragma unroll
    for (int dt = 0; dt < 2; ++dt)
#pragma unroll
        for (int e = 0; e < 16; ++e) stash[(dt * 16 + e) * 64] = o[dt][e] * ig0; }
    for (int ct = 0; ct < nct; ++ct) {
        __syncthreads();
        { const int krow = tid >> 3, kch = tid & 7;
          *(LAS u32x4*)(lds + AT_K + krow * 144 + kch * 16) = *(const u32x4*)(B.KCMP + ((size_t)bg * 256 + ct * 64 + krow) * 64 + kch * 8); }
        __syncthreads();
        f32x16 s[2];
        qk_tile<64>(lds + AT_K, qf, s, lane);
#pragma unroll
        for (int kt = 0; kt < 2; ++kt)
#pragma unroll
            for (int a = 0; a < 4; ++a) {
                float pv[4];
#pragma unroll
                for (int bb = 0; bb < 4; ++bb) {
                    const int reg = 4 * a + bb;
                    const int n = 64 * ct + 32 * kt + (reg & 7) + 8 * hh + 16 * (reg >> 3);
                    pv[bb] = (16 * n + 31 <= tq) ? ex2(__builtin_fmaf(s[kt][reg], c, nmc)) * inv : 0.f;
                }
                const int j = 16 * ct + 8 * kt + (a & 1) + 2 * hh + 4 * (a >> 1);
                const float carry = 0.5f * pv[3], direct = (pv[0] + pv[1]) + (pv[2] + carry);
                if (direct > 0.f) __hip_atomic_fetch_add(sImp + qs * 64 + j, (unsigned)(direct * 268435456.f + 0.5f), __ATOMIC_RELAXED, __HIP_MEMORY_SCOPE_WORKGROUP);
                if (carry > 0.f && j < 63) __hip_atomic_fetch_add(sImp + qs * 64 + j + 1, (unsigned)(carry * 268435456.f + 0.5f), __ATOMIC_RELAXED, __HIP_MEMORY_SCOPE_WORKGROUP);
            }
    }
    __syncthreads();
    {
        const int q = tid >> 3, sub = tid & 7;
        unsigned bits = 0;
        if (qt < 16) {
#pragma unroll
            for (int k = 0; k < 8; ++k) if (sub * 8 + k <= qt) bits |= 1u << k;
        } else {
            unsigned v[8]; int cnt[8];
#pragma unroll
            for (int k = 0; k < 8; ++k) { v[k] = sImp[q * 64 + sub * 8 + k]; cnt[k] = 0; }
            for (int jp = 1; jp <= qt - 2; ++jp) {
                const unsigned vp = sImp[q * 64 + jp];
#pragma unroll
                for (int k = 0; k < 8; ++k) cnt[k] += (vp > v[k] || (vp == v[k] && jp < sub * 8 + k)) ? 1 : 0;
            }
#pragma unroll
            for (int k = 0; k < 8; ++k) {
                const int j = sub * 8 + k;
                const bool forced = (j == 0) || (j == qt) || (j == qt - 1), cand = (j >= 1) && (j <= qt - 2);
                if (forced || (cand && cnt[k] < 13)) bits |= 1u << k;
            }
        }
        unsigned lo = sub < 4 ? bits << (sub * 8) : 0u, hi = sub >= 4 ? bits << ((sub - 4) * 8) : 0u;
        lo |= __shfl_xor(lo, 1); hi |= __shfl_xor(hi, 1); lo |= __shfl_xor(lo, 2); hi |= __shfl_xor(hi, 2); lo |= __shfl_xor(lo, 4); hi |= __shfl_xor(hi, 4);
        if (sub == 0) { sSel[q * 2] = lo; sSel[q * 2 + 1] = hi; }
    }
    __syncthreads();
    if (w == 0) {
        unsigned lo = sSel[lane * 2], hi = sSel[lane * 2 + 1];
#pragma unroll
        for (int x = 1; x < 64; x <<= 1) { lo |= __shfl_xor(lo, x); hi |= __shfl_xor(hi, x); }
        if (lane == 0) {
            int n = 0;
            for (int j = 0; j <= qt; ++j) { const unsigned bit = j < 32 ? (lo >> j) : (hi >> (j - 32)); if (bit & 1u) sList[n++] = j; }
            *sCnt = n;
        }
    }
    __syncthreads();
    {
        const int nsel = *sCnt;
        const unsigned lo = sSel[qs * 2], hi = sSel[qs * 2 + 1];
        m = -1e30f; l = 0.f; zero16(o[0]); zero16(o[1]);
        attn_run<64, true, STAG_SLC>(lds, B.KS + (size_t)bg * S * 64, nullptr, B.VST + (size_t)bg * 64 * S, S, nsel, TileList{sList}, MaskSlc{tq, lo, hi, qt}, NoSkip{}, c, qf, m, l, o);
        const float lt = l + __shfl_xor(l, 32); const float iv = (lt > 0.f ? 1.f / lt : 0.f) * B.GN[row * 24 + 8 + head];
#pragma unroll
        for (int dt = 0; dt < 2; ++dt)
#pragma unroll
            for (int e = 0; e < 16; ++e) stash[(dt * 16 + e) * 64] += o[dt][e] * iv;
    }
    {
        const int t0 = qt >= 8 ? qt - 8 : 0;
        m = -1e30f; l = 0.f; zero16(o[0]); zero16(o[1]);
        attn_run<64, false, STAG_WIN>(lds, B.KW + (size_t)bg * S * 64, nullptr, B.VWT + (size_t)bg * 64 * S, S, qt - t0 + 1, TileOff{t0}, MaskWin{tq, qt * 64 + (w & 1) * 32}, NoSkip{}, c, qf, m, l, o);
        const float lt = l + __shfl_xor(l, 32); const float iv = (lt > 0.f ? 1.f / lt : 0.f) * B.GN[row * 24 + 16 + head];
#pragma unroll
        for (int dt = 0; dt < 2; ++dt)
#pragma unroll
            for (int e = 0; e < 16; ++e) o[dt][e] = stash[(dt * 16 + e) * 64] + o[dt][e] * iv;
    }
    bf16_t* orow = B.OAB + row * 1024 + head * 64;
#pragma unroll
    for (int dt = 0; dt < 2; ++dt)
#pragma unroll
        for (int a = 0; a < 4; ++a) {
            u32x2 w2 = {pk2(o[dt][4 * a], o[dt][4 * a + 1]), pk2(o[dt][4 * a + 2], o[dt][4 * a + 3])};
            *(u32x2*)(orow + 32 * dt + 8 * a + 4 * hh) = w2;
        }
}

DI void mla_unit(const Bufs& B, LAS unsigned char* lds, int b, int h, int qb) {
    const int tid = my_tid(), lane = tid & 63, w = __builtin_amdgcn_readfirstlane(tid >> 6), hh = lane >> 5;
    const int tq = qb * 256 + w * 32 + (lane & 31);
    const size_t row = (size_t)b * S + tq;
    bf16x8 qf[6];
#pragma unroll
    for (int ks = 0; ks < 6; ++ks) qf[ks] = *(const bf16x8*)(B.QM + row * 768 + h * 96 + ks * 16 + hh * 8);
    const float c = 0.10206207261596575f * LOG2E;
    float m = -1e30f, l = 0.f; f32x16 o[2]; zero16(o[0]); zero16(o[1]);
    attn_run<96, false, STAG_MLA>(lds, B.KM + (size_t)(b * 8 + h) * S * 64, B.KPE + (size_t)b * S * 32, B.VMT + (size_t)(b * 8 + h) * 64 * S, S, 4 * (qb + 1),
                 TileId{}, MaskCausal{tq, qb * 256 + w * 32}, SkipAbove{qb * 256 + w * 32 + 31}, c, qf, m, l, o);
    const float lt = l + __shfl_xor(l, 32); const float iv = lt > 0.f ? 1.f / lt : 0.f;
    bf16_t* orow = B.OAB + row * 1024 + 512 + h * 64;
#pragma unroll
    for (int dt = 0; dt < 2; ++dt)
#pragma unroll
        for (int a = 0; a < 4; ++a) {
            u32x2 w2 = {pk2(o[dt][4 * a] * iv, o[dt][4 * a + 1] * iv), pk2(o[dt][4 * a + 2] * iv, o[dt][4 * a + 3] * iv)};
            *(u32x2*)(orow + 32 * dt + 8 * a + 4 * hh) = w2;
        }
}

DI void attn_phase(const Bufs& B, LAS unsigned char* lds, unsigned* counter) {
    LAS int* sUnit = (LAS int*)(lds + MISC_OFF); int it_ = 0; (void)sUnit; (void)it_; (void)counter;
    for (;;) {
#if ATT_STATIC
        __syncthreads();
        const int u = (int)blockIdx.x + 256 * it_; ++it_;
        if (u >= 2048) break;
#else
        __syncthreads();
        if (threadIdx.x == 0) *sUnit = (int)atomicAdd(counter, 1u);
        __syncthreads();
        const int u = *sUnit;
        if (u >= 2048) break;
#endif
        const int i = u >> 1;
        if ((u & 1) == 0) {
#if EXP_ATT == 2
            { const int b = (i & 63) >> 3, h = i & 7, qb = 15 - (i >> 6);
              for (int e = threadIdx.x; e < 2048; e += 512) *(u32x4*)(B.OAB + ((size_t)b * S + qb * 256 + (e >> 3)) * 1024 + 512 + h * 64 + (e & 7) * 8) = (u32x4){0x3c003c00u, 0x3c003c00u, 0x3c003c00u, 0x3c003c00u}; }
#else
            mla_unit(B, lds, (i & 63) >> 3, i & 7, 15 - (i >> 6));
#if ATT_DUP == 1
            __syncthreads(); mla_unit(B, lds, (i & 63) >> 3, i & 7, 15 - (i >> 6));
#endif
#endif
        } else {
#if EXP_ATT == 1
            { const int b = (i & 15) >> 1, g = i & 1, qt = 63 - (i >> 4);
              for (int e = threadIdx.x; e < 2048; e += 512) *(u32x4*)(B.OAB + ((size_t)b * S + qt * 64 + (e >> 5)) * 1024 + g * 256 + (e & 31) * 8) = (u32x4){0x3c003c00u, 0x3c003c00u, 0x3c003c00u, 0x3c003c00u}; }
#else
            nsa_unit(B, lds, (i & 15) >> 1, i & 1, 63 - (i >> 4));
#if ATT_DUP == 2
            __syncthreads(); nsa_unit(B, lds, (i & 15) >> 1, i & 1, 63 - (i >> 4));
#endif
#endif
        }
    }
}

DI float wave_sum(float v) {
#pragma unroll
    for (int o = 1; o < 64; o <<= 1) v += __shfl_xor(v, o);
    return v;
}
DI void norm_rows_bf16(const float* x, const float* g, bf16_t* xn) {
    const int tid_ = my_tid(), lane = tid_ & 63, gw = blockIdx.x * 8 + (tid_ >> 6), ngw = gridDim.x * 8;
    f32x4 gv[4];
#pragma unroll
    for (int j = 0; j < 4; ++j) gv[j] = ((const f32x4*)g)[lane + 64 * j];
    for (int r = gw; r < M; r += ngw) {
        const f32x4* xr = (const f32x4*)(x + (size_t)r * D) + lane;
        f32x4 v[4]; float s = 0.f;
#pragma unroll
        for (int j = 0; j < 4; ++j) { v[j] = xr[64 * j]; s += (v[j][0] * v[j][0] + v[j][1] * v[j][1]) + (v[j][2] * v[j][2] + v[j][3] * v[j][3]); }
        const float rstd = rsqrtf(wave_sum(s) * (1.f / D) + EPS);
        u32x2* o8 = (u32x2*)(xn + (size_t)r * D) + lane;
#pragma unroll
        for (int j = 0; j < 4; ++j) o8[64 * j] = (u32x2){pk2(v[j][0] * rstd * gv[j][0], v[j][1] * rstd * gv[j][1]), pk2(v[j][2] * rstd * gv[j][2], v[j][3] * rstd * gv[j][3])};
    }
}
DI void norm_rows_f32_inplace(float* x, const float* g) {
    const int tid_ = my_tid(), lane = tid_ & 63, gw = blockIdx.x * 8 + (tid_ >> 6), ngw = gridDim.x * 8;
    f32x4 gv[4];
#pragma unroll
    for (int j = 0; j < 4; ++j) gv[j] = ((const f32x4*)g)[lane + 64 * j];
    for (int r = gw; r < M; r += ngw) {
        f32x4* xr = (f32x4*)(x + (size_t)r * D) + lane;
        f32x4 v[4]; float s = 0.f;
#pragma unroll
        for (int j = 0; j < 4; ++j) { v[j] = xr[64 * j]; s += (v[j][0] * v[j][0] + v[j][1] * v[j][1]) + (v[j][2] * v[j][2] + v[j][3] * v[j][3]); }
        const float rstd = rsqrtf(wave_sum(s) * (1.f / D) + EPS);
#pragma unroll
        for (int j = 0; j < 4; ++j) xr[64 * j] = (f32x4){v[j][0] * rstd * gv[j][0], v[j][1] * rstd * gv[j][1], v[j][2] * rstd * gv[j][2], v[j][3] * rstd * gv[j][3]};
    }
}

DI int perm64(int p) { return (p >> 1) + 32 * (p & 1); }
DI int perm32r(int p) { return (p >> 1) + 16 * (p & 1); }
DI int map_in(int c) {
    if (c < 512) return (c & ~63) + perm64(c & 63);
    if (c < 1280) { const int t = (c - 512) >> 8, cc = (c - 512) & 255, kv = cc >> 7, g = (cc >> 6) & 1, p = cc & 63; return 512 + t * 256 + kv * 128 + g * 64 + (kv == 0 ? perm64(p) : p); }
    if (c < 1536) return 1304 + (c - 1280);
    if (c < 1792) { const int cc = c - 1536; if (cc < 128) return 1560 + cc; if (cc < 160) return 1688 + perm32r(cc - 128); if (cc < 184) return 1280 + (cc - 160); return -1; }
    if (c < 2816) return 1720 + (c - 1792);
    return 2744 + (c - 2816);
}
struct Wts {
    const float *w_in, *cmp_pe, *cmp_w1, *cmp_w2, *nsa_w_o, *q_norm, *kv_norm, *w_uq, *w_ukv, *mla_w_o, *w_out, *w_up, *w_down;
};
template <int JOB> DI float prep_get(const Wts& W, int n, int k) {
    if constexpr (JOB == 0) { const int c = map_in(n); return c >= 0 ? W.w_in[(size_t)k * IN_COLS + c] : 0.f; }
    if constexpr (JOB == 1) { const int j = n >> 8, h = n & 255, lp = k >> 6, p = k & 63, d = j == 0 ? perm64(p) : p; return W.cmp_w1[((size_t)j * 2048 + lp * 64 + d) * 256 + h]; }
    if constexpr (JOB == 2) { const int j = n >> 8, np = n & 255; return np < 64 ? W.cmp_w2[((size_t)j * 256 + k) * 64 + (j == 0 ? perm64(np) : np)] : 0.f; }
    if constexpr (JOB == 3) { return n < 1024 ? W.nsa_w_o[(size_t)k * 1024 + n] : W.mla_w_o[(size_t)k * 1024 + (n - 1024)]; }
    if constexpr (JOB == 4) { const int hh = n / 96, c = n - hh * 96; const int sc = c < 64 ? n : hh * 96 + 64 + perm32r(c - 64); return W.q_norm[k] * W.w_uq[(size_t)k * 768 + sc]; }
    if constexpr (JOB == 5) { return k < 128 ? W.kv_norm[k] * W.w_ukv[(size_t)k * 1024 + n] : 0.f; }
    if constexpr (JOB == 6) { return W.w_out[(size_t)k * 1024 + n]; }
    if constexpr (JOB == 7) { return W.w_up[(size_t)k * 4096 + n]; }
    if constexpr (JOB == 8) { return W.w_down[(size_t)k * 1024 + n]; }
    return 0.f;
}
template <int JOB> DI void prep_tile(const Wts& W, LAS float* scr, bf16_t* dst, int ldd, int n0, int k0) {
    const int tid = my_tid();
#pragma unroll
    for (int it = 0; it < 8; ++it) { const int kk = it * 8 + (tid >> 6), nn = tid & 63; scr[kk * 65 + nn] = prep_get<JOB>(W, n0 + nn, k0 + kk); }
    __syncthreads();
    { const int n = tid >> 3, kc = tid & 7; const LAS float* s = scr + (kc * 8) * 65 + n;
      u32x4 o = {pk2(s[0], s[65]), pk2(s[130], s[195]), pk2(s[260], s[325]), pk2(s[390], s[455])};
      *(u32x4*)(dst + (size_t)(n0 + n) * ldd + k0 + kc * 8) = o; }
    __syncthreads();
}
DI void prep_tile_vec(const float* src, int ldsrc, LAS float* scr, bf16_t* dst, int ldd, int n0, int k0) {
    const int tid = my_tid();
#pragma unroll
    for (int it = 0; it < 2; ++it) { const int kk = it * 32 + (tid >> 4), n4 = (tid & 15) * 4;
        const f32x4 v = *(const f32x4*)(src + (size_t)(k0 + kk) * ldsrc + n4);
        LAS float* d = scr + kk * 65 + n4; d[0] = v[0]; d[1] = v[1]; d[2] = v[2]; d[3] = v[3]; }
    __syncthreads();
    { const int n = tid >> 3, kc = tid & 7; const LAS float* s = scr + (kc * 8) * 65 + n;
      u32x4 o = {pk2(s[0], s[65]), pk2(s[130], s[195]), pk2(s[260], s[325]), pk2(s[390], s[455])};
      *(u32x4*)(dst + (size_t)(n0 + n) * ldd + k0 + kc * 8) = o; }
    __syncthreads();
}
DI void prep_phase(const Wts& W, unsigned char* ws, LAS unsigned char* lds, int layer) {
    LAS float* scr = (LAS float*)lds;
    const int tid = my_tid();
    constexpr int T0 = 960, T1 = T0 + 256, T2 = T1 + 32, T3 = T2 + 256, T4 = T3 + 48, T5 = T4 + 64, T6_ = T5 + 256, T7 = T6_ + 1024, T8 = T7 + 1024, TB = T8 + 8;
    for (int job = blockIdx.x; job < TB; job += gridDim.x) {
        int r = job;
        if (r < T0) { const int n0 = (r >> 4) * 64, k0 = (r & 15) * 64;
            if ((n0 >= 1280 && n0 < 1536) || n0 >= 1792) prep_tile_vec(W.w_in + map_in(n0), IN_COLS, scr, (bf16_t*)(ws + WS_WIN), 1024, n0, k0);
            else prep_tile<0>(W, scr, (bf16_t*)(ws + WS_WIN), 1024, n0, k0);
            continue; }
        if (r < T1) { r -= T0; prep_tile<1>(W, scr, (bf16_t*)(ws + WS_W1T), 2048, (r >> 5) * 64, (r & 31) * 64); continue; }
        if (r < T2) { r -= T1; prep_tile<2>(W, scr, (bf16_t*)(ws + WS_W2T), 256, (r >> 2) * 64, (r & 3) * 64); continue; }
        if (r < T3) { r -= T2; const int n0 = (r >> 3) * 64, k0 = (r & 7) * 64;
            prep_tile_vec(n0 < 1024 ? W.nsa_w_o + n0 : W.mla_w_o + (n0 - 1024), 1024, scr, (bf16_t*)(ws + WS_WOAB), 512, n0, k0); continue; }
        if (r < T4) { r -= T3; prep_tile<4>(W, scr, (bf16_t*)(ws + WS_WUQ), 256, (r >> 2) * 64, (r & 3) * 64); continue; }
        if (r < T5) { r -= T4; prep_tile<5>(W, scr, (bf16_t*)(ws + WS_WUKV), 256, (r >> 2) * 64, (r & 3) * 64); continue; }
        if (r < T6_) { r -= T5; const int n0 = (r >> 4) * 64; prep_tile_vec(W.w_out + n0, 1024, scr, (bf16_t*)(ws + WS_WOUT), 1024, n0, (r & 15) * 64); continue; }
        if (r < T7) { r -= T6_; const int n0 = (r >> 4) * 64; prep_tile_vec(W.w_up + n0, 4096, scr, (bf16_t*)(ws + WS_WUP), 1024, n0, (r & 15) * 64); continue; }
        if (r < T8) { r -= T7; const int n0 = (r >> 6) * 64; prep_tile_vec(W.w_down + n0, 1024, scr, (bf16_t*)(ws + WS_WDN), 4096, n0, (r & 63) * 64); continue; }
        {
            r -= T8; const int j = r >> 2, hc = r & 3, kk = tid >> 6, hx = tid & 63, h = hc * 64 + hx;
            float a = 0.f;
            for (int i = 0; i < 256; ++i) { const int k = kk + 8 * i; a += W.cmp_pe[j * 2048 + k] * W.cmp_w1[((size_t)j * 2048 + k) * 256 + h]; }
            scr[kk * 64 + hx] = a;
            __syncthreads();
            if (tid < 64) { float s = 0.f; for (int q = 0; q < 8; ++q) s += scr[q * 64 + tid]; ((float*)(ws + WS_CB1))[j * 256 + hc * 64 + tid] = s; }
            __syncthreads();
        }
    }
    if (layer == 0) {
        f32x2* cs64 = (f32x2*)(ws + WS_CS64); f32x2* cs32 = (f32x2*)(ws + WS_CS32);
        for (int idx = blockIdx.x * 512 + tid; idx < S * 48; idx += gridDim.x * 512) {
            int pos, i; float inv;
            if (idx < S * 32) { pos = idx >> 5; i = idx & 31; inv = (float)exp2(-(double)i * (13.287712379549449 / 32.0)); }
            else { const int e = idx - S * 32; pos = e >> 4; i = e & 15; inv = (float)exp2(-(double)i * (13.287712379549449 / 16.0)); }
            const float ang = (float)pos * inv;
            const double rev = (double)ang * 0.15915494309189535; const float fr = (float)(rev - floor(rev));
            const f32x2 v = {__builtin_amdgcn_cosf(fr), __builtin_amdgcn_sinf(fr)};
            if (idx < S * 32) cs64[idx] = v; else cs32[idx - S * 32] = v;
        }
    }
}

struct Params { const float* in[17]; float* out; unsigned char* ws; int ph_lo, ph_hi; };
typedef const __attribute__((address_space(4))) unsigned char* kaptr_t;
DI const float* karg_ptr(int byte_off) { kaptr_t ka = (kaptr_t)__builtin_amdgcn_kernarg_segment_ptr(); asm volatile("" : "+s"(ka)); return *(const float* const __attribute__((address_space(4)))*)(ka + byte_off); }
#define KIN(i) karg_ptr(8 * (i))

DI void grid_barrier_cg(cg::grid_group& grid) {
    asm volatile("s_waitcnt vmcnt(0) lgkmcnt(0)" ::: "memory");
    __syncthreads();
    if (threadIdx.x < 64) asm volatile("buffer_wbl2 sc1\n\ts_waitcnt vmcnt(0)" ::: "memory");
    __syncthreads();
    grid.sync();
    asm volatile("buffer_inv sc1\n\ts_waitcnt vmcnt(0)" ::: "memory");
}

#define XB_TMO      128
#define XB_XCNT(j)  (256  + 64 * (j))
#define XB_XSUB(j)  (1280 + 64 * (j))
#define XB_XGEN(j)  (2304 + 64 * (j))
#define XB_TOP      3328
#define XB_TOPGEN   3392
#define XCD_BAR_WORDS 3456
#define XB_SPIN_CAP (1u << 18)
DI unsigned xb_ld(unsigned* p)              { return __hip_atomic_load(p, __ATOMIC_RELAXED, __HIP_MEMORY_SCOPE_AGENT); }
DI unsigned xb_add(unsigned* p, unsigned v) { return __hip_atomic_fetch_add(p, v, __ATOMIC_RELAXED, __HIP_MEMORY_SCOPE_AGENT); }
DI unsigned xb_xcc_id() { return (unsigned)__builtin_amdgcn_s_getreg((3 << 11) | 20) & 0xFu; }
#define XB_SPIN(cond, bar) do { unsigned _sp = 0; while (cond) { __builtin_amdgcn_s_sleep(1); \
    if ((++_sp & 255u) == 0u) { if (xb_ld(&(bar)[XB_TMO])) break; if (_sp > XB_SPIN_CAP) { atomicAdd(&(bar)[XB_TMO], 1u); break; } } } } while (0)
DI void xcd_barrier_complete(unsigned* bar, unsigned x, unsigned& nloc, unsigned& nx) {
    const unsigned G = gridDim.x * gridDim.y * gridDim.z;
    unsigned sum, cnt, mine, sp = 0u;
    for (;;) {
        sum = 0u; cnt = 0u; mine = 0u;
#pragma unroll
        for (unsigned j = 0; j < 16; ++j) { const unsigned c = xb_ld(&bar[XB_XCNT(j)]); sum += c; cnt += (c > 0u) ? 1u : 0u; mine = (j == x) ? c : mine; }
        if (sum == G) break;
        __builtin_amdgcn_s_sleep(1);
        if ((++sp & 255u) == 0u) { if (xb_ld(&bar[XB_TMO])) break; if (sp > XB_SPIN_CAP) { atomicAdd(&bar[XB_TMO], 1u); break; } }
    }
    nloc = mine > 0u ? mine : 1u; nx = cnt > 0u ? cnt : 1u;
}
DI void xcd_barrier(unsigned* bar, volatile LAS unsigned* st) {
    asm volatile("s_waitcnt vmcnt(0)" ::: "memory");
    __syncthreads();
    if (threadIdx.x == 0) {
        const unsigned x = xb_xcc_id();
        __builtin_amdgcn_s_waitcnt(0);
        unsigned nloc = st[0], nx = st[1];
        if (nloc == 0u) { xcd_barrier_complete(bar, x, nloc, nx); st[0] = nloc; st[1] = nx; }
        const unsigned old = xb_add(&bar[XB_XSUB(x)], 1u);
        const unsigned gen = old / nloc;
        if (old + 1u == (gen + 1u) * nloc) {
            __builtin_amdgcn_fence(__ATOMIC_RELEASE, "agent");
            asm volatile("s_waitcnt vmcnt(0)" ::: "memory");
            const unsigned og = xb_add(&bar[XB_TOP], 1u);
            const unsigned tg = og / nx;
            if (og + 1u == (tg + 1u) * nx) xb_add(&bar[XB_TOPGEN], 1u);
            else XB_SPIN(xb_ld(&bar[XB_TOPGEN]) == tg, bar);
            __builtin_amdgcn_fence(__ATOMIC_ACQUIRE, "agent");
            xb_add(&bar[XB_XGEN(x)], 1u);
            asm volatile("s_waitcnt vmcnt(0)" ::: "memory");
        } else {
            XB_SPIN(xb_ld(&bar[XB_XGEN(x)]) == gen, bar);
            __builtin_amdgcn_fence(__ATOMIC_ACQUIRE, "agent");
            asm volatile("s_waitcnt vmcnt(0)" ::: "memory");
        }
    }
    __syncthreads();
}
template <bool FIRST> DI void grid_barrier(cg::grid_group& grid, LAS unsigned char* lds) {
    unsigned* bar = (unsigned*)((unsigned char*)karg_ptr(144) + WS_BAR);
    if constexpr (FIRST) {
        grid_barrier_cg(grid);
        if (threadIdx.x == 0) (void)xb_add(&bar[XB_XCNT(xb_xcc_id())], 1u);
    } else {
        xcd_barrier(bar, (volatile LAS unsigned*)(lds + MISC_OFF + 64));
    }
}

#define PH_IN(k) (lo <= (k) && (k) < hi)
#define PH_SEAM(k) do { if (PH_IN(k) && PH_IN((k) + 1)) grid_barrier<(k) == 0>(grid, lds); } while (0)
#define PH_ENV() int G = gridDim.x, bx = blockIdx.x; asm volatile("" : "+s"(G), "+s"(bx)); unsigned char* ws = (unsigned char*)karg_ptr(144); float* X = (float*)karg_ptr(136); \
                 const int tid = my_tid(); bf16_t* XN = (bf16_t*)(ws + WS_XN); (void)tid; (void)X; (void)XN; (void)G; (void)bx

template <int L> DI void run_layer(LAS unsigned char* lds, cg::grid_group& grid, int lo, int hi) {
    constexpr int P0 = 10 * L;
    if (PH_IN(P0 + 0)) for (int rep_ = 0; rep_ < ((((DUP_MASK >> 0) & 1) && L > 0) ? 2 : 1); ++rep_) { if (rep_) grid_barrier<false>(grid, lds);
        PH_ENV();
        Wts W;
        W.w_in = KIN(2) + (size_t)L * 1024 * IN_COLS; W.cmp_pe = KIN(3) + (size_t)L * 2 * 2048; W.cmp_w1 = KIN(4) + (size_t)L * 2 * 2048 * 256;
        W.cmp_w2 = KIN(5) + (size_t)L * 2 * 256 * 64; W.nsa_w_o = KIN(6) + (size_t)L * 512 * 1024; W.q_norm = KIN(7) + L * 256; W.kv_norm = KIN(8) + L * 128;
        W.w_uq = KIN(9) + (size_t)L * 256 * 768; W.w_ukv = KIN(10) + (size_t)L * 128 * 1024; W.mla_w_o = KIN(11) + (size_t)L * 512 * 1024;
        W.w_out = KIN(12) + (size_t)L * 1024 * 1024; W.w_up = KIN(14) + (size_t)L * 1024 * 4096; W.w_down = KIN(15) + (size_t)L * 4096 * 1024;
        prep_phase(W, ws, lds, L);
        unsigned* ctl = (unsigned*)(ws + WS_CTL);
        if (L == 0 && bx == 0 && tid < 2 * NL) atomicExch(ctl + tid * 64, 0u);
        norm_rows_bf16(L == 0 ? KIN(0) : X, KIN(1) + L * D, XN);
    }
    PH_SEAM(P0 + 0);
    if (PH_IN(P0 + 1)) for (int rep_ = 0; rep_ < (((DUP_MASK >> 1) & 1) ? 2 : 1); ++rep_) { if (rep_) grid_barrier<false>(grid, lds);
        PH_ENV();
        pg8::Gemm g{XN, (const bf16_t*)(ws + WS_WIN), 1024, 1024}; pg8::StaticOrder So; So.init(M, NIN, G, bx);
        EpiWrap<EpiInImpl> E; E.ws = ws;
        pg8::gemm_phase(lds, g, So, E);
    }
    PH_SEAM(P0 + 1);
    if (PH_IN(P0 + 2)) for (int rep_ = 0; rep_ < (((DUP_MASK >> 2) & 1) ? 2 : 1); ++rep_) { if (rep_) grid_barrier<false>(grid, lds);
        PH_ENV();
        { pg8::Gemm g{(const bf16_t*)(ws + WS_KCV), (const bf16_t*)(ws + WS_W1T), 1024, 2048}; pg8::CmpOrder So{G, bx};
          EpiWrap<EpiC1Impl> E; E.ws = ws;
          pg8::gemm_phase(lds, g, So, E); }
        const int crot = (bx + G - 32) % G;
        { pg8::Gemm g{(const bf16_t*)(ws + WS_CQ), (const bf16_t*)(ws + WS_WUQ), 256, 256}; pg8::StaticOrder So; So.init(M, 768, G, crot);
          EpiWrap<EpiUQImpl> E; E.ws = ws;
          pg8::gemm_phase(lds, g, So, E); }
        { pg8::Gemm g{(const bf16_t*)(ws + WS_T6), (const bf16_t*)(ws + WS_WUKV), 256, 256}; pg8::StaticOrder So; So.init(M, 1024, G, crot);
          EpiWrap<EpiUKVImpl> E; E.ws = ws;
          pg8::gemm_phase(lds, g, So, E); }
    }
    PH_SEAM(P0 + 2);
    if (PH_IN(P0 + 3)) for (int rep_ = 0; rep_ < (((DUP_MASK >> 3) & 1) ? 2 : 1); ++rep_) { if (rep_) grid_barrier<false>(grid, lds);
        PH_ENV();
        pg8::Gemm g{(const bf16_t*)(ws + WS_HC), (const bf16_t*)(ws + WS_W2T), 256, 256}; pg8::CmpOrder So{G, bx};
        EpiWrap<EpiC2Impl> E; E.ws = ws;
        pg8::gemm_phase(lds, g, So, E);
    }
    PH_SEAM(P0 + 3);
    if (PH_IN(P0 + 4)) for (int rep_ = 0; rep_ < (((DUP_MASK >> 4) & 1) ? 2 : 1); ++rep_) { if (rep_) grid_barrier<false>(grid, lds);
        PH_ENV();
        Bufs B; B.QN = (const bf16_t*)(ws + WS_QN); B.KS = (const bf16_t*)(ws + WS_KS); B.KW = (const bf16_t*)(ws + WS_KW); B.VST = (const bf16_t*)(ws + WS_VST);
        B.VWT = (const bf16_t*)(ws + WS_VWT); B.KCMP = (const bf16_t*)(ws + WS_KCMP); B.VCMPT = (const bf16_t*)(ws + WS_VCMPT); B.QM = (const bf16_t*)(ws + WS_QM);
        B.KM = (const bf16_t*)(ws + WS_KM); B.KPE = (const bf16_t*)(ws + WS_KPE); B.VMT = (const bf16_t*)(ws + WS_VMT); B.GN = (const float*)(ws + WS_GN); B.OAB = XN;
#if EXP_NOATTN
        { u32x4* o = (u32x4*)XN; for (size_t i = (size_t)bx * 512 + tid; i < (size_t)M * 1024 / 8; i += (size_t)G * 512) o[i] = (u32x4){0x3c003c00u, 0x3c003c00u, 0x3c003c00u, 0x3c003c00u}; (void)B; }
#else
        attn_phase(B, lds, (unsigned*)(ws + WS_CTL) + (L * 2 + rep_) * 64);
#endif
    }
    PH_SEAM(P0 + 4);
    if (PH_IN(P0 + 5)) for (int rep_ = 0; rep_ < (((DUP_MASK >> 5) & 1) ? 2 : 1); ++rep_) { if (rep_) grid_barrier<false>(grid, lds);
        PH_ENV();
        pg8::StaticOrder So; So.init(M, 1024, G, bx);
        { pg8::Gemm g{XN, (const bf16_t*)(ws + WS_WOAB), 1024, 512}; EpiWrap<EpiD1aImpl> E; E.ws = ws; pg8::gemm_phase(lds, g, So, E); }
        { pg8::Gemm g{XN + 512, (const bf16_t*)(ws + WS_WOAB) + 1024 * 512, 1024, 512}; EpiWrap<EpiD1bImpl> E; E.ws = ws; pg8::gemm_phase(lds, g, So, E); }
    }
    PH_SEAM(P0 + 5);
    if (PH_IN(P0 + 6)) for (int rep_ = 0; rep_ < (((DUP_MASK >> 6) & 1) ? 2 : 1); ++rep_) { if (rep_) grid_barrier<false>(grid, lds);
        PH_ENV();
        pg8::Gemm g{(const bf16_t*)(ws + WS_MG), (const bf16_t*)(ws + WS_WOUT), 1024, 1024}; pg8::StaticOrder So; So.init(M, 1024, G, bx);
        EpiWrap<EpiD2Impl> E; E.xin = (L == 0 ? KIN(0) : X); E.X = X;
        pg8::gemm_phase(lds, g, So, E);
    }
    PH_SEAM(P0 + 6);
    if (PH_IN(P0 + 7)) for (int rep_ = 0; rep_ < (((DUP_MASK >> 7) & 1) ? 2 : 1); ++rep_) { if (rep_) grid_barrier<false>(grid, lds);
        PH_ENV();
        norm_rows_bf16(X, KIN(13) + L * D, XN);
    }
    PH_SEAM(P0 + 7);
    if (PH_IN(P0 + 8)) for (int rep_ = 0; rep_ < (((DUP_MASK >> 8) & 1) ? 2 : 1); ++rep_) { if (rep_) grid_barrier<false>(grid, lds);
        PH_ENV();
        pg8::Gemm g{XN, (const bf16_t*)(ws + WS_WUP), 1024, 1024}; pg8::StaticOrder So; So.init(M, FF, G, bx);
        EpiWrap<EpiUpImpl> E; E.ws = ws;
        pg8::gemm_phase(lds, g, So, E);
    }
    PH_SEAM(P0 + 8);
    if (PH_IN(P0 + 9)) for (int rep_ = 0; rep_ < (((DUP_MASK >> 9) & 1) ? 2 : 1); ++rep_) { if (rep_) grid_barrier<false>(grid, lds);
        PH_ENV();
        pg8::Gemm g{(const bf16_t*)(ws + WS_HF), (const bf16_t*)(ws + WS_WDN), 4096, 4096}; pg8::StaticOrder So; So.init(M, 1024, G, bx);
        EpiWrap<EpiD2Impl> E; E.xin = X; E.X = X;
        pg8::gemm_phase(lds, g, So, E);
    }
    PH_SEAM(P0 + 9);
}

__global__ void __launch_bounds__(512, 2) mega(Params P) {
    extern __shared__ __attribute__((aligned(16))) unsigned char lds_raw[];
    LAS unsigned char* lds = (LAS unsigned char*)lds_raw;
    cg::grid_group grid = cg::this_grid();
    const int lo = P.ph_lo, hi = P.ph_hi;
    if (threadIdx.x < 2) ((volatile LAS unsigned*)(lds + MISC_OFF + 64))[threadIdx.x] = 0u;
    if (blockIdx.x == 0 && hi - lo > 1) { unsigned* bar = (unsigned*)((unsigned char*)karg_ptr(144) + WS_BAR);
        for (int i = threadIdx.x; i < XCD_BAR_WORDS; i += 512) __hip_atomic_store(bar + i, 0u, __ATOMIC_RELAXED, __HIP_MEMORY_SCOPE_AGENT); }
    __syncthreads();
    run_layer<0>(lds, grid, lo, hi);
    run_layer<1>(lds, grid, lo, hi);
    run_layer<2>(lds, grid, lo, hi);
    run_layer<3>(lds, grid, lo, hi);
    if (PH_IN(39) && PH_IN(40)) {   }
    if (PH_IN(40)) { float* X = (float*)karg_ptr(136); norm_rows_f32_inplace(X, KIN(16)); }
}

extern "C" void kernel_launch(void* const* d_in, const int* in_sizes, int n_in, void* d_out, int out_size, void* d_ws, size_t ws_size, hipStream_t stream) {
    static int grid = 0;
    if (grid == 0) {
        if (n_in != 17 || out_size != M * D || ws_size < WS_END) { fprintf(stderr, "kernel_launch: unexpected shapes (n_in %d out %d ws %zu)\n", n_in, out_size, ws_size); grid = -1; return; }
        int dev = 0, cus = 0, per_cu = 0;
        hipGetDevice(&dev);
        hipDeviceGetAttribute(&cus, hipDeviceAttributeMultiprocessorCount, dev);
        if (hipFuncSetAttribute((const void*)mega, hipFuncAttributeMaxDynamicSharedMemorySize, LDS_BYTES) != hipSuccess) { fprintf(stderr, "kernel_launch: hipFuncSetAttribute failed\n"); grid = -1; return; }
        if (hipOccupancyMaxActiveBlocksPerMultiprocessor(&per_cu, (const void*)mega, 512, LDS_BYTES) != hipSuccess || per_cu < 1) { fprintf(stderr, "kernel_launch: occupancy query gave %d\n", per_cu); per_cu = 1; }
        (void)hipGetLastError();
        grid = cus * per_cu;
    }
    if (grid < 0) return;
    Params p{};
    for (int i = 0; i < 17; ++i) p.in[i] = (const float*)d_in[i];
    p.out = (float*)d_out; p.ws = (unsigned char*)d_ws;
#if MK_MULTI
    for (int ph = 0; ph <= 40; ++ph) {
        p.ph_lo = ph; p.ph_hi = ph + 1;
        hipLaunchKernelGGL(mega, dim3(grid), dim3(512), LDS_BYTES, stream, p);
    }
#else
    p.ph_lo = 0; p.ph_hi = 41;
    void* args[] = {&p};
    hipError_t e = hipLaunchCooperativeKernel((const void*)mega, dim3(grid), dim3(512), args, LDS_BYTES, stream);
    if (e != hipSuccess) fprintf(stderr, "kernel_launch: cooperative launch failed: %s (grid %d)\n", hipGetErrorString(e), grid);
#endif
}
```

```cpp
#include <hip/hip_runtime.h>
#include <hip/hip_cooperative_groups.h>
#include <cstdio>
#include <cstdint>
namespace cg = cooperative_groups;

#ifndef EXP_NOATTN
#define EXP_NOATTN 0
#endif
#ifndef ATT_STATIC
#define ATT_STATIC 0
#endif
#ifndef EXP_ATT
#define EXP_ATT 0
#endif
#ifndef DUP_MASK
#define DUP_MASK 0
#endif
#ifndef ATT_DUP
#define ATT_DUP 0
#endif
#ifndef STAG_CMP
#define STAG_CMP false
#define STAG_SLC false
#define STAG_WIN true
#define STAG_MLA true
#endif
#ifndef MK_MULTI
#define MK_MULTI 0
#endif

#define LAS __attribute__((address_space(3)))
#define DI __device__ __forceinline__
typedef unsigned short bf16_t;
typedef short bf16x8 __attribute__((ext_vector_type(8)));
typedef float f32x4 __attribute__((ext_vector_type(4)));
typedef float f32x2 __attribute__((ext_vector_type(2)));
typedef float f32x16 __attribute__((ext_vector_type(16)));
typedef unsigned u32x4 __attribute__((ext_vector_type(4)));
typedef unsigned u32x2 __attribute__((ext_vector_type(2)));
typedef __bf16 bf16v2 __attribute__((ext_vector_type(2)));

DI unsigned pk2(float lo, float hi) { f32x2 v = {lo, hi}; return __builtin_bit_cast(unsigned, __builtin_convertvector(v, bf16v2)); }
DI bf16_t f2bf(float x) { return (bf16_t)(pk2(x, 0.f) & 0xffffu); }
DI float bflo(unsigned w) { return __uint_as_float(w << 16); }
DI float bfhi(unsigned w) { return __uint_as_float(w & 0xffff0000u); }
DI float sigmoidf_(float x) { return 1.f / (1.f + __expf(-x)); }
DI float ex2(float x) { return __builtin_amdgcn_exp2f(x); }
DI int my_tid() { int t = threadIdx.x; asm volatile("" : "+v"(t)); return t; }

constexpr int NB = 8, S = 4096, D = 1024, NL = 4, M = NB * S, FF = 4096;
constexpr int NIN = 3840;
constexpr int IN_COLS = 3768;
constexpr float EPS = 1e-6f;
constexpr float LOG2E = 1.4426950408889634f;

constexpr size_t MiB = 1u << 20;
constexpr size_t WS_CTL = 0;
constexpr size_t WS_BAR = 16384;
constexpr size_t WS_CB1 = 4096;
constexpr size_t WS_RSQ = 65536;
constexpr size_t WS_RSKV = 65536 + 131072;
constexpr size_t WS_CS64 = 1 * MiB;
constexpr size_t WS_CS32 = 2 * MiB;
constexpr size_t WS_WIN = 3 * MiB;
constexpr size_t WS_W1T = WS_WIN + (size_t)NIN * 1024 * 2;
constexpr size_t WS_W2T = WS_W1T + 2 * MiB;
constexpr size_t WS_WOAB = WS_W2T + 256 * 1024;
constexpr size_t WS_WUQ = WS_WOAB + 2 * MiB;
constexpr size_t WS_WUKV = WS_WUQ + 384 * 1024;
constexpr size_t WS_WOUT = 16 * MiB;
constexpr size_t WS_WUP = 18 * MiB;
constexpr size_t WS_WDN = 26 * MiB;
constexpr size_t WS_XN = 34 * MiB;
constexpr size_t WS_GA = 98 * MiB;
constexpr size_t WS_GB = 162 * MiB;
constexpr size_t WS_QN = 226 * MiB;
constexpr size_t WS_KCV = 258 * MiB;
constexpr size_t WS_KS = 274 * MiB, WS_KW = 282 * MiB, WS_VST = 290 * MiB, WS_VWT = 298 * MiB;
constexpr size_t WS_CQ = 306 * MiB, WS_T6 = 322 * MiB, WS_KPE = 338 * MiB, WS_GN = 340 * MiB;
constexpr size_t WS_QM = 343 * MiB, WS_KM = 391 * MiB, WS_VMT = 423 * MiB, WS_HC = 455 * MiB;
constexpr size_t WS_KCMP = 459 * MiB, WS_VCMPT = WS_KCMP + 512 * 1024;
constexpr size_t WS_MG = 226 * MiB;
constexpr size_t WS_HF = 98 * MiB;
constexpr size_t WS_PQ = 460 * MiB;
constexpr size_t WS_PKV = 461 * MiB;
constexpr size_t WS_END = 462 * MiB;
static_assert(WS_WUKV + 512 * 1024 <= WS_WOUT, "ws map");

constexpr int LDS_BYTES = 147456;
constexpr int MISC_OFF = 147200;
constexpr int AT_K = 0, AT_KB = 13312  , AT_V = 26624, AT_VB = 9216  , AT_IMP = 54272, AT_SEL = 70656, AT_LIST = 71168, AT_CNT = 71424, AT_ACC = 71680;

namespace pg8 {
constexpr int BM = 256, BK = 64, HALF = 128, HTB = HALF * BK * 2, NXCD = 8, WGM = 8;
__host__ __device__ __forceinline__ int lds_byte(int r, int c) { const int st = (r >> 4) * 2 + (c >> 5), rr = r & 15, cc = c & 31, ob = rr * 64 + cc * 2; return st * 1024 + (ob ^ (((ob >> 9) & 1) << 5)); }
__host__ __device__ __forceinline__ void stage_rc(int b, int& R, int& C) { const int st = b / 1024, sb = b % 1024, swz = sb ^ (((sb >> 9) & 1) << 5); R = (st >> 1) * 16 + swz / 64; C = (st & 1) * 32 + (swz % 64) / 2; }
__host__ __device__ __forceinline__ int perm32(int rho) { const int n = rho >> 4, i = rho & 15; return 8 * (i >> 2) + 4 * n + (i & 3); }

struct Unit { int pm, pn; };
struct Gemm { const bf16_t* A; const bf16_t* Bt; int lda; int K; };

struct StaticOrder {
    int nM, nN, nwg, G, c;
    __device__ void init(int M_, int N_, int G_, int c_) { nM = M_ / BM; nN = N_ / BM; nwg = nM * nN; G = G_; c = c_; }
    __device__ bool next(int i, Unit& u) const {
        const long L = (long)i * G + c; if (L >= nwg) return false;
        int wgid = (int)L; { const int q = nwg / NXCD, r = nwg % NXCD, xcd = wgid % NXCD, off = wgid / NXCD; wgid = (xcd < r ? xcd * (q + 1) : r * (q + 1) + (xcd - r) * q) + off; }
        const int nig = WGM * nN, gid = wgid / nig, fm = gid * WGM, gsz = (nM - fm) < WGM ? (nM - fm) : WGM;
        u.pm = fm + ((wgid % nig) % gsz); u.pn = (wgid % nig) / gsz; return true;
    }
};
struct CmpOrder {
    int G, c;
    __device__ bool next(int i, Unit& u) const { const int L = i * G + c; if (L >= 32) return false; u.pm = L; u.pn = L >> 4; return true; }
};

template <class Epi, class Sched>
__device__ __forceinline__ void gemm_phase(LAS unsigned char* lds, const Gemm g, const Sched& S, const Epi& E) {
    const int tid = my_tid(), wid = __builtin_amdgcn_readfirstlane(tid >> 6), lane = tid & 63, wr = wid >> 2, wc = wid & 3, fr = lane & 15, fq = lane >> 4;
    const int K = g.K, nt = K / BK, lda = g.lda;
    unsigned voffA, voffB;
    { int R, C; stage_rc(tid * 16, R, C); const int Rb = (R & ~31) + perm32(R & 31);
        voffA = (unsigned)(R * lda + C) * 2u; voffB = (unsigned)(Rb * K + C) * 2u; }
    const size_t qvoffA = (size_t)64 * lda * 2, qvoffB = (size_t)64 * K * 2;
    const size_t kstep = (size_t)(BK * 2);
    const size_t hstepA = (size_t)HALF * lda * 2, hstepB = (size_t)HALF * K * 2;
    const size_t tstepA = 2 * hstepA, tstepB = 2 * hstepB;
    const unsigned ldsw = (unsigned)wid * 1024u;
    const int aoff = lds_byte(wr * 64 + fr, fq * 8), boff = lds_byte(wc * 32 + fr, fq * 8);
#define PG8_SA(b, h) (((b) * 2 + (h)) * HTB)
#define PG8_SB(b, h) ((4 + (b) * 2 + (h)) * HTB)
#define PG8_STAGE(bufoff, gbase, voff) do { _Pragma("unroll") for (int _i = 0; _i < 2; ++_i) \
        __builtin_amdgcn_global_load_lds((const unsigned*)((const char*)(gbase) + (size_t)_i * q##voff + (voff)), (LAS unsigned*)(lds + (bufoff) + ldsw + _i * 8192), 16, 0, 0); } while (0)
#define PG8_LDA(dst, b, h) do { _Pragma("unroll") for (int m = 0; m < 4; ++m) _Pragma("unroll") for (int k = 0; k < 2; ++k) dst[m][k] = *(const LAS bf16x8*)(lds + PG8_SA(b, h) + aoff + m * 2048 + k * 1024); } while (0)
#define PG8_LDB(dst, b, h) do { _Pragma("unroll") for (int n = 0; n < 2; ++n) _Pragma("unroll") for (int k = 0; k < 2; ++k) dst[n][k] = *(const LAS bf16x8*)(lds + PG8_SB(b, h) + boff + n * 2048 + k * 1024); } while (0)
#define PG8_MMA(ai, bj, At, Bt) do { __builtin_amdgcn_s_setprio(1); _Pragma("unroll") for (int m = 0; m < 4; ++m) _Pragma("unroll") for (int n = 0; n < 2; ++n) _Pragma("unroll") for (int k = 0; k < 2; ++k) \
        acc[ai][bj][m][n] = __builtin_amdgcn_mfma_f32_16x16x32_bf16(Bt[n][k], At[m][k], acc[ai][bj][m][n], 0, 0, 0); __builtin_amdgcn_s_setprio(0); } while (0)
#define PG8_WAIT_V(n) asm volatile("s_waitcnt vmcnt(" #n ")" ::: "memory")
#define PG8_WAIT_L(n) asm volatile("s_waitcnt lgkmcnt(" #n ")" ::: "memory")
#define PG8_BAR __builtin_amdgcn_s_barrier()
#define PG8_SCHED __builtin_amdgcn_sched_barrier(0)
    Unit cur, nxt; int ui = 0;
    if (!S.next(0, cur)) return;
    f32x4 acc[2][2][4][2];
#pragma unroll
    for (int a = 0; a < 2; ++a)
#pragma unroll
        for (int b = 0; b < 2; ++b)
#pragma unroll
            for (int m = 0; m < 4; ++m)
#pragma unroll
                for (int n = 0; n < 2; ++n) acc[a][b][m][n] = (f32x4){0.f, 0.f, 0.f, 0.f};
    bf16x8 At[4][2], B0[2][2], B1[2][2];
    const char* cA = (const char*)g.A + (size_t)cur.pm * tstepA; const char* cB = (const char*)g.Bt + (size_t)cur.pn * tstepB;
    PG8_STAGE(PG8_SB(0, 0), cB, voffB); PG8_STAGE(PG8_SB(0, 1), cB + hstepB, voffB); PG8_STAGE(PG8_SA(0, 0), cA, voffA); PG8_STAGE(PG8_SA(0, 1), cA + hstepA, voffA);
    if (wr == 1) PG8_BAR;
    PG8_WAIT_V(2); PG8_BAR;
    PG8_STAGE(PG8_SB(1, 0), cB + kstep, voffB); PG8_STAGE(PG8_SA(1, 0), cA + kstep, voffA); PG8_STAGE(PG8_SB(1, 1), cB + hstepB + kstep, voffB);
    PG8_WAIT_V(6); PG8_BAR;
    for (;;) {
        const bool has_next = S.next(ui + 1, nxt);
        const char* nA = has_next ? (const char*)g.A + (size_t)nxt.pm * tstepA : cA; const char* nB = has_next ? (const char*)g.Bt + (size_t)nxt.pn * tstepB : cB;
        for (int t = 0; t < nt; t += 2) {
            const bool last = (t == nt - 2);
            const char* a1 = cA + (size_t)(t + 1) * kstep;
            const char* a2 = last ? nA : cA + (size_t)(t + 2) * kstep; const char* b2 = last ? nB : cB + (size_t)(t + 2) * kstep;
            const char* a3 = a2 + kstep; const char* b3 = b2 + kstep;
            PG8_LDB(B0, 0, 0); PG8_LDB(B1, 0, 1); PG8_SCHED; PG8_LDA(At, 0, 0); PG8_STAGE(PG8_SA(1, 1), a1 + hstepA, voffA);
            PG8_WAIT_V(8); PG8_WAIT_L(0); PG8_BAR; PG8_MMA(0, 0, At, B0); PG8_MMA(0, 1, At, B1); PG8_BAR; PG8_SCHED;
            PG8_LDA(At, 0, 1); PG8_STAGE(PG8_SB(0, 0), b2, voffB); PG8_STAGE(PG8_SB(0, 1), b2 + hstepB, voffB); PG8_STAGE(PG8_SA(0, 0), a2, voffA);
            PG8_WAIT_V(8); PG8_WAIT_L(0); PG8_BAR; PG8_MMA(1, 0, At, B0); PG8_MMA(1, 1, At, B1); PG8_BAR; PG8_SCHED;
            PG8_LDB(B0, 1, 0); PG8_LDB(B1, 1, 1); PG8_SCHED; PG8_LDA(At, 1, 0); PG8_STAGE(PG8_SA(0, 1), a2 + hstepA, voffA);
            PG8_WAIT_V(8); PG8_WAIT_L(0); PG8_BAR; PG8_MMA(0, 0, At, B0); PG8_MMA(0, 1, At, B1); PG8_BAR; PG8_SCHED;
            PG8_LDA(At, 1, 1); PG8_STAGE(PG8_SB(1, 0), b3, voffB); PG8_STAGE(PG8_SB(1, 1), b3 + hstepB, voffB); PG8_STAGE(PG8_SA(1, 0), a3, voffA);
            PG8_WAIT_V(8); PG8_WAIT_L(0); PG8_BAR; PG8_MMA(1, 0, At, B0); PG8_MMA(1, 1, At, B1); PG8_BAR; PG8_SCHED;
        }
        if (wr == 0) PG8_BAR;
        E(acc, cur, wr, wc, fr, fq);
        if (!has_next) break;
#pragma unroll
        for (int a = 0; a < 2; ++a)
#pragma unroll
            for (int b = 0; b < 2; ++b)
#pragma unroll
                for (int m = 0; m < 4; ++m)
#pragma unroll
                    for (int n = 0; n < 2; ++n) acc[a][b][m][n] = (f32x4){0.f, 0.f, 0.f, 0.f};
        cur = nxt; cA = nA; cB = nB; ++ui;
        if (wr == 1) PG8_BAR;
    }
    PG8_WAIT_V(0);
    PG8_BAR;
#undef PG8_SA
#undef PG8_SB
#undef PG8_STAGE
#undef PG8_LDA
#undef PG8_LDB
#undef PG8_MMA
#undef PG8_WAIT_V
#undef PG8_WAIT_L
#undef PG8_BAR
#undef PG8_SCHED
}
}
using pg8::Unit;

DI void store8(bf16_t* p, const float (&v)[8]) { u32x4 w = {pk2(v[0], v[1]), pk2(v[2], v[3]), pk2(v[4], v[5]), pk2(v[6], v[7])}; *(u32x4*)p = w; }
DI void rope8(float (&v)[8], const f32x2* cs) {
    const f32x4 c0 = *(const f32x4*)cs, c1 = *(const f32x4*)(cs + 2);
    const float co[4] = {c0[0], c0[2], c1[0], c1[2]}, si[4] = {c0[1], c0[3], c1[1], c1[3]};
#pragma unroll
    for (int k = 0; k < 4; ++k) { const float a = v[2 * k], b = v[2 * k + 1]; v[2 * k] = a * co[k] - b * si[k]; v[2 * k + 1] = a * si[k] + b * co[k]; }
}
DI float sumsq_fq(const float (&v)[8]) {
    float s = 0.f;
#pragma unroll
    for (int e = 0; e < 8; ++e) s += v[e] * v[e];
    s += __shfl_xor(s, 16); s += __shfl_xor(s, 32); return s;
}

template <class Impl> struct EpiWrap : Impl {
    static constexpr bool MID = false;
    DI void operator()(const f32x4 (&acc)[2][2][4][2], const Unit& u, int wr, int wc, int, int) const {
        const int t2 = my_tid(), fr = t2 & 15, fq = (t2 >> 4) & 3;
#pragma unroll
        for (int ai = 0; ai < 2; ++ai)
#pragma unroll
            for (int m = 0; m < 4; ++m)
#pragma unroll
                for (int bj = 0; bj < 2; ++bj) {
                    const f32x4 a0 = acc[ai][bj][m][0], a1 = acc[ai][bj][m][1];
                    float v[8] = {a0[0], a0[1], a0[2], a0[3], a1[0], a1[1], a1[2], a1[3]};
                    this->chunk(u.pm * 256 + ai * 128 + wr * 64 + m * 16 + fr, u.pn, bj * 128 + wc * 32 + 8 * fq, v);
                }
    }
};

#define WSP(T, off) ((T*)(ws + (off)))
struct EpiInImpl {
    unsigned char* ws;
    DI void chunk(int row, int pn, int cc, float (&v)[8]) const {
        const int pos = row & (S - 1), b = row >> 12;
        bf16_t* const QN = WSP(bf16_t, WS_QN); bf16_t* const KCV = WSP(bf16_t, WS_KCV); bf16_t* const CQ = WSP(bf16_t, WS_CQ); bf16_t* const T6 = WSP(bf16_t, WS_T6);
        bf16_t* const KPE = WSP(bf16_t, WS_KPE); float* const GN = WSP(float, WS_GN); float* const PQ = WSP(float, WS_PQ); float* const PKV = WSP(float, WS_PKV);
        const f32x2* const CS64 = WSP(const f32x2, WS_CS64); const f32x2* const CS32 = WSP(const f32x2, WS_CS32);
        if (pn < 2) {
            rope8(v, CS64 + pos * 32 + ((cc & 63) >> 1));
            store8(QN + (size_t)row * 512 + pn * 256 + cc, v);
        } else if (pn < 5) {
            const int kv = cc >> 7, g = (cc >> 6) & 1, p = cc & 63, bg = b * 2 + g;
            if (kv == 0) {
                rope8(v, CS64 + pos * 32 + (p >> 1));
                bf16_t* dst = WSP(bf16_t, pn == 2 ? WS_KCV : (pn == 3 ? WS_KS : WS_KW));
                store8(dst + ((size_t)bg * S + pos) * 64 + p, v);
            } else if (pn == 2) {
                store8(KCV + ((size_t)(16 + bg) * S + pos) * 64 + p, v);
            } else {
                bf16_t* dst = WSP(bf16_t, pn == 3 ? WS_VST : WS_VWT);
#pragma unroll
                for (int e = 0; e < 8; ++e) dst[((size_t)bg * 64 + p + e) * S + pos] = f2bf(v[e]);
            }
        } else if (pn == 5) {
            store8(CQ + (size_t)row * 256 + cc, v);
            const float s = sumsq_fq(v);
            if ((threadIdx.x & 48) == 0) PQ[(size_t)row * 8 + (cc >> 5)] = s;
        } else if (pn == 6) {
            store8(T6 + (size_t)row * 256 + cc, v);
            if (cc < 128) {
                const float s = sumsq_fq(v);
                if ((threadIdx.x & 48) == 0) PKV[(size_t)row * 4 + (cc >> 5)] = s;
            } else if (cc < 160) {
                rope8(v, CS32 + pos * 16 + ((cc - 128) >> 1));
                store8(KPE + (size_t)row * 32 + (cc - 128), v);
            } else if (cc < 184) {
#pragma unroll
                for (int e = 0; e < 8; ++e) GN[(size_t)row * 24 + (cc - 160) + e] = sigmoidf_(v[e]);
            }
        } else {
#pragma unroll
            for (int e = 0; e < 8; ++e) v[e] = sigmoidf_(v[e]);
            if (pn < 11) store8(WSP(bf16_t, WS_GA) + (size_t)row * 1024 + (pn - 7) * 256 + cc, v);
            else store8(WSP(bf16_t, WS_GB) + (size_t)row * 1024 + (pn - 11) * 256 + cc, v);
        }
    }
};
struct EpiC1Impl {
    unsigned char* ws;
    DI void chunk(int row, int pn, int cc, float (&v)[8]) const {
        bf16_t* const HC = WSP(bf16_t, WS_HC); const float* const CB1 = WSP(const float, WS_CB1);
        const f32x4 b0 = *(const f32x4*)(CB1 + pn * 256 + cc), b1 = *(const f32x4*)(CB1 + pn * 256 + cc + 4);
        const float bb[8] = {b0[0], b0[1], b0[2], b0[3], b1[0], b1[1], b1[2], b1[3]};
#pragma unroll
        for (int e = 0; e < 8; ++e) { const float x = v[e] + bb[e]; v[e] = x / (1.f + __expf(-x)); }
        store8(HC + (size_t)row * 256 + cc, v);
    }
};
struct EpiC2Impl {
    unsigned char* ws;
    DI void chunk(int row, int pn, int cc, float (&v)[8]) const {
        if (cc >= 64) return;
        bf16_t* const KCMP = WSP(bf16_t, WS_KCMP); bf16_t* const VCMPT = WSP(bf16_t, WS_VCMPT);
        const int bg = (row >> 8) & 15, n = row & 255;
        if (n == 255) {
#pragma unroll
            for (int e = 0; e < 8; ++e) v[e] = 0.f;
        }
        if (pn == 0) store8(KCMP + ((size_t)bg * 256 + n) * 64 + cc, v);
        else {
#pragma unroll
            for (int e = 0; e < 8; ++e) VCMPT[((size_t)bg * 64 + cc + e) * 256 + n] = f2bf(v[e]);
        }
    }
};
struct EpiUQImpl {
    unsigned char* ws;
    DI void chunk(int row, int pn, int cc, float (&v)[8]) const {
        bf16_t* const QM = WSP(bf16_t, WS_QM); const float* const PQ = WSP(const float, WS_PQ); const f32x2* const CS32 = WSP(const f32x2, WS_CS32);
        const int c = pn * 256 + cc, hh = c / 96, c96 = c - hh * 96, pos = row & (S - 1);
        const f32x4 p0 = *(const f32x4*)(PQ + (size_t)row * 8), p1 = *(const f32x4*)(PQ + (size_t)row * 8 + 4);
        const float rstd = rsqrtf((((p0[0] + p0[1]) + (p0[2] + p0[3])) + ((p1[0] + p1[1]) + (p1[2] + p1[3]))) * (1.f / 256.f) + EPS);
#pragma unroll
        for (int e = 0; e < 8; ++e) v[e] *= rstd;
        if (c96 >= 64) rope8(v, CS32 + pos * 16 + ((c96 - 64) >> 1));
        store8(QM + (size_t)row * 768 + c, v);
    }
};
struct EpiUKVImpl {
    unsigned char* ws;
    DI void chunk(int row, int pn, int cc, float (&v)[8]) const {
        bf16_t* const KM = WSP(bf16_t, WS_KM); bf16_t* const VMT = WSP(bf16_t, WS_VMT); const float* const PKV = WSP(const float, WS_PKV);
        const int c = pn * 256 + cc, hh = c >> 7, c128 = c & 127, pos = row & (S - 1), b = row >> 12;
        const f32x4 p0 = *(const f32x4*)(PKV + (size_t)row * 4);
        const float rstd = rsqrtf(((p0[0] + p0[1]) + (p0[2] + p0[3])) * (1.f / 128.f) + EPS);
#pragma unroll
        for (int e = 0; e < 8; ++e) v[e] *= rstd;
        if (c128 < 64) store8(KM + ((size_t)(b * 8 + hh) * S + pos) * 64 + c128, v);
        else {
#pragma unroll
            for (int e = 0; e < 8; ++e) VMT[((size_t)(b * 8 + hh) * 64 + (c128 - 64) + e) * S + pos] = f2bf(v[e]);
        }
    }
};
struct EpiD2Impl {
    const float* xin; float* X;
    DI void chunk(int row, int pn, int cc, float (&v)[8]) const {
        const size_t o = (size_t)row * 1024 + pn * 256 + cc;
        const f32x4 x0 = *(const f32x4*)(xin + o), x1 = *(const f32x4*)(xin + o + 4);
        *(f32x4*)(X + o) = (f32x4){x0[0] + v[0], x0[1] + v[1], x0[2] + v[2], x0[3] + v[3]};
        *(f32x4*)(X + o + 4) = (f32x4){x1[0] + v[4], x1[1] + v[5], x1[2] + v[6], x1[3] + v[7]};
    }
};
struct EpiUpImpl {
    unsigned char* ws;
    DI void chunk(int row, int pn, int cc, float (&v)[8]) const {
        bf16_t* const HF = WSP(bf16_t, WS_HF);
#pragma unroll
        for (int e = 0; e < 8; ++e) { const float r = fmaxf(v[e], 0.f); v[e] = r * r; }
        store8(HF + (size_t)row * FF + pn * 256 + cc, v);
    }
};
struct EpiD1aImpl {
    unsigned char* ws;
    DI void chunk(int row, int pn, int cc, float (&v)[8]) const {
        const size_t o = (size_t)row * 1024 + pn * 256 + cc;
        const u32x4 a = *(const u32x4*)(WSP(const bf16_t, WS_GA) + o);
        v[0] *= bflo(a[0]); v[1] *= bfhi(a[0]); v[2] *= bflo(a[1]); v[3] *= bfhi(a[1]); v[4] *= bflo(a[2]); v[5] *= bfhi(a[2]); v[6] *= bflo(a[3]); v[7] *= bfhi(a[3]);
        store8(WSP(bf16_t, WS_MG) + o, v);
    }
};
struct EpiD1bImpl {
    unsigned char* ws;
    DI void chunk(int row, int pn, int cc, float (&v)[8]) const {
        const size_t o = (size_t)row * 1024 + pn * 256 + cc;
        const u32x4 b = *(const u32x4*)(WSP(const bf16_t, WS_GB) + o), g = *(const u32x4*)(WSP(const bf16_t, WS_MG) + o);
        v[0] = bflo(g[0]) + v[0] * bflo(b[0]); v[1] = bfhi(g[0]) + v[1] * bfhi(b[0]); v[2] = bflo(g[1]) + v[2] * bflo(b[1]); v[3] = bfhi(g[1]) + v[3] * bfhi(b[1]);
        v[4] = bflo(g[2]) + v[4] * bflo(b[2]); v[5] = bfhi(g[2]) + v[5] * bfhi(b[2]); v[6] = bflo(g[3]) + v[6] * bflo(b[3]); v[7] = bfhi(g[3]) + v[7] * bfhi(b[3]);
        store8(WSP(bf16_t, WS_MG) + o, v);
    }
};

#define MFMA32(a, b, c) __builtin_amdgcn_mfma_f32_32x32x16_bf16((a), (b), (c), 0, 0, 0)

template <int DQK> DI void qk_tile(const LAS unsigned char* sK, const bf16x8 (&qf)[DQK / 16], f32x16 (&s)[2], int lane) {
    constexpr int KSTR = DQK * 2 + 16;
    const int r = lane & 31, h = lane >> 5;
    const int rp = (r & 0x13) | ((r & 4) << 1) | ((r & 8) >> 1);
    bf16x8 kf[2][DQK / 16];
#pragma unroll
    for (int kt = 0; kt < 2; ++kt)
#pragma unroll
        for (int ks = 0; ks < DQK / 16; ++ks) kf[kt][ks] = *(const LAS bf16x8*)(sK + (32 * kt + rp) * KSTR + ks * 32 + h * 16);
    __builtin_amdgcn_sched_barrier(0);
    __builtin_amdgcn_s_setprio(1);
#pragma unroll
    for (int kt = 0; kt < 2; ++kt) {
        f32x16 a;
#pragma unroll
        for (int i = 0; i < 16; ++i) a[i] = 0.f;
#pragma unroll
        for (int ks = 0; ks < DQK / 16; ++ks) a = MFMA32(kf[kt][ks], qf[ks], a);
        s[kt] = a;
    }
    __builtin_amdgcn_s_setprio(0);
}
DI void v_load(bf16x8 (&vf)[2][2][2], const LAS unsigned char* sV, int lane) {
    const int h = lane >> 5, r = lane & 31;
#pragma unroll
    for (int kt = 0; kt < 2; ++kt)
#pragma unroll
        for (int s2 = 0; s2 < 2; ++s2)
#pragma unroll
            for (int dt = 0; dt < 2; ++dt) vf[kt][s2][dt] = *(const LAS bf16x8*)(sV + (32 * dt + r) * 144 + (32 * kt + 16 * s2 + 8 * h) * 2);
}

template <bool LANEOFF> DI void pack_p(const f32x16 (&s)[2], unsigned keep, u32x4 (&pp)[4]) {
#pragma unroll
    for (int kt = 0; kt < 2; ++kt)
#pragma unroll
        for (int s2 = 0; s2 < 2; ++s2) {
            u32x4 pw = {pk2(s[kt][8 * s2 + 0], s[kt][8 * s2 + 1]), pk2(s[kt][8 * s2 + 2], s[kt][8 * s2 + 3]),
                        pk2(s[kt][8 * s2 + 4], s[kt][8 * s2 + 5]), pk2(s[kt][8 * s2 + 6], s[kt][8 * s2 + 7])};
            if constexpr (LANEOFF) { pw[0] &= keep; pw[1] &= keep; pw[2] &= keep; pw[3] &= keep; }
            pp[kt * 2 + s2] = pw;
        }
}
DI void pv_packed(const u32x4 (&pp)[4], const bf16x8 (&vf)[2][2][2], f32x16 (&o)[2]) {
    __builtin_amdgcn_s_setprio(1);
#pragma unroll
    for (int kt = 0; kt < 2; ++kt)
#pragma unroll
        for (int s2 = 0; s2 < 2; ++s2) {
            const bf16x8 pb = __builtin_bit_cast(bf16x8, pp[kt * 2 + s2]);
#pragma unroll
            for (int dt = 0; dt < 2; ++dt) o[dt] = MFMA32(vf[kt][s2][dt], pb, o[dt]);
        }
    __builtin_amdgcn_s_setprio(0);
}
template <class Mask> DI void softmax_masked(f32x16 (&s)[2], int tile, const Mask& mask, float c, float& m, float& l, f32x16 (&o)[2], int lane) {
    const int h = lane >> 5;
    float mx = -1e30f;
#pragma unroll
    for (int kt = 0; kt < 2; ++kt)
#pragma unroll
        for (int reg = 0; reg < 16; ++reg) {
            const int key = 32 * kt + (reg & 7) + 8 * h + 16 * (reg >> 3);
            const float x = mask(tile, key) ? s[kt][reg] : -1e30f;
            s[kt][reg] = x; mx = fmaxf(mx, x);
        }
    mx = fmaxf(mx, __shfl_xor(mx, 32));
    const float mn = fmaxf(m, mx), alpha = ex2((m - mn) * c), nmc = -mn * c;
    m = mn;
    float sum = 0.f;
#pragma unroll
    for (int kt = 0; kt < 2; ++kt)
#pragma unroll
        for (int reg = 0; reg < 16; ++reg) {
            const float x = s[kt][reg];
            const float p = (x > -5e29f) ? ex2(__builtin_fmaf(x, c, nmc)) : 0.f;
            s[kt][reg] = p; sum += p;
        }
    l = l * alpha + sum;
    o[0] *= alpha; o[1] *= alpha;
}
template <bool LANEOFF> DI void softmax_full(f32x16 (&s)[2], bool lane_on, float c, float& m, float& l, f32x16 (&o)[2]) {
    float mx0 = fmaxf(s[0][0], s[1][0]), mx1 = fmaxf(s[0][1], s[1][1]);
#pragma unroll
    for (int reg = 2; reg < 16; reg += 2) { mx0 = fmaxf(mx0, fmaxf(s[0][reg], s[1][reg])); mx1 = fmaxf(mx1, fmaxf(s[0][reg + 1], s[1][reg + 1])); }
    float mx = fmaxf(mx0, mx1);
    mx = fmaxf(mx, __shfl_xor(mx, 32));
    if constexpr (LANEOFF) mx = lane_on ? mx : -1e30f;
    const float mn = fmaxf(m, mx);
    if (__any(mn > m)) { const float alpha = ex2((m - mn) * c); l *= alpha; o[0] *= alpha; o[1] *= alpha; }
    m = mn;
    const float nmc = -mn * c;
    float sum0 = 0.f, sum1 = 0.f;
#pragma unroll
    for (int kt = 0; kt < 2; ++kt)
#pragma unroll
        for (int reg = 0; reg < 16; reg += 2) {
            const float p0 = ex2(__builtin_fmaf(s[kt][reg], c, nmc)), p1 = ex2(__builtin_fmaf(s[kt][reg + 1], c, nmc));
            s[kt][reg] = p0; s[kt][reg + 1] = p1; sum0 += p0; sum1 += p1;
        }
    float sum = sum0 + sum1;
    if constexpr (LANEOFF) sum = lane_on ? sum : 0.f;
    l += sum;
}

struct TileRegs { u32x4 k, v, p; };
template <int DQK, bool LANEOFF, bool STAG, class TileOf, class Mask, class Skip>
DI void attn_run(LAS unsigned char* lds, const bf16_t* Kg, const bf16_t* Kpe, const bf16_t* Vg, int ldv, int ntiles,
                 const TileOf& tile_of, const Mask& mask, const Skip& skip, float c, const bf16x8 (&qf)[DQK / 16], float& m, float& l, f32x16 (&o)[2]) {
    constexpr int KSTR = DQK * 2 + 16;
    const int tid = my_tid(), lane = tid & 63;
    const int krow = tid >> 3, kch = tid & 7, prow = (tid >> 2) & 63, pch = tid & 3;
    TileRegs RA, RB;
    asm volatile("" : "=v"(RA.k), "=v"(RA.v), "=v"(RA.p), "=v"(RB.k), "=v"(RB.v), "=v"(RB.p));
#define ATT_LOAD(R, tt) do { const int t_ = (tt); (R).k = *(const u32x4*)(Kg + ((size_t)(t_ * 64 + krow)) * 64 + kch * 8); (R).v = *(const u32x4*)(Vg + (size_t)krow * ldv + t_ * 64 + kch * 8); \
        if constexpr (DQK == 96) { if (tid < 256) (R).p = *(const u32x4*)(Kpe + ((size_t)(t_ * 64 + prow)) * 32 + pch * 8); } } while (0)
#define ATT_WRITE(R, kb_, vb_) do { *(LAS u32x4*)(lds + AT_K + (kb_) + krow * KSTR + kch * 16) = (R).k; *(LAS u32x4*)(lds + AT_V + (vb_) + krow * 144 + kch * 16) = (R).v; \
        if constexpr (DQK == 96) { if (tid < 256) *(LAS u32x4*)(lds + AT_K + (kb_) + prow * KSTR + 128 + pch * 16) = (R).p; } } while (0)
#define ATT_ITER(i_, RL, RW) do { const int t = tile_of(i_); const int kb = ((i_) & 1) * AT_KB, vb = ((i_) & 1) * AT_VB; \
        if ((i_) + 2 < ntiles) ATT_LOAD(RL, tile_of((i_) + 2)); \
        if (!skip(t)) { \
            f32x16 s[2]; \
            qk_tile<DQK>(lds + AT_K + kb, qf, s, lane); \
            bf16x8 vf[2][2][2]; v_load(vf, lds + AT_V + vb, lane); \
            unsigned keep = 0xffffffffu; \
            if (mask.full(t)) { const bool on = mask.lane_on(t); softmax_full<LANEOFF>(s, on, c, m, l, o); if constexpr (LANEOFF) keep = on ? 0xffffffffu : 0u; } \
            else softmax_masked(s, t, mask, c, m, l, o, lane); \
            u32x4 pp[4]; pack_p<LANEOFF>(s, keep, pp); pv_packed(pp, vf, o); \
        } \
        if ((i_) + 1 < ntiles) ATT_WRITE(RW, AT_KB - kb, AT_VB - vb); \
        __syncthreads(); } while (0)
    __syncthreads();
    if (ntiles > 0) { ATT_LOAD(RA, tile_of(0)); ATT_WRITE(RA, 0, 0); }
    if (ntiles > 1) ATT_LOAD(RB, tile_of(1));
    __syncthreads();
    for (int i = 0; i < ntiles; i += 2) {
        ATT_ITER(i, RA, RB);
        if (i + 1 < ntiles) ATT_ITER(i + 1, RB, RA);
    }
#undef ATT_LOAD
#undef ATT_WRITE
#undef ATT_ITER
}

struct TileId { DI int operator()(int i) const { return i; } };
struct TileOff { int off; DI int operator()(int i) const { return off + i; } };
struct TileList { const LAS int* lst; DI int operator()(int i) const { return lst[i]; } };
struct NoSkip { DI bool operator()(int) const { return false; } };
struct SkipAbove { int tmax; DI bool operator()(int t) const { return t * 64 > tmax; } };
struct MaskCmp { int tq;
    DI bool operator()(int t, int key) const { return 16 * (64 * t + key) + 31 <= tq; }
    DI bool full(int) const { return false; } DI bool lane_on(int) const { return true; } };
struct MaskSlc { int tq; unsigned lo, hi; int qt;
    DI bool bit(int t) const { return ((t < 32 ? (lo >> t) : (hi >> (t - 32))) & 1u) != 0u; }
    DI bool operator()(int t, int key) const { return bit(t) && (64 * t + key <= tq); }
    DI bool full(int t) const { return t < qt; } DI bool lane_on(int t) const { return bit(t); } };
struct MaskWin { int tq, tq0w;
    DI bool operator()(int t, int key) const { const int d = tq - (64 * t + key); return d >= 0 && d < 512; }
    DI bool full(int t) const { return (64 * t + 63 <= tq0w) && (tq0w + 31 - 64 * t <= 511); } DI bool lane_on(int) const { return true; } };
struct MaskCausal { int tq, tq0w;
    DI bool operator()(int t, int key) const { return 64 * t + key <= tq; }
    DI bool full(int t) const { return 64 * t + 63 <= tq0w; } DI bool lane_on(int) const { return true; } };

struct Bufs {
    const bf16_t *QN, *KS, *KW, *VST, *VWT, *KCMP, *VCMPT, *QM, *KM, *KPE, *VMT; const float* GN; bf16_t* OAB;
};

DI void zero16(f32x16& v) {
#pragma unroll
    for (int i = 0; i < 16; ++i) v[i] = 0.f;
}

DI void nsa_unit(const Bufs& B, LAS unsigned char* lds, int b, int g, int qt) {
    const int tid = my_tid(), lane = tid & 63, w = __builtin_amdgcn_readfirstlane(tid >> 6), r = w >> 1, hh = lane >> 5;
    const int qs = (w & 1) * 32 + (lane & 31), bg = b * 2 + g, tq = qt * 64 + qs, head = g * 4 + r;
    const size_t row = (size_t)b * S + tq;
    LAS unsigned* sImp = (LAS unsigned*)(lds + AT_IMP);
    LAS unsigned* sSel = (LAS unsigned*)(lds + AT_SEL);
    LAS int* sList = (LAS int*)(lds + AT_LIST);
    LAS int* sCnt = (LAS int*)(lds + AT_CNT);
    bf16x8 qf[4];
#pragma unroll
    for (int ks = 0; ks < 4; ++ks) qf[ks] = *(const bf16x8*)(B.QN + row * 512 + head * 64 + ks * 16 + hh * 8);
    for (int i = tid; i < 4096; i += 512) sImp[i] = 0u;
    const float c = 0.125f * LOG2E;
    LAS float* stash = (LAS float*)(lds + AT_ACC + w * 8192) + lane;
    float m, l; f32x16 o[2];
    const int nct = (4 * qt + 2) / 64 + 1;
    m = -1e30f; l = 0.f; zero16(o[0]); zero16(o[1]);
    attn_run<64, false, STAG_CMP>(lds, B.KCMP + (size_t)bg * 256 * 64, nullptr, B.VCMPT + (size_t)bg * 64 * 256, 256, nct, TileId{}, MaskCmp{tq}, NoSkip{}, c, qf, m, l, o);
    const float nmc = -m * c;
    float inv;
    { const float lt = l + __shfl_xor(l, 32); inv = lt > 0.f ? 1.f / lt : 0.f; }
    { const float ig0 = inv * B.GN[row * 24 + head];
#pragma unroll
    for (int dt = 0; dt < 2; ++dt)
#pragma unroll
        for (int e = 0; e < 16; ++e) stash[(dt * 16 + e) * 64] = o[dt][e] * ig0; }
    for (int ct = 0; ct < nct; ++ct) {
        __syncthreads();
        { const int krow = tid >> 3, kch = tid & 7;
          *(LAS u32x4*)(lds + AT_K + krow * 144 + kch * 16) = *(const u32x4*)(B.KCMP + ((size_t)bg * 256 + ct * 64 + krow) * 64 + kch * 8); }
        __syncthreads();
        f32x16 s[2];
        qk_tile<64>(lds + AT_K, qf, s, lane);
#pragma unroll
        for (int kt = 0; kt < 2; ++kt)
#pragma unroll
            for (int a = 0; a < 4; ++a) {
                float pv[4];
#pragma unroll
                for (int bb = 0; bb < 4; ++bb) {
                    const int reg = 4 * a + bb;
                    const int n = 64 * ct + 32 * kt + (reg & 7) + 8 * hh + 16 * (reg >> 3);
                    pv[bb] = (16 * n + 31 <= tq) ? ex2(__builtin_fmaf(s[kt][reg], c, nmc)) * inv : 0.f;
                }
                const int j = 16 * ct + 8 * kt + (a & 1) + 2 * hh + 4 * (a >> 1);
                const float carry = 0.5f * pv[3], direct = (pv[0] + pv[1]) + (pv[2] + carry);
                if (direct > 0.f) __hip_atomic_fetch_add(sImp + qs * 64 + j, (unsigned)(direct * 268435456.f + 0.5f), __ATOMIC_RELAXED, __HIP_MEMORY_SCOPE_WORKGROUP);
                if (carry > 0.f && j < 63) __hip_atomic_fetch_add(sImp + qs * 64 + j + 1, (unsigned)(carry * 268435456.f + 0.5f), __ATOMIC_RELAXED, __HIP_MEMORY_SCOPE_WORKGROUP);
            }
    }
    __syncthreads();
    {
        const int q = tid >> 3, sub = tid & 7;
        unsigned bits = 0;
        if (qt < 16) {
#pragma unroll
            for (int k = 0; k < 8; ++k) if (sub * 8 + k <= qt) bits |= 1u << k;
        } else {
            unsigned v[8]; int cnt[8];
#pragma unroll
            for (int k = 0; k < 8; ++k) { v[k] = sImp[q * 64 + sub * 8 + k]; cnt[k] = 0; }
            for (int jp = 1; jp <= qt - 2; ++jp) {
                const unsigned vp = sImp[q * 64 + jp];
#pragma unroll
                for (int k = 0; k < 8; ++k) cnt[k] += (vp > v[k] || (vp == v[k] && jp < sub * 8 + k)) ? 1 : 0;
            }
#pragma unroll
            for (int k = 0; k < 8; ++k) {
                const int j = sub * 8 + k;
                const bool forced = (j == 0) || (j == qt) || (j == qt - 1), cand = (j >= 1) && (j <= qt - 2);
                if (forced || (cand && cnt[k] < 13)) bits |= 1u << k;
            }
        }
        unsigned lo = sub < 4 ? bits << (sub * 8) : 0u, hi = sub >= 4 ? bits << ((sub - 4) * 8) : 0u;
        lo |= __shfl_xor(lo, 1); hi |= __shfl_xor(hi, 1); lo |= __shfl_xor(lo, 2); hi |= __shfl_xor(hi, 2); lo |= __shfl_xor(lo, 4); hi |= __shfl_xor(hi, 4);
        if (sub == 0) { sSel[q * 2] = lo; sSel[q * 2 + 1] = hi; }
    }
    __syncthreads();
    if (w == 0) {
        unsigned lo = sSel[lane * 2], hi = sSel[lane * 2 + 1];
#pragma unroll
        for (int x = 1; x < 64; x <<= 1) { lo |= __shfl_xor(lo, x); hi |= __shfl_xor(hi, x); }
        if (lane == 0) {
            int n = 0;
            for (int j = 0; j <= qt; ++j) { const unsigned bit = j < 32 ? (lo >> j) : (hi >> (j - 32)); if (bit & 1u) sList[n++] = j; }
            *sCnt = n;
        }
    }
    __syncthreads();
    {
        const int nsel = *sCnt;
        const unsigned lo = sSel[qs * 2], hi = sSel[qs * 2 + 1];
        m = -1e30f; l = 0.f; zero16(o[0]); zero16(o[1]);
        attn_run<64, true, STAG_SLC>(lds, B.KS + (size_t)bg * S * 64, nullptr, B.VST + (size_t)bg * 64 * S, S, nsel, TileList{sList}, MaskSlc{tq, lo, hi, qt}, NoSkip{}, c, qf, m, l, o);
        const float lt = l + __shfl_xor(l, 32); const float iv = (lt > 0.f ? 1.f / lt : 0.f) * B.GN[row * 24 + 8 + head];
#pragma unroll
        for (int dt = 0; dt < 2; ++dt)
#pragma unroll
            for (int e = 0; e < 16; ++e) stash[(dt * 16 + e) * 64] += o[dt][e] * iv;
    }
    {
        const int t0 = qt >= 8 ? qt - 8 : 0;
        m = -1e30f; l = 0.f; zero16(o[0]); zero16(o[1]);
        attn_run<64, false, STAG_WIN>(lds, B.KW + (size_t)bg * S * 64, nullptr, B.VWT + (size_t)bg * 64 * S, S, qt - t0 + 1, TileOff{t0}, MaskWin{tq, qt * 64 + (w & 1) * 32}, NoSkip{}, c, qf, m, l, o);
        const float lt = l + __shfl_xor(l, 32); const float iv = (lt > 0.f ? 1.f / lt : 0.f) * B.GN[row * 24 + 16 + head];
#pragma unroll
        for (int dt = 0; dt < 2; ++dt)
#pragma unroll
            for (int e = 0; e < 16; ++e) o[dt][e] = stash[(dt * 16 + e) * 64] + o[dt][e] * iv;
    }
    bf16_t* orow = B.OAB + row * 1024 + head * 64;
#pragma unroll
    for (int dt = 0; dt < 2; ++dt)
#pragma unroll
        for (int a = 0; a < 4; ++a) {
            u32x2 w2 = {pk2(o[dt][4 * a], o[dt][4 * a + 1]), pk2(o[dt][4 * a + 2], o[dt][4 * a + 3])};
            *(u32x2*)(orow + 32 * dt + 8 * a + 4 * hh) = w2;
        }
}

DI void mla_unit(const Bufs& B, LAS unsigned char* lds, int b, int h, int qb) {
    const int tid = my_tid(), lane = tid & 63, w = __builtin_amdgcn_readfirstlane(tid >> 6), hh = lane >> 5;
    const int tq = qb * 256 + w * 32 + (lane & 31);
    const size_t row = (size_t)b * S + tq;
    bf16x8 qf[6];
#pragma unroll
    for (int ks = 0; ks < 6; ++ks) qf[ks] = *(const bf16x8*)(B.QM + row * 768 + h * 96 + ks * 16 + hh * 8);
    const float c = 0.10206207261596575f * LOG2E;
    float m = -1e30f, l = 0.f; f32x16 o[2]; zero16(o[0]); zero16(o[1]);
    attn_run<96, false, STAG_MLA>(lds, B.KM + (size_t)(b * 8 + h) * S * 64, B.KPE + (size_t)b * S * 32, B.VMT + (size_t)(b * 8 + h) * 64 * S, S, 4 * (qb + 1),
                 TileId{}, MaskCausal{tq, qb * 256 + w * 32}, SkipAbove{qb * 256 + w * 32 + 31}, c, qf, m, l, o);
    const float lt = l + __shfl_xor(l, 32); const float iv = lt > 0.f ? 1.f / lt : 0.f;
    bf16_t* orow = B.OAB + row * 1024 + 512 + h * 64;
#pragma unroll
    for (int dt = 0; dt < 2; ++dt)
#pragma unroll
        for (int a = 0; a < 4; ++a) {
            u32x2 w2 = {pk2(o[dt][4 * a] * iv, o[dt][4 * a + 1] * iv), pk2(o[dt][4 * a + 2] * iv, o[dt][4 * a + 3] * iv)};
            *(u32x2*)(orow + 32 * dt + 8 * a + 4 * hh) = w2;
        }
}

DI void attn_phase(const Bufs& B, LAS unsigned char* lds, unsigned* counter) {
    LAS int* sUnit = (LAS int*)(lds + MISC_OFF); int it_ = 0; (void)sUnit; (void)it_; (void)counter;
    for (;;) {
#if ATT_STATIC
        __syncthreads();
        const int u = (int)blockIdx.x + 256 * it_; ++it_;
        if (u >= 2048) break;
#else
        __syncthreads();
        if (threadIdx.x == 0) *sUnit = (int)atomicAdd(counter, 1u);
        __syncthreads();
        const int u = *sUnit;
        if (u >= 2048) break;
#endif
        const int i = u >> 1;
        if ((u & 1) == 0) {
#if EXP_ATT == 2
            { const int b = (i & 63) >> 3, h = i & 7, qb = 15 - (i >> 6);
              for (int e = threadIdx.x; e < 2048; e += 512) *(u32x4*)(B.OAB + ((size_t)b * S + qb * 256 + (e >> 3)) * 1024 + 512 + h * 64 + (e & 7) * 8) = (u32x4){0x3c003c00u, 0x3c003c00u, 0x3c003c00u, 0x3c003c00u}; }
#else
            mla_unit(B, lds, (i & 63) >> 3, i & 7, 15 - (i >> 6));
#if ATT_DUP == 1
            __syncthreads(); mla_unit(B, lds, (i & 63) >> 3, i & 7, 15 - (i >> 6));
#endif
#endif
        } else {
#if EXP_ATT == 1
            { const int b = (i & 15) >> 1, g = i & 1, qt = 63 - (i >> 4);
              for (int e = threadIdx.x; e < 2048; e += 512) *(u32x4*)(B.OAB + ((size_t)b * S + qt * 64 + (e >> 5)) * 1024 + g * 256 + (e & 31) * 8) = (u32x4){0x3c003c00u, 0x3c003c00u, 0x3c003c00u, 0x3c003c00u}; }
#else
            nsa_unit(B, lds, (i & 15) >> 1, i & 1, 63 - (i >> 4));
#if ATT_DUP == 2
            __syncthreads(); nsa_unit(B, lds, (i & 15) >> 1, i & 1, 63 - (i >> 4));
#endif
#endif
        }
    }
}

DI float wave_sum(float v) {
#pragma unroll
    for (int o = 1; o < 64; o <<= 1) v += __shfl_xor(v, o);
    return v;
}
DI void norm_rows_bf16(const float* x, const float* g, bf16_t* xn) {
    const int tid_ = my_tid(), lane = tid_ & 63, gw = blockIdx.x * 8 + (tid_ >> 6), ngw = gridDim.x * 8;
    f32x4 gv[4];
#pragma unroll
    for (int j = 0; j < 4; ++j) gv[j] = ((const f32x4*)g)[lane + 64 * j];
    for (int r = gw; r < M; r += ngw) {
        const f32x4* xr = (const f32x4*)(x + (size_t)r * D) + lane;
        f32x4 v[4]; float s = 0.f;
#pragma unroll
        for (int j = 0; j < 4; ++j) { v[j] = xr[64 * j]; s += (v[j][0] * v[j][0] + v[j][1] * v[j][1]) + (v[j][2] * v[j][2] + v[j][3] * v[j][3]); }
        const float rstd = rsqrtf(wave_sum(s) * (1.f / D) + EPS);
        u32x2* o8 = (u32x2*)(xn + (size_t)r * D) + lane;
#pragma unroll
        for (int j = 0; j < 4; ++j) o8[64 * j] = (u32x2){pk2(v[j][0] * rstd * gv[j][0], v[j][1] * rstd * gv[j][1]), pk2(v[j][2] * rstd * gv[j][2], v[j][3] * rstd * gv[j][3])};
    }
}
DI void norm_rows_f32_inplace(float* x, const float* g) {
    const int tid_ = my_tid(), lane = tid_ & 63, gw = blockIdx.x * 8 + (tid_ >> 6), ngw = gridDim.x * 8;
    f32x4 gv[4];
#pragma unroll
    for (int j = 0; j < 4; ++j) gv[j] = ((const f32x4*)g)[lane + 64 * j];
    for (int r = gw; r < M; r += ngw) {
        f32x4* xr = (f32x4*)(x + (size_t)r * D) + lane;
        f32x4 v[4]; float s = 0.f;
#pragma unroll
        for (int j = 0; j < 4; ++j) { v[j] = xr[64 * j]; s += (v[j][0] * v[j][0] + v[j][1] * v[j][1]) + (v[j][2] * v[j][2] + v[j][3] * v[j][3]); }
        const float rstd = rsqrtf(wave_sum(s) * (1.f / D) + EPS);
#pragma unroll
        for (int j = 0; j < 4; ++j) xr[64 * j] = (f32x4){v[j][0] * rstd * gv[j][0], v[j][1] * rstd * gv[j][1], v[j][2] * rstd * gv[j][2], v[j][3] * rstd * gv[j][3]};
    }
}

DI int perm64(int p) { return (p >> 1) + 32 * (p & 1); }
DI int perm32r(int p) { return (p >> 1) + 16 * (p & 1); }
DI int map_in(int c) {
    if (c < 512) return (c & ~63) + perm64(c & 63);
    if (c < 1280) { const int t = (c - 512) >> 8, cc = (c - 512) & 255, kv = cc >> 7, g = (cc >> 6) & 1, p = cc & 63; return 512 + t * 256 + kv * 128 + g * 64 + (kv == 0 ? perm64(p) : p); }
    if (c < 1536) return 1304 + (c - 1280);
    if (c < 1792) { const int cc = c - 1536; if (cc < 128) return 1560 + cc; if (cc < 160) return 1688 + perm32r(cc - 128); if (cc < 184) return 1280 + (cc - 160); return -1; }
    if (c < 2816) return 1720 + (c - 1792);
    return 2744 + (c - 2816);
}
struct Wts {
    const float *w_in, *cmp_pe, *cmp_w1, *cmp_w2, *nsa_w_o, *q_norm, *kv_norm, *w_uq, *w_ukv, *mla_w_o, *w_out, *w_up, *w_down;
};
template <int JOB> DI float prep_get(const Wts& W, int n, int k) {
    if constexpr (JOB == 0) { const int c = map_in(n); return c >= 0 ? W.w_in[(size_t)k * IN_COLS + c] : 0.f; }
    if constexpr (JOB == 1) { const int j = n >> 8, h = n & 255, lp = k >> 6, p = k & 63, d = j == 0 ? perm64(p) : p; return W.cmp_w1[((size_t)j * 2048 + lp * 64 + d) * 256 + h]; }
    if constexpr (JOB == 2) { const int j = n >> 8, np = n & 255; return np < 64 ? W.cmp_w2[((size_t)j * 256 + k) * 64 + (j == 0 ? perm64(np) : np)] : 0.f; }
    if constexpr (JOB == 3) { return n < 1024 ? W.nsa_w_o[(size_t)k * 1024 + n] : W.mla_w_o[(size_t)k * 1024 + (n - 1024)]; }
    if constexpr (JOB == 4) { const int hh = n / 96, c = n - hh * 96; const int sc = c < 64 ? n : hh * 96 + 64 + perm32r(c - 64); return W.q_norm[k] * W.w_uq[(size_t)k * 768 + sc]; }
    if constexpr (JOB == 5) { return k < 128 ? W.kv_norm[k] * W.w_ukv[(size_t)k * 1024 + n] : 0.f; }
    if constexpr (JOB == 6) { return W.w_out[(size_t)k * 1024 + n]; }
    if constexpr (JOB == 7) { return W.w_up[(size_t)k * 4096 + n]; }
    if constexpr (JOB == 8) { return W.w_down[(size_t)k * 1024 + n]; }
    return 0.f;
}
template <int JOB> DI void prep_tile(const Wts& W, LAS float* scr, bf16_t* dst, int ldd, int n0, int k0) {
    const int tid = my_tid();
#pragma unroll
    for (int it = 0; it < 8; ++it) { const int kk = it * 8 + (tid >> 6), nn = tid & 63; scr[kk * 65 + nn] = prep_get<JOB>(W, n0 + nn, k0 + kk); }
    __syncthreads();
    { const int n = tid >> 3, kc = tid & 7; const LAS float* s = scr + (kc * 8) * 65 + n;
      u32x4 o = {pk2(s[0], s[65]), pk2(s[130], s[195]), pk2(s[260], s[325]), pk2(s[390], s[455])};
      *(u32x4*)(dst + (size_t)(n0 + n) * ldd + k0 + kc * 8) = o; }
    __syncthreads();
}
DI void prep_tile_vec(const float* src, int ldsrc, LAS float* scr, bf16_t* dst, int ldd, int n0, int k0) {
    const int tid = my_tid();
#pragma unroll
    for (int it = 0; it < 2; ++it) { const int kk = it * 32 + (tid >> 4), n4 = (tid & 15) * 4;
        const f32x4 v = *(const f32x4*)(src + (size_t)(k0 + kk) * ldsrc + n4);
        LAS float* d = scr + kk * 65 + n4; d[0] = v[0]; d[1] = v[1]; d[2] = v[2]; d[3] = v[3]; }
    __syncthreads();
    { const int n = tid >> 3, kc = tid & 7; const LAS float* s = scr + (kc * 8) * 65 + n;
      u32x4 o = {pk2(s[0], s[65]), pk2(s[130], s[195]), pk2(s[260], s[325]), pk2(s[390], s[455])};
      *(u32x4*)(dst + (size_t)(n0 + n) * ldd + k0 + kc * 8) = o; }
    __syncthreads();
}
DI void prep_phase(const Wts& W, unsigned char* ws, LAS unsigned char* lds, int layer) {
    LAS float* scr = (LAS float*)lds;
    const int tid = my_tid();
    constexpr int T0 = 960, T1 = T0 + 256, T2 = T1 + 32, T3 = T2 + 256, T4 = T3 + 48, T5 = T4 + 64, T6_ = T5 + 256, T7 = T6_ + 1024, T8 = T7 + 1024, TB = T8 + 8;
    for (int job = blockIdx.x; job < TB; job += gridDim.x) {
        int r = job;
        if (r < T0) { const int n0 = (r >> 4) * 64, k0 = (r & 15) * 64;
            if ((n0 >= 1280 && n0 < 1536) || n0 >= 1792) prep_tile_vec(W.w_in + map_in(n0), IN_COLS, scr, (bf16_t*)(ws + WS_WIN), 1024, n0, k0);
            else prep_tile<0>(W, scr, (bf16_t*)(ws + WS_WIN), 1024, n0, k0);
            continue; }
        if (r < T1) { r -= T0; prep_tile<1>(W, scr, (bf16_t*)(ws + WS_W1T), 2048, (r >> 5) * 64, (r & 31) * 64); continue; }
        if (r < T2) { r -= T1; prep_tile<2>(W, scr, (bf16_t*)(ws + WS_W2T), 256, (r >> 2) * 64, (r & 3) * 64); continue; }
        if (r < T3) { r -= T2; const int n0 = (r >> 3) * 64, k0 = (r & 7) * 64;
            prep_tile_vec(n0 < 1024 ? W.nsa_w_o + n0 : W.mla_w_o + (n0 - 1024), 1024, scr, (bf16_t*)(ws + WS_WOAB), 512, n0, k0); continue; }
        if (r < T4) { r -= T3; prep_tile<4>(W, scr, (bf16_t*)(ws + WS_WUQ), 256, (r >> 2) * 64, (r & 3) * 64); continue; }
        if (r < T5) { r -= T4; prep_tile<5>(W, scr, (bf16_t*)(ws + WS_WUKV), 256, (r >> 2) * 64, (r & 3) * 64); continue; }
        if (r < T6_) { r -= T5; const int n0 = (r >> 4) * 64; prep_tile_vec(W.w_out + n0, 1024, scr, (bf16_t*)(ws + WS_WOUT), 1024, n0, (r & 15) * 64); continue; }
        if (r < T7) { r -= T6_; const int n0 = (r >> 4) * 64; prep_tile_vec(W.w_up + n0, 4096, scr, (bf16_t*)(ws + WS_WUP), 1024, n0, (r & 15) * 64); continue; }
        if (r < T8) { r -= T7; const int n0 = (r >> 6) * 64; prep_tile_vec(W.w_down + n0, 1024, scr, (bf16_t*)(ws + WS_WDN), 4096, n0, (r & 63) * 64); continue; }
        {
            r -= T8; const int j = r >> 2, hc = r & 3, kk = tid >> 6, hx = tid & 63, h = hc * 64 + hx;
            float a = 0.f;
            for (int i = 0; i < 256; ++i) { const int k = kk + 8 * i; a += W.cmp_pe[j * 2048 + k] * W.cmp_w1[((size_t)j * 2048 + k) * 256 + h]; }
            scr[kk * 64 + hx] = a;
            __syncthreads();
            if (tid < 64) { float s = 0.f; for (int q = 0; q < 8; ++q) s += scr[q * 64 + tid]; ((float*)(ws + WS_CB1))[j * 256 + hc * 64 + tid] = s; }
            __syncthreads();
        }
    }
    if (layer == 0) {
        f32x2* cs64 = (f32x2*)(ws + WS_CS64); f32x2* cs32 = (f32x2*)(ws + WS_CS32);
        for (int idx = blockIdx.x * 512 + tid; idx < S * 48; idx += gridDim.x * 512) {
            int pos, i; float inv;
            if (idx < S * 32) { pos = idx >> 5; i = idx & 31; inv = (float)exp2(-(double)i * (13.287712379549449 / 32.0)); }
            else { const int e = idx - S * 32; pos = e >> 4; i = e & 15; inv = (float)exp2(-(double)i * (13.287712379549449 / 16.0)); }
            const float ang = (float)pos * inv;
            const double rev = (double)ang * 0.15915494309189535; const float fr = (float)(rev - floor(rev));
            const f32x2 v = {__builtin_amdgcn_cosf(fr), __builtin_amdgcn_sinf(fr)};
            if (idx < S * 32) cs64[idx] = v; else cs32[idx - S * 32] = v;
        }
    }
}

struct Params { const float* in[17]; float* out; unsigned char* ws; int ph_lo, ph_hi; };
typedef const __attribute__((address_space(4))) unsigned char* kaptr_t;
DI const float* karg_ptr(int byte_off) { kaptr_t ka = (kaptr_t)__builtin_amdgcn_kernarg_segment_ptr(); asm volatile("" : "+s"(ka)); return *(const float* const __attribute__((address_space(4)))*)(ka + byte_off); }
#define KIN(i) karg_ptr(8 * (i))

DI void grid_barrier_cg(cg::grid_group& grid) {
    asm volatile("s_waitcnt vmcnt(0) lgkmcnt(0)" ::: "memory");
    __syncthreads();
    if (threadIdx.x < 64) asm volatile("buffer_wbl2 sc1\n\ts_waitcnt vmcnt(0)" ::: "memory");
    __syncthreads();
    grid.sync();
    asm volatile("buffer_inv sc1\n\ts_waitcnt vmcnt(0)" ::: "memory");
}

#define XB_TMO      128
#define XB_XCNT(j)  (256  + 64 * (j))
#define XB_XSUB(j)  (1280 + 64 * (j))
#define XB_XGEN(j)  (2304 + 64 * (j))
#define XB_TOP      3328
#define XB_TOPGEN   3392
#define XCD_BAR_WORDS 3456
#define XB_SPIN_CAP (1u << 18)
DI unsigned xb_ld(unsigned* p)              { return __hip_atomic_load(p, __ATOMIC_RELAXED, __HIP_MEMORY_SCOPE_AGENT); }
DI unsigned xb_add(unsigned* p, unsigned v) { return __hip_atomic_fetch_add(p, v, __ATOMIC_RELAXED, __HIP_MEMORY_SCOPE_AGENT); }
DI unsigned xb_xcc_id() { return (unsigned)__builtin_amdgcn_s_getreg((3 << 11) | 20) & 0xFu; }
#define XB_SPIN(cond, bar) do { unsigned _sp = 0; while (cond) { __builtin_amdgcn_s_sleep(1); \
    if ((++_sp & 255u) == 0u) { if (xb_ld(&(bar)[XB_TMO])) break; if (_sp > XB_SPIN_CAP) { atomicAdd(&(bar)[XB_TMO], 1u); break; } } } } while (0)
DI void xcd_barrier_complete(unsigned* bar, unsigned x, unsigned& nloc, unsigned& nx) {
    const unsigned G = gridDim.x * gridDim.y * gridDim.z;
    unsigned sum, cnt, mine, sp = 0u;
    for (;;) {
        sum = 0u; cnt = 0u; mine = 0u;
#pragma unroll
        for (unsigned j = 0; j < 16; ++j) { const unsigned c = xb_ld(&bar[XB_XCNT(j)]); sum += c; cnt += (c > 0u) ? 1u : 0u; mine = (j == x) ? c : mine; }
        if (sum == G) break;
        __builtin_amdgcn_s_sleep(1);
        if ((++sp & 255u) == 0u) { if (xb_ld(&bar[XB_TMO])) break; if (sp > XB_SPIN_CAP) { atomicAdd(&bar[XB_TMO], 1u); break; } }
    }
    nloc = mine > 0u ? mine : 1u; nx = cnt > 0u ? cnt : 1u;
}
DI void xcd_barrier(unsigned* bar, volatile LAS unsigned* st) {
    asm volatile("s_waitcnt vmcnt(0)" ::: "memory");
    __syncthreads();
    if (threadIdx.x == 0) {
        const unsigned x = xb_xcc_id();
        __builtin_amdgcn_s_waitcnt(0);
        unsigned nloc = st[0], nx = st[1];
        if (nloc == 0u) { xcd_barrier_complete(bar, x, nloc, nx); st[0] = nloc; st[1] = nx; }
        const unsigned old = xb_add(&bar[XB_XSUB(x)], 1u);
        const unsigned gen = old / nloc;
        if (old + 1u == (gen + 1u) * nloc) {
            __builtin_amdgcn_fence(__ATOMIC_RELEASE, "agent");
            asm volatile("s_waitcnt vmcnt(0)" ::: "memory");
            const unsigned og = xb_add(&bar[XB_TOP], 1u);
            const unsigned tg = og / nx;
            if (og + 1u == (tg + 1u) * nx) xb_add(&bar[XB_TOPGEN], 1u);
            else XB_SPIN(xb_ld(&bar[XB_TOPGEN]) == tg, bar);
            __builtin_amdgcn_fence(__ATOMIC_ACQUIRE, "agent");
            xb_add(&bar[XB_XGEN(x)], 1u);
            asm volatile("s_waitcnt vmcnt(0)" ::: "memory");
        } else {
            XB_SPIN(xb_ld(&bar[XB_XGEN(x)]) == gen, bar);
            __builtin_amdgcn_fence(__ATOMIC_ACQUIRE, "agent");
            asm volatile("s_waitcnt vmcnt(0)" ::: "memory");
        }
    }
    __syncthreads();
}
template <bool FIRST> DI void grid_barrier(cg::grid_group& grid, LAS unsigned char* lds) {
    unsigned* bar = (unsigned*)((unsigned char*)karg_ptr(144) + WS_BAR);
    if constexpr (FIRST) {
        grid_barrier_cg(grid);
        if (threadIdx.x == 0) (void)xb_add(&bar[XB_XCNT(xb_xcc_id())], 1u);
    } else {
        xcd_barrier(bar, (volatile LAS unsigned*)(lds + MISC_OFF + 64));
    }
}

#define PH_IN(k) (lo <= (k) && (k) < hi)
#define PH_SEAM(k) do { if (PH_IN(k) && PH_IN((k) + 1)) grid_barrier<(k) == 0>(grid, lds); } while (0)
#define PH_ENV() int G = gridDim.x, bx = blockIdx.x; asm volatile("" : "+s"(G), "+s"(bx)); unsigned char* ws = (unsigned char*)karg_ptr(144); float* X = (float*)karg_ptr(136); \
                 const int tid = my_tid(); bf16_t* XN = (bf16_t*)(ws + WS_XN); (void)tid; (void)X; (void)XN; (void)G; (void)bx

template <int L> DI void run_layer(LAS unsigned char* lds, cg::grid_group& grid, int lo, int hi) {
    constexpr int P0 = 10 * L;
    if (PH_IN(P0 + 0)) for (int rep_ = 0; rep_ < ((((DUP_MASK >> 0) & 1) && L > 0) ? 2 : 1); ++rep_) { if (rep_) grid_barrier<false>(grid, lds);
        PH_ENV();
        Wts W;
        W.w_in = KIN(2) + (size_t)L * 1024 * IN_COLS; W.cmp_pe = KIN(3) + (size_t)L * 2 * 2048; W.cmp_w1 = KIN(4) + (size_t)L * 2 * 2048 * 256;
        W.cmp_w2 = KIN(5) + (size_t)L * 2 * 256 * 64; W.nsa_w_o = KIN(6) + (size_t)L * 512 * 1024; W.q_norm = KIN(7) + L * 256; W.kv_norm = KIN(8) + L * 128;
        W.w_uq = KIN(9) + (size_t)L * 256 * 768; W.w_ukv = KIN(10) + (size_t)L * 128 * 1024; W.mla_w_o = KIN(11) + (size_t)L * 512 * 1024;
        W.w_out = KIN(12) + (size_t)L * 1024 * 1024; W.w_up = KIN(14) + (size_t)L * 1024 * 4096; W.w_down = KIN(15) + (size_t)L * 4096 * 1024;
        prep_phase(W, ws, lds, L);
        unsigned* ctl = (unsigned*)(ws + WS_CTL);
        if (L == 0 && bx == 0 && tid < 2 * NL) atomicExch(ctl + tid * 64, 0u);
        norm_rows_bf16(L == 0 ? KIN(0) : X, KIN(1) + L * D, XN);
    }
    PH_SEAM(P0 + 0);
    if (PH_IN(P0 + 1)) for (int rep_ = 0; rep_ < (((DUP_MASK >> 1) & 1) ? 2 : 1); ++rep_) { if (rep_) grid_barrier<false>(grid, lds);
        PH_ENV();
        pg8::Gemm g{XN, (const bf16_t*)(ws + WS_WIN), 1024, 1024}; pg8::StaticOrder So; So.init(M, NIN, G, bx);
        EpiWrap<EpiInImpl> E; E.ws = ws;
        pg8::gemm_phase(lds, g, So, E);
    }
    PH_SEAM(P0 + 1);
    if (PH_IN(P0 + 2)) for (int rep_ = 0; rep_ < (((DUP_MASK >> 2) & 1) ? 2 : 1); ++rep_) { if (rep_) grid_barrier<false>(grid, lds);
        PH_ENV();
        if (bx < 32) {
            pg8::CmpOrder So{G, bx};
            { pg8::Gemm g{(const bf16_t*)(ws + WS_KCV), (const bf16_t*)(ws + WS_W1T), 1024, 2048}; EpiWrap<EpiC1Impl> E; E.ws = ws; pg8::gemm_phase(lds, g, So, E); }
            { pg8::Gemm g{(const bf16_t*)(ws + WS_HC), (const bf16_t*)(ws + WS_W2T), 256, 256}; EpiWrap<EpiC2Impl> E; E.ws = ws; pg8::gemm_phase(lds, g, So, E); }
        } else {
            { pg8::Gemm g{(const bf16_t*)(ws + WS_CQ), (const bf16_t*)(ws + WS_WUQ), 256, 256}; pg8::StaticOrder So; So.init(M, 768, G - 32, bx - 32);
              EpiWrap<EpiUQImpl> E; E.ws = ws;
              pg8::gemm_phase(lds, g, So, E); }
            { pg8::Gemm g{(const bf16_t*)(ws + WS_T6), (const bf16_t*)(ws + WS_WUKV), 256, 256}; pg8::StaticOrder So; So.init(M, 1024, G - 32, bx - 32);
              EpiWrap<EpiUKVImpl> E; E.ws = ws;
              pg8::gemm_phase(lds, g, So, E); }
        }
    }
    PH_SEAM(P0 + 2);
    if (PH_IN(P0 + 4)) for (int rep_ = 0; rep_ < (((DUP_MASK >> 4) & 1) ? 2 : 1); ++rep_) { if (rep_) grid_barrier<false>(grid, lds);
        PH_ENV();
        Bufs B; B.QN = (const bf16_t*)(ws + WS_QN); B.KS = (const bf16_t*)(ws + WS_KS); B.KW = (const bf16_t*)(ws + WS_KW); B.VST = (const bf16_t*)(ws + WS_VST);
        B.VWT = (const bf16_t*)(ws + WS_VWT); B.KCMP = (const bf16_t*)(ws + WS_KCMP); B.VCMPT = (const bf16_t*)(ws + WS_VCMPT); B.QM = (const bf16_t*)(ws + WS_QM);
        B.KM = (const bf16_t*)(ws + WS_KM); B.KPE = (const bf16_t*)(ws + WS_KPE); B.VMT = (const bf16_t*)(ws + WS_VMT); B.GN = (const float*)(ws + WS_GN); B.OAB = XN;
#if EXP_NOATTN
        { u32x4* o = (u32x4*)XN; for (size_t i = (size_t)bx * 512 + tid; i < (size_t)M * 1024 / 8; i += (size_t)G * 512) o[i] = (u32x4){0x3c003c00u, 0x3c003c00u, 0x3c003c00u, 0x3c003c00u}; (void)B; }
#else
        attn_phase(B, lds, (unsigned*)(ws + WS_CTL) + (L * 2 + rep_) * 64);
#endif
    }
    PH_SEAM(P0 + 4);
    if (PH_IN(P0 + 5)) for (int rep_ = 0; rep_ < (((DUP_MASK >> 5) & 1) ? 2 : 1); ++rep_) { if (rep_) grid_barrier<false>(grid, lds);
        PH_ENV();
        pg8::StaticOrder So; So.init(M, 1024, G, bx);
        { pg8::Gemm g{XN, (const bf16_t*)(ws + WS_WOAB), 1024, 512}; EpiWrap<EpiD1aImpl> E; E.ws = ws; pg8::gemm_phase(lds, g, So, E); }
        { pg8::Gemm g{XN + 512, (const bf16_t*)(ws + WS_WOAB) + 1024 * 512, 1024, 512}; EpiWrap<EpiD1bImpl> E; E.ws = ws; pg8::gemm_phase(lds, g, So, E); }
    }
    PH_SEAM(P0 + 5);
    if (PH_IN(P0 + 6)) for (int rep_ = 0; rep_ < (((DUP_MASK >> 6) & 1) ? 2 : 1); ++rep_) { if (rep_) grid_barrier<false>(grid, lds);
        PH_ENV();
        pg8::Gemm g{(const bf16_t*)(ws + WS_MG), (const bf16_t*)(ws + WS_WOUT), 1024, 1024}; pg8::StaticOrder So; So.init(M, 1024, G, bx);
        EpiWrap<EpiD2Impl> E; E.xin = (L == 0 ? KIN(0) : X); E.X = X;
        pg8::gemm_phase(lds, g, So, E);
    }
    PH_SEAM(P0 + 6);
    if (PH_IN(P0 + 7)) for (int rep_ = 0; rep_ < (((DUP_MASK >> 7) & 1) ? 2 : 1); ++rep_) { if (rep_) grid_barrier<false>(grid, lds);
        PH_ENV();
        norm_rows_bf16(X, KIN(13) + L * D, XN);
    }
    PH_SEAM(P0 + 7);
    if (PH_IN(P0 + 8)) for (int rep_ = 0; rep_ < (((DUP_MASK >> 8) & 1) ? 2 : 1); ++rep_) { if (rep_) grid_barrier<false>(grid, lds);
        PH_ENV();
        pg8::Gemm g{XN, (const bf16_t*)(ws + WS_WUP), 1024, 1024}; pg8::StaticOrder So; So.init(M, FF, G, bx);
        EpiWrap<EpiUpImpl> E; E.ws = ws;
        pg8::gemm_phase(lds, g, So, E);
    }
    PH_SEAM(P0 + 8);
    if (PH_IN(P0 + 9)) for (int rep_ = 0; rep_ < (((DUP_MASK >> 9) & 1) ? 2 : 1); ++rep_) { if (rep_) grid_barrier<false>(grid, lds);
        PH_ENV();
        pg8::Gemm g{(const bf16_t*)(ws + WS_HF), (const bf16_t*)(ws + WS_WDN), 4096, 4096}; pg8::StaticOrder So; So.init(M, 1024, G, bx);
        EpiWrap<EpiD2Impl> E; E.xin = X; E.X = X;
        pg8::gemm_phase(lds, g, So, E);
    }
    PH_SEAM(P0 + 9);
}

__global__ void __launch_bounds__(512, 2) mega(Params P) {
    extern __shared__ __attribute__((aligned(16))) unsigned char lds_raw[];
    LAS unsigned char* lds = (LAS unsigned char*)lds_raw;
    cg::grid_group grid = cg::this_grid();
    const int lo = P.ph_lo, hi = P.ph_hi;
    if (threadIdx.x < 2) ((volatile LAS unsigned*)(lds + MISC_OFF + 64))[threadIdx.x] = 0u;
    if (blockIdx.x == 0 && hi - lo > 1) { unsigned* bar = (unsigned*)((unsigned char*)karg_ptr(144) + WS_BAR);
        for (int i = threadIdx.x; i < XCD_BAR_WORDS; i += 512) __hip_atomic_store(bar + i, 0u, __ATOMIC_RELAXED, __HIP_MEMORY_SCOPE_AGENT); }
    __syncthreads();
    run_layer<0>(lds, grid, lo, hi);
    run_layer<1>(lds, grid, lo, hi);
    run_layer<2>(lds, grid, lo, hi);
    run_layer<3>(lds, grid, lo, hi);
    if (PH_IN(39) && PH_IN(40)) {   }
    if (PH_IN(40)) { float* X = (float*)karg_ptr(136); norm_rows_f32_inplace(X, KIN(16)); }
}

extern "C" void kernel_launch(void* const* d_in, const int* in_sizes, int n_in, void* d_out, int out_size, void* d_ws, size_t ws_size, hipStream_t stream) {
    static int grid = 0;
    if (grid == 0) {
        if (n_in != 17 || out_size != M * D || ws_size < WS_END) { fprintf(stderr, "kernel_launch: unexpected shapes (n_in %d out %d ws %zu)\n", n_in, out_size, ws_size); grid = -1; return; }
        int dev = 0, cus = 0, per_cu = 0;
        hipGetDevice(&dev);
        hipDeviceGetAttribute(&cus, hipDeviceAttributeMultiprocessorCount, dev);
        if (hipFuncSetAttribute((const void*)mega, hipFuncAttributeMaxDynamicSharedMemorySize, LDS_BYTES) != hipSuccess) { fprintf(stderr, "kernel_launch: hipFuncSetAttribute failed\n"); grid = -1; return; }
        if (hipOccupancyMaxActiveBlocksPerMultiprocessor(&per_cu, (const void*)mega, 512, LDS_BYTES) != hipSuccess || per_cu < 1) { fprintf(stderr, "kernel_launch: occupancy query gave %d\n", per_cu); per_cu = 1; }
        (void)hipGetLastError();
        grid = cus * per_cu;
        if (grid < 64) { fprintf(stderr, "kernel_launch: grid %d too small for the phase program\n", grid); grid = -1; return; }
    }
    if (grid < 0) return;
    Params p{};
    for (int i = 0; i < 17; ++i) p.in[i] = (const float*)d_in[i];
    p.out = (float*)d_out; p.ws = (unsigned char*)d_ws;
#if MK_MULTI
    for (int ph = 0; ph <= 40; ++ph) {
        p.ph_lo = ph; p.ph_hi = ph + 1;
        hipLaunchKernelGGL(mega, dim3(grid), dim3(512), LDS_BYTES, stream, p);
    }
#else
    p.ph_lo = 0; p.ph_hi = 41;
    void* args[] = {&p};
    hipError_t e = hipLaunchCooperativeKernel((const void*)mega, dim3(grid), dim3(512), args, LDS_BYTES, stream);
    if (e != hipSuccess) fprintf(stderr, "kernel_launch: cooperative launch failed: %s (grid %d)\n", hipGetErrorString(e), grid);
#endif
}
```

```cpp
#include <hip/hip_runtime.h>
#include <hip/hip_cooperative_groups.h>
#include <cstdio>
#include <cstdint>
namespace cg = cooperative_groups;

#ifndef EXP_NOATTN
#define EXP_NOATTN 0
#endif
#ifndef ATT_STATIC
#define ATT_STATIC 0
#endif
#ifndef EXP_ATT
#define EXP_ATT 0
#endif
#ifndef DUP_MASK
#define DUP_MASK 0
#endif
#ifndef ATT_DUP
#define ATT_DUP 0
#endif
#ifndef STAG_CMP
#define STAG_CMP false
#define STAG_SLC false
#define STAG_WIN true
#define STAG_MLA true
#endif
#ifndef MK_MULTI
#define MK_MULTI 0
#endif

#define LAS __attribute__((address_space(3)))
#define DI __device__ __forceinline__
typedef unsigned short bf16_t;
typedef short bf16x8 __attribute__((ext_vector_type(8)));
typedef float f32x4 __attribute__((ext_vector_type(4)));
typedef float f32x2 __attribute__((ext_vector_type(2)));
typedef float f32x16 __attribute__((ext_vector_type(16)));
typedef unsigned u32x4 __attribute__((ext_vector_type(4)));
typedef unsigned u32x2 __attribute__((ext_vector_type(2)));
typedef __bf16 bf16v2 __attribute__((ext_vector_type(2)));

DI unsigned pk2(float lo, float hi) { f32x2 v = {lo, hi}; return __builtin_bit_cast(unsigned, __builtin_convertvector(v, bf16v2)); }
DI bf16_t f2bf(float x) { return (bf16_t)(pk2(x, 0.f) & 0xffffu); }
DI float bflo(unsigned w) { return __uint_as_float(w << 16); }
DI float bfhi(unsigned w) { return __uint_as_float(w & 0xffff0000u); }
DI float sigmoidf_(float x) { return 1.f / (1.f + __expf(-x)); }
DI float ex2(float x) { return __builtin_amdgcn_exp2f(x); }
DI int my_tid() { int t = threadIdx.x; asm volatile("" : "+v"(t)); return t; }

constexpr int NB = 8, S = 4096, D = 1024, NL = 4, M = NB * S, FF = 4096;
constexpr int NIN = 3840;
constexpr int IN_COLS = 3768;
constexpr float EPS = 1e-6f;
constexpr float LOG2E = 1.4426950408889634f;

constexpr size_t MiB = 1u << 20;
constexpr size_t WS_CTL = 0;
constexpr size_t WS_BAR = 16384;
constexpr size_t WS_CB1 = 4096;
constexpr size_t WS_RSQ = 65536;
constexpr size_t WS_RSKV = 65536 + 131072;
constexpr size_t WS_CS64 = 1 * MiB;
constexpr size_t WS_CS32 = 2 * MiB;
constexpr size_t WS_WIN = 3 * MiB;
constexpr size_t WS_W1T = WS_WIN + (size_t)NIN * 1024 * 2;
constexpr size_t WS_W2T = WS_W1T + 2 * MiB;
constexpr size_t WS_WOAB = WS_W2T + 256 * 1024;
constexpr size_t WS_WUQ = WS_WOAB + 2 * MiB;
constexpr size_t WS_WUKV = WS_WUQ + 384 * 1024;
constexpr size_t WS_WOUT = 16 * MiB;
constexpr size_t WS_WUP = 18 * MiB;
constexpr size_t WS_WDN = 26 * MiB;
constexpr size_t WS_XN = 34 * MiB;
constexpr size_t WS_GA = 98 * MiB;
constexpr size_t WS_GB = 162 * MiB;
constexpr size_t WS_QN = 226 * MiB;
constexpr size_t WS_KCV = 258 * MiB;
constexpr size_t WS_KS = 274 * MiB, WS_KW = 282 * MiB, WS_VST = 290 * MiB, WS_VWT = 298 * MiB;
constexpr size_t WS_CQ = 306 * MiB, WS_T6 = 322 * MiB, WS_KPE = 338 * MiB, WS_GN = 340 * MiB;
constexpr size_t WS_QM = 343 * MiB, WS_KM = 391 * MiB, WS_VMT = 423 * MiB, WS_HC = 455 * MiB;
constexpr size_t WS_KCMP = 459 * MiB, WS_VCMPT = WS_KCMP + 512 * 1024;
constexpr size_t WS_MG = 226 * MiB;
constexpr size_t WS_HF = 98 * MiB;
constexpr size_t WS_PQ = 460 * MiB;
constexpr size_t WS_PKV = 461 * MiB;
constexpr size_t WS_END = 462 * MiB;
static_assert(WS_WUKV + 512 * 1024 <= WS_WOUT, "ws map");

constexpr int LDS_BYTES = 147456;
constexpr int MISC_OFF = 147200;
constexpr int AT_K = 0, AT_KB = 13312  , AT_V = 26624, AT_VB = 9216  , AT_IMP = 54272, AT_SEL = 70656, AT_LIST = 71168, AT_CNT = 71424, AT_ACC = 71680;

namespace pg8 {
constexpr int BM = 256, BK = 64, HALF = 128, HTB = HALF * BK * 2, NXCD = 8, WGM = 8;
__host__ __device__ __forceinline__ int lds_byte(int r, int c) { const int st = (r >> 4) * 2 + (c >> 5), rr = r & 15, cc = c & 31, ob = rr * 64 + cc * 2; return st * 1024 + (ob ^ (((ob >> 9) & 1) << 5)); }
__host__ __device__ __forceinline__ void stage_rc(int b, int& R, int& C) { const int st = b / 1024, sb = b % 1024, swz = sb ^ (((sb >> 9) & 1) << 5); R = (st >> 1) * 16 + swz / 64; C = (st & 1) * 32 + (swz % 64) / 2; }
__host__ __device__ __forceinline__ int perm32(int rho) { const int n = rho >> 4, i = rho & 15; return 8 * (i >> 2) + 4 * n + (i & 3); }

struct Unit { int pm, pn; };
struct Gemm { const bf16_t* A; const bf16_t* Bt; int lda; int K; };

struct StaticOrder {
    int nM, nN, nwg, G, c;
    __device__ void init(int M_, int N_, int G_, int c_) { nM = M_ / BM; nN = N_ / BM; nwg = nM * nN; G = G_; c = c_; }
    __device__ bool next(int i, Unit& u) const {
        const long L = (long)i * G + c; if (L >= nwg) return false;
        int wgid = (int)L; { const int q = nwg / NXCD, r = nwg % NXCD, xcd = wgid % NXCD, off = wgid / NXCD; wgid = (xcd < r ? xcd * (q + 1) : r * (q + 1) + (xcd - r) * q) + off; }
        const int nig = WGM * nN, gid = wgid / nig, fm = gid * WGM, gsz = (nM - fm) < WGM ? (nM - fm) : WGM;
        u.pm = fm + ((wgid % nig) % gsz); u.pn = (wgid % nig) / gsz; return true;
    }
};
struct CmpOrder {
    int G, c;
    __device__ bool next(int i, Unit& u) const { const int L = i * G + c; if (L >= 32) return false; u.pm = L; u.pn = L >> 4; return true; }
};

template <class Epi, class Sched>
__device__ __forceinline__ void gemm_phase(LAS unsigned char* lds, const Gemm g, const Sched& S, const Epi& E) {
    const int tid = my_tid(), wid = __builtin_amdgcn_readfirstlane(tid >> 6), lane = tid & 63, wr = wid >> 2, wc = wid & 3, fr = lane & 15, fq = lane >> 4;
    const int K = g.K, nt = K / BK, lda = g.lda;
    unsigned voffA, voffB;
    { int R, C; stage_rc(tid * 16, R, C); const int Rb = (R & ~31) + perm32(R & 31);
        voffA = (unsigned)(R * lda + C) * 2u; voffB = (unsigned)(Rb * K + C) * 2u; }
    const size_t qvoffA = (size_t)64 * lda * 2, qvoffB = (size_t)64 * K * 2;
    const size_t kstep = (size_t)(BK * 2);
    const size_t hstepA = (size_t)HALF * lda * 2, hstepB = (size_t)HALF * K * 2;
    const size_t tstepA = 2 * hstepA, tstepB = 2 * hstepB;
    const unsigned ldsw = (unsigned)wid * 1024u;
    const int aoff = lds_byte(wr * 64 + fr, fq * 8), boff = lds_byte(wc * 32 + fr, fq * 8);
#define PG8_SA(b, h) (((b) * 2 + (h)) * HTB)
#define PG8_SB(b, h) ((4 + (b) * 2 + (h)) * HTB)
#define PG8_STAGE(bufoff, gbase, voff) do { _Pragma("unroll") for (int _i = 0; _i < 2; ++_i) \
        __builtin_amdgcn_global_load_lds((const unsigned*)((const char*)(gbase) + (size_t)_i * q##voff + (voff)), (LAS unsigned*)(lds + (bufoff) + ldsw + _i * 8192), 16, 0, 0); } while (0)
#define PG8_LDA(dst, b, h) do { _Pragma("unroll") for (int m = 0; m < 4; ++m) _Pragma("unroll") for (int k = 0; k < 2; ++k) dst[m][k] = *(const LAS bf16x8*)(lds + PG8_SA(b, h) + aoff + m * 2048 + k * 1024); } while (0)
#define PG8_LDB(dst, b, h) do { _Pragma("unroll") for (int n = 0; n < 2; ++n) _Pragma("unroll") for (int k = 0; k < 2; ++k) dst[n][k] = *(const LAS bf16x8*)(lds + PG8_SB(b, h) + boff + n * 2048 + k * 1024); } while (0)
#define PG8_MMA(ai, bj, At, Bt) do { __builtin_amdgcn_s_setprio(1); _Pragma("unroll") for (int m = 0; m < 4; ++m) _Pragma("unroll") for (int n = 0; n < 2; ++n) _Pragma("unroll") for (int k = 0; k < 2; ++k) \
        acc[ai][bj][m][n] = __builtin_amdgcn_mfma_f32_16x16x32_bf16(Bt[n][k], At[m][k], acc[ai][bj][m][n], 0, 0, 0); __builtin_amdgcn_s_setprio(0); } while (0)
#define PG8_WAIT_V(n) asm volatile("s_waitcnt vmcnt(" #n ")" ::: "memory")
#define PG8_WAIT_L(n) asm volatile("s_waitcnt lgkmcnt(" #n ")" ::: "memory")
#define PG8_BAR __builtin_amdgcn_s_barrier()
#define PG8_SCHED __builtin_amdgcn_sched_barrier(0)
    Unit cur, nxt; int ui = 0;
    if (!S.next(0, cur)) return;
    f32x4 acc[2][2][4][2];
#pragma unroll
    for (int a = 0; a < 2; ++a)
#pragma unroll
        for (int b = 0; b < 2; ++b)
#pragma unroll
            for (int m = 0; m < 4; ++m)
#pragma unroll
                for (int n = 0; n < 2; ++n) acc[a][b][m][n] = (f32x4){0.f, 0.f, 0.f, 0.f};
    bf16x8 At[4][2], B0[2][2], B1[2][2];
    const char* cA = (const char*)g.A + (size_t)cur.pm * tstepA; const char* cB = (const char*)g.Bt + (size_t)cur.pn * tstepB;
    PG8_STAGE(PG8_SB(0, 0), cB, voffB); PG8_STAGE(PG8_SB(0, 1), cB + hstepB, voffB); PG8_STAGE(PG8_SA(0, 0), cA, voffA); PG8_STAGE(PG8_SA(0, 1), cA + hstepA, voffA);
    if (wr == 1) PG8_BAR;
    PG8_WAIT_V(2); PG8_BAR;
    PG8_STAGE(PG8_SB(1, 0), cB + kstep, voffB); PG8_STAGE(PG8_SA(1, 0), cA + kstep, voffA); PG8_STAGE(PG8_SB(1, 1), cB + hstepB + kstep, voffB);
    PG8_WAIT_V(6); PG8_BAR;
    for (;;) {
        const bool has_next = S.next(ui + 1, nxt);
        const char* nA = has_next ? (const char*)g.A + (size_t)nxt.pm * tstepA : cA; const char* nB = has_next ? (const char*)g.Bt + (size_t)nxt.pn * tstepB : cB;
        for (int t = 0; t < nt; t += 2) {
            const bool last = (t == nt - 2);
            const char* a1 = cA + (size_t)(t + 1) * kstep;
            const char* a2 = last ? nA : cA + (size_t)(t + 2) * kstep; const char* b2 = last ? nB : cB + (size_t)(t + 2) * kstep;
            const char* a3 = a2 + kstep; const char* b3 = b2 + kstep;
            PG8_LDB(B0, 0, 0); PG8_LDB(B1, 0, 1); PG8_SCHED; PG8_LDA(At, 0, 0); PG8_STAGE(PG8_SA(1, 1), a1 + hstepA, voffA);
            PG8_WAIT_V(8); PG8_WAIT_L(0); PG8_BAR; PG8_MMA(0, 0, At, B0); PG8_MMA(0, 1, At, B1); PG8_BAR; PG8_SCHED;
            PG8_LDA(At, 0, 1); PG8_STAGE(PG8_SB(0, 0), b2, voffB); PG8_STAGE(PG8_SB(0, 1), b2 + hstepB, voffB); PG8_STAGE(PG8_SA(0, 0), a2, voffA);
            PG8_WAIT_V(8); PG8_WAIT_L(0); PG8_BAR; PG8_MMA(1, 0, At, B0); PG8_MMA(1, 1, At, B1); PG8_BAR; PG8_SCHED;
            PG8_LDB(B0, 1, 0); PG8_LDB(B1, 1, 1); PG8_SCHED; PG8_LDA(At, 1, 0); PG8_STAGE(PG8_SA(0, 1), a2 + hstepA, voffA);
            PG8_WAIT_V(8); PG8_WAIT_L(0); PG8_BAR; PG8_MMA(0, 0, At, B0); PG8_MMA(0, 1, At, B1); PG8_BAR; PG8_SCHED;
            PG8_LDA(At, 1, 1); PG8_STAGE(PG8_SB(1, 0), b3, voffB); PG8_STAGE(PG8_SB(1, 1), b3 + hstepB, voffB); PG8_STAGE(PG8_SA(1, 0), a3, voffA);
            PG8_WAIT_V(8); PG8_WAIT_L(0); PG8_BAR; PG8_MMA(1, 0, At, B0); PG8_MMA(1, 1, At, B1); PG8_BAR; PG8_SCHED;
        }
        if (wr == 0) PG8_BAR;
        E(acc, cur, wr, wc, fr, fq);
        if (!has_next) break;
#pragma unroll
        for (int a = 0; a < 2; ++a)
#pragma unroll
            for (int b = 0; b < 2; ++b)
#pragma unroll
                for (int m = 0; m < 4; ++m)
#pragma unroll
                    for (int n = 0; n < 2; ++n) acc[a][b][m][n] = (f32x4){0.f, 0.f, 0.f, 0.f};
        cur = nxt; cA = nA; cB = nB; ++ui;
        if (wr == 1) PG8_BAR;
    }
    PG8_WAIT_V(0);
    PG8_BAR;
#undef PG8_SA
#undef PG8_SB
#undef PG8_STAGE
#undef PG8_LDA
#undef PG8_LDB
#undef PG8_MMA
#undef PG8_WAIT_V
#undef PG8_WAIT_L
#undef PG8_BAR
#undef PG8_SCHED
}
}
using pg8::Unit;

DI void store8(bf16_t* p, const float (&v)[8]) { u32x4 w = {pk2(v[0], v[1]), pk2(v[2], v[3]), pk2(v[4], v[5]), pk2(v[6], v[7])}; *(u32x4*)p = w; }
DI void rope8(float (&v)[8], const f32x2* cs) {
    const f32x4 c0 = *(const f32x4*)cs, c1 = *(const f32x4*)(cs + 2);
    const float co[4] = {c0[0], c0[2], c1[0], c1[2]}, si[4] = {c0[1], c0[3], c1[1], c1[3]};
#pragma unroll
    for (int k = 0; k < 4; ++k) { const float a = v[2 * k], b = v[2 * k + 1]; v[2 * k] = a * co[k] - b * si[k]; v[2 * k + 1] = a * si[k] + b * co[k]; }
}
DI float sumsq_fq(const float (&v)[8]) {
    float s = 0.f;
#pragma unroll
    for (int e = 0; e < 8; ++e) s += v[e] * v[e];
    s += __shfl_xor(s, 16); s += __shfl_xor(s, 32); return s;
}

template <class Impl> struct EpiWrap : Impl {
    static constexpr bool MID = false;
    DI void operator()(const f32x4 (&acc)[2][2][4][2], const Unit& u, int wr, int wc, int, int) const {
        const int t2 = my_tid(), fr = t2 & 15, fq = (t2 >> 4) & 3;
#pragma unroll
        for (int ai = 0; ai < 2; ++ai)
#pragma unroll
            for (int m = 0; m < 4; ++m)
#pragma unroll
                for (int bj = 0; bj < 2; ++bj) {
                    const f32x4 a0 = acc[ai][bj][m][0], a1 = acc[ai][bj][m][1];
                    float v[8] = {a0[0], a0[1], a0[2], a0[3], a1[0], a1[1], a1[2], a1[3]};
                    this->chunk(u.pm * 256 + ai * 128 + wr * 64 + m * 16 + fr, u.pn, bj * 128 + wc * 32 + 8 * fq, v);
                }
    }
};

#define WSP(T, off) ((T*)(ws + (off)))
struct EpiInImpl {
    unsigned char* ws;
    DI void chunk(int row, int pn, int cc, float (&v)[8]) const {
        const int pos = row & (S - 1), b = row >> 12;
        bf16_t* const QN = WSP(bf16_t, WS_QN); bf16_t* const KCV = WSP(bf16_t, WS_KCV); bf16_t* const CQ = WSP(bf16_t, WS_CQ); bf16_t* const T6 = WSP(bf16_t, WS_T6);
        bf16_t* const KPE = WSP(bf16_t, WS_KPE); float* const GN = WSP(float, WS_GN); float* const PQ = WSP(float, WS_PQ); float* const PKV = WSP(float, WS_PKV);
        const f32x2* const CS64 = WSP(const f32x2, WS_CS64); const f32x2* const CS32 = WSP(const f32x2, WS_CS32);
        if (pn < 2) {
            rope8(v, CS64 + pos * 32 + ((cc & 63) >> 1));
            store8(QN + (size_t)row * 512 + pn * 256 + cc, v);
        } else if (pn < 5) {
            const int kv = cc >> 7, g = (cc >> 6) & 1, p = cc & 63, bg = b * 2 + g;
            if (kv == 0) {
                rope8(v, CS64 + pos * 32 + (p >> 1));
                bf16_t* dst = WSP(bf16_t, pn == 2 ? WS_KCV : (pn == 3 ? WS_KS : WS_KW));
                store8(dst + ((size_t)bg * S + pos) * 64 + p, v);
            } else if (pn == 2) {
                store8(KCV + ((size_t)(16 + bg) * S + pos) * 64 + p, v);
            } else {
                bf16_t* dst = WSP(bf16_t, pn == 3 ? WS_VST : WS_VWT);
#pragma unroll
                for (int e = 0; e < 8; ++e) dst[((size_t)bg * 64 + p + e) * S + pos] = f2bf(v[e]);
            }
        } else if (pn == 5) {
            store8(CQ + (size_t)row * 256 + cc, v);
            const float s = sumsq_fq(v);
            if ((threadIdx.x & 48) == 0) PQ[(size_t)row * 8 + (cc >> 5)] = s;
        } else if (pn == 6) {
            store8(T6 + (size_t)row * 256 + cc, v);
            if (cc < 128) {
                const float s = sumsq_fq(v);
                if ((threadIdx.x & 48) == 0) PKV[(size_t)row * 4 + (cc >> 5)] = s;
            } else if (cc < 160) {
                rope8(v, CS32 + pos * 16 + ((cc - 128) >> 1));
                store8(KPE + (size_t)row * 32 + (cc - 128), v);
            } else if (cc < 184) {
#pragma unroll
                for (int e = 0; e < 8; ++e) GN[(size_t)row * 24 + (cc - 160) + e] = sigmoidf_(v[e]);
            }
        } else {
#pragma unroll
            for (int e = 0; e < 8; ++e) v[e] = sigmoidf_(v[e]);
            if (pn < 11) store8(WSP(bf16_t, WS_GA) + (size_t)row * 1024 + (pn - 7) * 256 + cc, v);
            else store8(WSP(bf16_t, WS_GB) + (size_t)row * 1024 + (pn - 11) * 256 + cc, v);
        }
    }
};
struct EpiC1Impl {
    unsigned char* ws;
    DI void chunk(int row, int pn, int cc, float (&v)[8]) const {
        bf16_t* const HC = WSP(bf16_t, WS_HC); const float* const CB1 = WSP(const float, WS_CB1);
        const f32x4 b0 = *(const f32x4*)(CB1 + pn * 256 + cc), b1 = *(const f32x4*)(CB1 + pn * 256 + cc + 4);
        const float bb[8] = {b0[0], b0[1], b0[2], b0[3], b1[0], b1[1], b1[2], b1[3]};
#pragma unroll
        for (int e = 0; e < 8; ++e) { const float x = v[e] + bb[e]; v[e] = x / (1.f + __expf(-x)); }
        store8(HC + (size_t)row * 256 + cc, v);
    }
};
struct EpiC2Impl {
    unsigned char* ws;
    DI void chunk(int row, int pn, int cc, float (&v)[8]) const {
        if (cc >= 64) return;
        bf16_t* const KCMP = WSP(bf16_t, WS_KCMP); bf16_t* const VCMPT = WSP(bf16_t, WS_VCMPT);
        const int bg = (row >> 8) & 15, n = row & 255;
        if (n == 255) {
#pragma unroll
            for (int e = 0; e < 8; ++e) v[e] = 0.f;
        }
        if (pn == 0) store8(KCMP + ((size_t)bg * 256 + n) * 64 + cc, v);
        else {
#pragma unroll
            for (int e = 0; e < 8; ++e) VCMPT[((size_t)bg * 64 + cc + e) * 256 + n] = f2bf(v[e]);
        }
    }
};
struct EpiUQImpl {
    unsigned char* ws;
    DI void chunk(int row, int pn, int cc, float (&v)[8]) const {
        bf16_t* const QM = WSP(bf16_t, WS_QM); const float* const PQ = WSP(const float, WS_PQ); const f32x2* const CS32 = WSP(const f32x2, WS_CS32);
        const int c = pn * 256 + cc, hh = c / 96, c96 = c - hh * 96, pos = row & (S - 1);
        const f32x4 p0 = *(const f32x4*)(PQ + (size_t)row * 8), p1 = *(const f32x4*)(PQ + (size_t)row * 8 + 4);
        const float rstd = rsqrtf((((p0[0] + p0[1]) + (p0[2] + p0[3])) + ((p1[0] + p1[1]) + (p1[2] + p1[3]))) * (1.f / 256.f) + EPS);
#pragma unroll
        for (int e = 0; e < 8; ++e) v[e] *= rstd;
        if (c96 >= 64) rope8(v, CS32 + pos * 16 + ((c96 - 64) >> 1));
        store8(QM + (size_t)row * 768 + c, v);
    }
};
struct EpiUKVImpl {
    unsigned char* ws;
    DI void chunk(int row, int pn, int cc, float (&v)[8]) const {
        bf16_t* const KM = WSP(bf16_t, WS_KM); bf16_t* const VMT = WSP(bf16_t, WS_VMT); const float* const PKV = WSP(const float, WS_PKV);
        const int c = pn * 256 + cc, hh = c >> 7, c128 = c & 127, pos = row & (S - 1), b = row >> 12;
        const f32x4 p0 = *(const f32x4*)(PKV + (size_t)row * 4);
        const float rstd = rsqrtf(((p0[0] + p0[1]) + (p0[2] + p0[3])) * (1.f / 128.f) + EPS);
#pragma unroll
        for (int e = 0; e < 8; ++e) v[e] *= rstd;
        if (c128 < 64) store8(KM + ((size_t)(b * 8 + hh) * S + pos) * 64 + c128, v);
        else {
#pragma unroll
            for (int e = 0; e < 8; ++e) VMT[((size_t)(b * 8 + hh) * 64 + (c128 - 64) + e) * S + pos] = f2bf(v[e]);
        }
    }
};
struct EpiD2Impl {
    const float* xin; float* X;
    DI void chunk(int row, int pn, int cc, float (&v)[8]) const {
        const size_t o = (size_t)row * 1024 + pn * 256 + cc;
        const f32x4 x0 = *(const f32x4*)(xin + o), x1 = *(const f32x4*)(xin + o + 4);
        *(f32x4*)(X + o) = (f32x4){x0[0] + v[0], x0[1] + v[1], x0[2] + v[2], x0[3] + v[3]};
        *(f32x4*)(X + o + 4) = (f32x4){x1[0] + v[4], x1[1] + v[5], x1[2] + v[6], x1[3] + v[7]};
    }
};
struct EpiUpImpl {
    unsigned char* ws;
    DI void chunk(int row, int pn, int cc, float (&v)[8]) const {
        bf16_t* const HF = WSP(bf16_t, WS_HF);
#pragma unroll
        for (int e = 0; e < 8; ++e) { const float r = fmaxf(v[e], 0.f); v[e] = r * r; }
        store8(HF + (size_t)row * FF + pn * 256 + cc, v);
    }
};
struct EpiD1aImpl {
    unsigned char* ws;
    DI void chunk(int row, int pn, int cc, float (&v)[8]) const {
        const size_t o = (size_t)row * 1024 + pn * 256 + cc;
        const u32x4 a = *(const u32x4*)(WSP(const bf16_t, WS_GA) + o);
        v[0] *= bflo(a[0]); v[1] *= bfhi(a[0]); v[2] *= bflo(a[1]); v[3] *= bfhi(a[1]); v[4] *= bflo(a[2]); v[5] *= bfhi(a[2]); v[6] *= bflo(a[3]); v[7] *= bfhi(a[3]);
        store8(WSP(bf16_t, WS_MG) + o, v);
    }
};
struct EpiD1bImpl {
    unsigned char* ws;
    DI void chunk(int row, int pn, int cc, float (&v)[8]) const {
        const size_t o = (size_t)row * 1024 + pn * 256 + cc;
        const u32x4 b = *(const u32x4*)(WSP(const bf16_t, WS_GB) + o), g = *(const u32x4*)(WSP(const bf16_t, WS_MG) + o);
        v[0] = bflo(g[0]) + v[0] * bflo(b[0]); v[1] = bfhi(g[0]) + v[1] * bfhi(b[0]); v[2] = bflo(g[1]) + v[2] * bflo(b[1]); v[3] = bfhi(g[1]) + v[3] * bfhi(b[1]);
        v[4] = bflo(g[2]) + v[4] * bflo(b[2]); v[5] = bfhi(g[2]) + v[5] * bfhi(b[2]); v[6] = bflo(g[3]) + v[6] * bflo(b[3]); v[7] = bfhi(g[3]) + v[7] * bfhi(b[3]);
        store8(WSP(bf16_t, WS_MG) + o, v);
    }
};

#define MFMA32(a, b, c) __builtin_amdgcn_mfma_f32_32x32x16_bf16((a), (b), (c), 0, 0, 0)

template <int DQK> DI void qk_tile(const LAS unsigned char* sK, const bf16x8 (&qf)[DQK / 16], f32x16 (&s)[2], int lane) {
    constexpr int KSTR = DQK * 2 + 16;
    const int r = lane & 31, h = lane >> 5;
    const int rp = (r & 0x13) | ((r & 4) << 1) | ((r & 8) >> 1);
    bf16x8 kf[2][DQK / 16];
#pragma unroll
    for (int kt = 0; kt < 2; ++kt)
#pragma unroll
        for (int ks = 0; ks < DQK / 16; ++ks) kf[kt][ks] = *(const LAS bf16x8*)(sK + (32 * kt + rp) * KSTR + ks * 32 + h * 16);
    __builtin_amdgcn_sched_barrier(0);
#pragma unroll
    for (int kt = 0; kt < 2; ++kt) {
        f32x16 a;
#pragma unroll
        for (int i = 0; i < 16; ++i) a[i] = 0.f;
#pragma unroll
        for (int ks = 0; ks < DQK / 16; ++ks) a = MFMA32(kf[kt][ks], qf[ks], a);
        s[kt] = a;
    }
}
DI void v_load(bf16x8 (&vf)[2][2][2], const LAS unsigned char* sV, int lane) {
    const int h = lane >> 5, r = lane & 31;
#pragma unroll
    for (int kt = 0; kt < 2; ++kt)
#pragma unroll
        for (int s2 = 0; s2 < 2; ++s2)
#pragma unroll
            for (int dt = 0; dt < 2; ++dt) vf[kt][s2][dt] = *(const LAS bf16x8*)(sV + (32 * dt + r) * 144 + (32 * kt + 16 * s2 + 8 * h) * 2);
}

template <bool LANEOFF> DI void pack_p(const f32x16 (&s)[2], unsigned keep, u32x4 (&pp)[4]) {
#pragma unroll
    for (int kt = 0; kt < 2; ++kt)
#pragma unroll
        for (int s2 = 0; s2 < 2; ++s2) {
            u32x4 pw = {pk2(s[kt][8 * s2 + 0], s[kt][8 * s2 + 1]), pk2(s[kt][8 * s2 + 2], s[kt][8 * s2 + 3]),
                        pk2(s[kt][8 * s2 + 4], s[kt][8 * s2 + 5]), pk2(s[kt][8 * s2 + 6], s[kt][8 * s2 + 7])};
            if constexpr (LANEOFF) { pw[0] &= keep; pw[1] &= keep; pw[2] &= keep; pw[3] &= keep; }
            pp[kt * 2 + s2] = pw;
        }
}
DI void pv_packed(const u32x4 (&pp)[4], const bf16x8 (&vf)[2][2][2], f32x16 (&o)[2]) {
#pragma unroll
    for (int kt = 0; kt < 2; ++kt)
#pragma unroll
        for (int s2 = 0; s2 < 2; ++s2) {
            const bf16x8 pb = __builtin_bit_cast(bf16x8, pp[kt * 2 + s2]);
#pragma unroll
            for (int dt = 0; dt < 2; ++dt) o[dt] = MFMA32(vf[kt][s2][dt], pb, o[dt]);
        }
}
template <class Mask> DI void softmax_masked(f32x16 (&s)[2], int tile, const Mask& mask, float c, float& m, float& l, f32x16 (&o)[2], int lane) {
    const int h = lane >> 5;
    float mx = -1e30f;
#pragma unroll
    for (int kt = 0; kt < 2; ++kt)
#pragma unroll
        for (int reg = 0; reg < 16; ++reg) {
            const int key = 32 * kt + (reg & 7) + 8 * h + 16 * (reg >> 3);
            const float x = mask(tile, key) ? s[kt][reg] : -1e30f;
            s[kt][reg] = x; mx = fmaxf(mx, x);
        }
    mx = fmaxf(mx, __shfl_xor(mx, 32));
    const float mn = fmaxf(m, mx), alpha = ex2((m - mn) * c), nmc = -mn * c;
    m = mn;
    float sum = 0.f;
#pragma unroll
    for (int kt = 0; kt < 2; ++kt)
#pragma unroll
        for (int reg = 0; reg < 16; ++reg) {
            const float x = s[kt][reg];
            const float p = (x > -5e29f) ? ex2(__builtin_fmaf(x, c, nmc)) : 0.f;
            s[kt][reg] = p; sum += p;
        }
    l = l * alpha + sum;
    o[0] *= alpha; o[1] *= alpha;
}
template <bool LANEOFF> DI void softmax_full(f32x16 (&s)[2], bool lane_on, float c, float& m, float& l, f32x16 (&o)[2]) {
    float mx0 = fmaxf(s[0][0], s[1][0]), mx1 = fmaxf(s[0][1], s[1][1]);
#pragma unroll
    for (int reg = 2; reg < 16; reg += 2) { mx0 = fmaxf(mx0, fmaxf(s[0][reg], s[1][reg])); mx1 = fmaxf(mx1, fmaxf(s[0][reg + 1], s[1][reg + 1])); }
    float mx = fmaxf(mx0, mx1);
    mx = fmaxf(mx, __shfl_xor(mx, 32));
    if constexpr (LANEOFF) mx = lane_on ? mx : -1e30f;
    const float mn = fmaxf(m, mx);
    if (__any(mn > m)) { const float alpha = ex2((m - mn) * c); l *= alpha; o[0] *= alpha; o[1] *= alpha; }
    m = mn;
    const float nmc = -mn * c;
    float sum0 = 0.f, sum1 = 0.f;
#pragma unroll
    for (int kt = 0; kt < 2; ++kt)
#pragma unroll
        for (int reg = 0; reg < 16; reg += 2) {
            const float p0 = ex2(__builtin_fmaf(s[kt][reg], c, nmc)), p1 = ex2(__builtin_fmaf(s[kt][reg + 1], c, nmc));
            s[kt][reg] = p0; s[kt][reg + 1] = p1; sum0 += p0; sum1 += p1;
        }
    float sum = sum0 + sum1;
    if constexpr (LANEOFF) sum = lane_on ? sum : 0.f;
    l += sum;
}

struct TileRegs { u32x4 k, v, p; };
template <int DQK, bool LANEOFF, bool STAG, class TileOf, class Mask, class Skip>
DI void attn_run(LAS unsigned char* lds, const bf16_t* Kg, const bf16_t* Kpe, const bf16_t* Vg, int ldv, int ntiles,
                 const TileOf& tile_of, const Mask& mask, const Skip& skip, float c, const bf16x8 (&qf)[DQK / 16], float& m, float& l, f32x16 (&o)[2]) {
    constexpr int KSTR = DQK * 2 + 16;
    const int tid = my_tid(), lane = tid & 63;
    const int krow = tid >> 3, kch = tid & 7, prow = (tid >> 2) & 63, pch = tid & 3;
    TileRegs RA, RB;
    asm volatile("" : "=v"(RA.k), "=v"(RA.v), "=v"(RA.p), "=v"(RB.k), "=v"(RB.v), "=v"(RB.p));
#define ATT_LOAD(R, tt) do { const int t_ = (tt); (R).k = *(const u32x4*)(Kg + ((size_t)(t_ * 64 + krow)) * 64 + kch * 8); (R).v = *(const u32x4*)(Vg + (size_t)krow * ldv + t_ * 64 + kch * 8); \
        if constexpr (DQK == 96) { if (tid < 256) (R).p = *(const u32x4*)(Kpe + ((size_t)(t_ * 64 + prow)) * 32 + pch * 8); } } while (0)
#define ATT_WRITE(R, kb_, vb_) do { *(LAS u32x4*)(lds + AT_K + (kb_) + krow * KSTR + kch * 16) = (R).k; *(LAS u32x4*)(lds + AT_V + (vb_) + krow * 144 + kch * 16) = (R).v; \
        if constexpr (DQK == 96) { if (tid < 256) *(LAS u32x4*)(lds + AT_K + (kb_) + prow * KSTR + 128 + pch * 16) = (R).p; } } while (0)
#define ATT_ITER(i_, RL, RW) do { const int t = tile_of(i_); const int kb = ((i_) & 1) * AT_KB, vb = ((i_) & 1) * AT_VB; \
        if ((i_) + 2 < ntiles) ATT_LOAD(RL, tile_of((i_) + 2)); \
        if (!skip(t)) { \
            f32x16 s[2]; \
            qk_tile<DQK>(lds + AT_K + kb, qf, s, lane); \
            bf16x8 vf[2][2][2]; v_load(vf, lds + AT_V + vb, lane); \
            unsigned keep = 0xffffffffu; \
            if (mask.full(t)) { const bool on = mask.lane_on(t); softmax_full<LANEOFF>(s, on, c, m, l, o); if constexpr (LANEOFF) keep = on ? 0xffffffffu : 0u; } \
            else softmax_masked(s, t, mask, c, m, l, o, lane); \
            u32x4 pp[4]; pack_p<LANEOFF>(s, keep, pp); pv_packed(pp, vf, o); \
        } \
        if ((i_) + 1 < ntiles) ATT_WRITE(RW, AT_KB - kb, AT_VB - vb); \
        __syncthreads(); } while (0)
    __syncthreads();
    if (ntiles > 0) { ATT_LOAD(RA, tile_of(0)); ATT_WRITE(RA, 0, 0); }
    if (ntiles > 1) ATT_LOAD(RB, tile_of(1));
    __syncthreads();
    for (int i = 0; i < ntiles; i += 2) {
        ATT_ITER(i, RA, RB);
        if (i + 1 < ntiles) ATT_ITER(i + 1, RB, RA);
    }
#undef ATT_LOAD
#undef ATT_WRITE
#undef ATT_ITER
}

struct TileId { DI int operator()(int i) const { return i; } };
struct TileOff { int off; DI int operator()(int i) const { return off + i; } };
struct TileList { const LAS int* lst; DI int operator()(int i) const { return lst[i]; } };
struct NoSkip { DI bool operator()(int) const { return false; } };
struct SkipAbove { int tmax; DI bool operator()(int t) const { return t * 64 > tmax; } };
struct MaskCmp { int tq;
    DI bool operator()(int t, int key) const { return 16 * (64 * t + key) + 31 <= tq; }
    DI bool full(int) const { return false; } DI bool lane_on(int) const { return true; } };
struct MaskSlc { int tq; unsigned lo, hi; int qt;
    DI bool bit(int t) const { return ((t < 32 ? (lo >> t) : (hi >> (t - 32))) & 1u) != 0u; }
    DI bool operator()(int t, int key) const { return bit(t) && (64 * t + key <= tq); }
    DI bool full(int t) const { return t < qt; } DI bool lane_on(int t) const { return bit(t); } };
struct MaskWin { int tq, tq0w;
    DI bool operator()(int t, int key) const { const int d = tq - (64 * t + key); return d >= 0 && d < 512; }
    DI bool full(int t) const { return (64 * t + 63 <= tq0w) && (tq0w + 31 - 64 * t <= 511); } DI bool lane_on(int) const { return true; } };
struct MaskCausal { int tq, tq0w;
    DI bool operator()(int t, int key) const { return 64 * t + key <= tq; }
    DI bool full(int t) const { return 64 * t + 63 <= tq0w; } DI bool lane_on(int) const { return true; } };

struct Bufs {
    const bf16_t *QN, *KS, *KW, *VST, *VWT, *KCMP, *VCMPT, *QM, *KM, *KPE, *VMT; const float* GN; bf16_t* OAB;
};

DI void zero16(f32x16& v) {
#pragma unroll
    for (int i = 0; i < 16; ++i) v[i] = 0.f;
}

DI void nsa_unit(const Bufs& B, LAS unsigned char* lds, int b, int g, int qt) {
    const int tid = my_tid(), lane = tid & 63, w = __builtin_amdgcn_readfirstlane(tid >> 6), r = w >> 1, hh = lane >> 5;
    const int qs = (w & 1) * 32 + (lane & 31), bg = b * 2 + g, tq = qt * 64 + qs, head = g * 4 + r;
    const size_t row = (size_t)b * S + tq;
    LAS unsigned* sImp = (LAS unsigned*)(lds + AT_IMP);
    LAS unsigned* sSel = (LAS unsigned*)(lds + AT_SEL);
    LAS int* sList = (LAS int*)(lds + AT_LIST);
    LAS int* sCnt = (LAS int*)(lds + AT_CNT);
    bf16x8 qf[4];
#pragma unroll
    for (int ks = 0; ks < 4; ++ks) qf[ks] = *(const bf16x8*)(B.QN + row * 512 + head * 64 + ks * 16 + hh * 8);
    for (int i = tid; i < 4096; i += 512) sImp[i] = 0u;
    const float c = 0.125f * LOG2E;
    LAS float* stash = (LAS float*)(lds + AT_ACC + w * 8192) + lane;
    float m, l; f32x16 o[2];
    const int nct = (4 * qt + 2) / 64 + 1;
    m = -1e30f; l = 0.f; zero16(o[0]); zero16(o[1]);
    attn_run<64, false, STAG_CMP>(lds, B.KCMP + (size_t)bg * 256 * 64, nullptr, B.VCMPT + (size_t)bg * 64 * 256, 256, nct, TileId{}, MaskCmp{tq}, NoSkip{}, c, qf, m, l, o);
    const float nmc = -m * c;
    float inv;
    { const float lt = l + __shfl_xor(l, 32); inv = lt > 0.f ? 1.f / lt : 0.f; }
    { const float ig0 = inv * B.GN[row * 24 + head];
#pragma unroll
    for (int dt = 0; dt < 2; ++dt)
#pragma unroll
        for (int e = 0; e < 16; ++e) stash[(dt * 16 + e) * 64] = o[dt][e] * ig0; }
    for (int ct = 0; ct < nct; ++ct) {
        __syncthreads();
        { const int krow = tid >> 3, kch = tid & 7;
          *(LAS u32x4*)(lds + AT_K + krow * 144 + kch * 16) = *(const u32x4*)(B.KCMP + ((size_t)bg * 256 + ct * 64 + krow) * 64 + kch * 8); }
        __syncthreads();
        f32x16 s[2];
        qk_tile<64>(lds + AT_K, qf, s, lane);
#pragma unroll
        for (int kt = 0; kt < 2; ++kt)
#pragma unroll
            for (int a = 0; a < 4; ++a) {
                float pv[4];
#pragma unroll
                for (int bb = 0; bb < 4; ++bb) {
                    const int reg = 4 * a + bb;
                    const int n = 64 * ct + 32 * kt + (reg & 7) + 8 * hh + 16 * (reg >> 3);
                    pv[bb] = (16 * n + 31 <= tq) ? ex2(__builtin_fmaf(s[kt][reg], c, nmc)) * inv : 0.f;
                }
                const int j = 16 * ct + 8 * kt + (a & 1) + 2 * hh + 4 * (a >> 1);
                const float carry = 0.5f * pv[3], direct = (pv[0] + pv[1]) + (pv[2] + carry);
                if (direct > 0.f) __hip_atomic_fetch_add(sImp + qs * 64 + j, (unsigned)(direct * 268435456.f + 0.5f), __ATOMIC_RELAXED, __HIP_MEMORY_SCOPE_WORKGROUP);
                if (carry > 0.f && j < 63) __hip_atomic_fetch_add(sImp + qs * 64 + j + 1, (unsigned)(carry * 268435456.f + 0.5f), __ATOMIC_RELAXED, __HIP_MEMORY_SCOPE_WORKGROUP);
            }
    }
    __syncthreads();
    {
        const int q = tid >> 3, sub = tid & 7;
        unsigned bits = 0;
        if (qt < 16) {
#pragma unroll
            for (int k = 0; k < 8; ++k) if (sub * 8 + k <= qt) bits |= 1u << k;
        } else {
            unsigned v[8]; int cnt[8];
#pragma unroll
            for (int k = 0; k < 8; ++k) { v[k] = sImp[q * 64 + sub * 8 + k]; cnt[k] = 0; }
            for (int jp = 1; jp <= qt - 2; ++jp) {
                const unsigned vp = sImp[q * 64 + jp];
#pragma unroll
                for (int k = 0; k < 8; ++k) cnt[k] += (vp > v[k] || (vp == v[k] && jp < sub * 8 + k)) ? 1 : 0;
            }
#pragma unroll
            for (int k = 0; k < 8; ++k) {
                const int j = sub * 8 + k;
                const bool forced = (j == 0) || (j == qt) || (j == qt - 1), cand = (j >= 1) && (j <= qt - 2);
                if (forced || (cand && cnt[k] < 13)) bits |= 1u << k;
            }
        }
        unsigned lo = sub < 4 ? bits << (sub * 8) : 0u, hi = sub >= 4 ? bits << ((sub - 4) * 8) : 0u;
        lo |= __shfl_xor(lo, 1); hi |= __shfl_xor(hi, 1); lo |= __shfl_xor(lo, 2); hi |= __shfl_xor(hi, 2); lo |= __shfl_xor(lo, 4); hi |= __shfl_xor(hi, 4);
        if (sub == 0) { sSel[q * 2] = lo; sSel[q * 2 + 1] = hi; }
    }
    __syncthreads();
    if (w == 0) {
        unsigned lo = sSel[lane * 2], hi = sSel[lane * 2 + 1];
#pragma unroll
        for (int x = 1; x < 64; x <<= 1) { lo |= __shfl_xor(lo, x); hi |= __shfl_xor(hi, x); }
        if (lane == 0) {
            int n = 0;
            for (int j = 0; j <= qt; ++j) { const unsigned bit = j < 32 ? (lo >> j) : (hi >> (j - 32)); if (bit & 1u) sList[n++] = j; }
            *sCnt = n;
        }
    }
    __syncthreads();
    {
        const int nsel = *sCnt;
        const unsigned lo = sSel[qs * 2], hi = sSel[qs * 2 + 1];
        m = -1e30f; l = 0.f; zero16(o[0]); zero16(o[1]);
        attn_run<64, true, STAG_SLC>(lds, B.KS + (size_t)bg * S * 64, nullptr, B.VST + (size_t)bg * 64 * S, S, nsel, TileList{sList}, MaskSlc{tq, lo, hi, qt}, NoSkip{}, c, qf, m, l, o);
        const float lt = l + __shfl_xor(l, 32); const float iv = (lt > 0.f ? 1.f / lt : 0.f) * B.GN[row * 24 + 8 + head];
#pragma unroll
        for (int dt = 0; dt < 2; ++dt)
#pragma unroll
            for (int e = 0; e < 16; ++e) stash[(dt * 16 + e) * 64] += o[dt][e] * iv;
    }
    {
        const int t0 = qt >= 8 ? qt - 8 : 0;
        m = -1e30f; l = 0.f; zero16(o[0]); zero16(o[1]);
        attn_run<64, false, STAG_WIN>(lds, B.KW + (size_t)bg * S * 64, nullptr, B.VWT + (size_t)bg * 64 * S, S, qt - t0 + 1, TileOff{t0}, MaskWin{tq, qt * 64 + (w & 1) * 32}, NoSkip{}, c, qf, m, l, o);
        const float lt = l + __shfl_xor(l, 32); const float iv = (lt > 0.f ? 1.f / lt : 0.f) * B.GN[row * 24 + 16 + head];
#pragma unroll
        for (int dt = 0; dt < 2; ++dt)
#pragma unroll
            for (int e = 0; e < 16; ++e) o[dt][e] = stash[(dt * 16 + e) * 64] + o[dt][e] * iv;
    }
    bf16_t* orow = B.OAB + row * 1024 + head * 64;
#pragma unroll
    for (int dt = 0; dt < 2; ++dt)
#pragma unroll
        for (int a = 0; a < 4; ++a) {
            u32x2 w2 = {pk2(o[dt][4 * a], o[dt][4 * a + 1]), pk2(o[dt][4 * a + 2], o[dt][4 * a + 3])};
            *(u32x2*)(orow + 32 * dt + 8 * a + 4 * hh) = w2;
        }
}

DI void mla_unit(const Bufs& B, LAS unsigned char* lds, int b, int h, int qb) {
    const int tid = my_tid(), lane = tid & 63, w = __builtin_amdgcn_readfirstlane(tid >> 6), hh = lane >> 5;
    const int tq = qb * 256 + w * 32 + (lane & 31);
    const size_t row = (size_t)b * S + tq;
    bf16x8 qf[6];
#pragma unroll
    for (int ks = 0; ks < 6; ++ks) qf[ks] = *(const bf16x8*)(B.QM + row * 768 + h * 96 + ks * 16 + hh * 8);
    const float c = 0.10206207261596575f * LOG2E;
    float m = -1e30f, l = 0.f; f32x16 o[2]; zero16(o[0]); zero16(o[1]);
    attn_run<96, false, STAG_MLA>(lds, B.KM + (size_t)(b * 8 + h) * S * 64, B.KPE + (size_t)b * S * 32, B.VMT + (size_t)(b * 8 + h) * 64 * S, S, 4 * (qb + 1),
                 TileId{}, MaskCausal{tq, qb * 256 + w * 32}, SkipAbove{qb * 256 + w * 32 + 31}, c, qf, m, l, o);
    const float lt = l + __shfl_xor(l, 32); const float iv = lt > 0.f ? 1.f / lt : 0.f;
    bf16_t* orow = B.OAB + row * 1024 + 512 + h * 64;
#pragma unroll
    for (int dt = 0; dt < 2; ++dt)
#pragma unroll
        for (int a = 0; a < 4; ++a) {
            u32x2 w2 = {pk2(o[dt][4 * a] * iv, o[dt][4 * a + 1] * iv), pk2(o[dt][4 * a + 2] * iv, o[dt][4 * a + 3] * iv)};
            *(u32x2*)(orow + 32 * dt + 8 * a + 4 * hh) = w2;
        }
}

DI void attn_phase(const Bufs& B, LAS unsigned char* lds, unsigned* counter) {
    LAS int* sUnit = (LAS int*)(lds + MISC_OFF); int it_ = 0; (void)sUnit; (void)it_; (void)counter;
    for (;;) {
#if ATT_STATIC
        __syncthreads();
        const int u = (int)blockIdx.x + 256 * it_; ++it_;
        if (u >= 2048) break;
#else
        __syncthreads();
        if (threadIdx.x == 0) *sUnit = (int)atomicAdd(counter, 1u);
        __syncthreads();
        const int u = *sUnit;
        if (u >= 2048) break;
#endif
        const int i = u >> 1;
        if ((u & 1) == 0) {
#if EXP_ATT == 2
            { const int b = (i & 63) >> 3, h = i & 7, qb = 15 - (i >> 6);
              for (int e = threadIdx.x; e < 2048; e += 512) *(u32x4*)(B.OAB + ((size_t)b * S + qb * 256 + (e >> 3)) * 1024 + 512 + h * 64 + (e & 7) * 8) = (u32x4){0x3c003c00u, 0x3c003c00u, 0x3c003c00u, 0x3c003c00u}; }
#else
            mla_unit(B, lds, (i & 63) >> 3, i & 7, 15 - (i >> 6));
#if ATT_DUP == 1
            __syncthreads(); mla_unit(B, lds, (i & 63) >> 3, i & 7, 15 - (i >> 6));
#endif
#endif
        } else {
#if EXP_ATT == 1
            { const int b = (i & 15) >> 1, g = i & 1, qt = 63 - (i >> 4);
              for (int e = threadIdx.x; e < 2048; e += 512) *(u32x4*)(B.OAB + ((size_t)b * S + qt * 64 + (e >> 5)) * 1024 + g * 256 + (e & 31) * 8) = (u32x4){0x3c003c00u, 0x3c003c00u, 0x3c003c00u, 0x3c003c00u}; }
#else
            nsa_unit(B, lds, (i & 15) >> 1, i & 1, 63 - (i >> 4));
#if ATT_DUP == 2
            __syncthreads(); nsa_unit(B, lds, (i & 15) >> 1, i & 1, 63 - (i >> 4));
#endif
#endif
        }
    }
}

DI float wave_sum(float v) {
#pragma unroll
    for (int o = 1; o < 64; o <<= 1) v += __shfl_xor(v, o);
    return v;
}
DI void norm_rows_bf16(const float* x, const float* g, bf16_t* xn) {
    const int tid_ = my_tid(), lane = tid_ & 63, gw = blockIdx.x * 8 + (tid_ >> 6), ngw = gridDim.x * 8;
    f32x4 gv[4];
#pragma unroll
    for (int j = 0; j < 4; ++j) gv[j] = ((const f32x4*)g)[lane + 64 * j];
    for (int r = gw; r < M; r += ngw) {
        const f32x4* xr = (const f32x4*)(x + (size_t)r * D) + lane;
        f32x4 v[4]; float s = 0.f;
#pragma unroll
        for (int j = 0; j < 4; ++j) { v[j] = xr[64 * j]; s += (v[j][0] * v[j][0] + v[j][1] * v[j][1]) + (v[j][2] * v[j][2] + v[j][3] * v[j][3]); }
        const float rstd = rsqrtf(wave_sum(s) * (1.f / D) + EPS);
        u32x2* o8 = (u32x2*)(xn + (size_t)r * D) + lane;
#pragma unroll
        for (int j = 0; j < 4; ++j) o8[64 * j] = (u32x2){pk2(v[j][0] * rstd * gv[j][0], v[j][1] * rstd * gv[j][1]), pk2(v[j][2] * rstd * gv[j][2], v[j][3] * rstd * gv[j][3])};
    }
}
DI void norm_rows_f32_inplace(float* x, const float* g) {
    const int tid_ = my_tid(), lane = tid_ & 63, gw = blockIdx.x * 8 + (tid_ >> 6), ngw = gridDim.x * 8;
    f32x4 gv[4];
#pragma unroll
    for (int j = 0; j < 4; ++j) gv[j] = ((const f32x4*)g)[lane + 64 * j];
    for (int r = gw; r < M; r += ngw) {
        f32x4* xr = (f32x4*)(x + (size_t)r * D) + lane;
        f32x4 v[4]; float s = 0.f;
#pragma unroll
        for (int j = 0; j < 4; ++j) { v[j] = xr[64 * j]; s += (v[j][0] * v[j][0] + v[j][1] * v[j][1]) + (v[j][2] * v[j][2] + v[j][3] * v[j][3]); }
        const float rstd = rsqrtf(wave_sum(s) * (1.f / D) + EPS);
#pragma unroll
        for (int j = 0; j < 4; ++j) xr[64 * j] = (f32x4){v[j][0] * rstd * gv[j][0], v[j][1] * rstd * gv[j][1], v[j][2] * rstd * gv[j][2], v[j][3] * rstd * gv[j][3]};
    }
}

DI int perm64(int p) { return (p >> 1) + 32 * (p & 1); }
DI int perm32r(int p) { return (p >> 1) + 16 * (p & 1); }
DI int map_in(int c) {
    if (c < 512) return (c & ~63) + perm64(c & 63);
    if (c < 1280) { const int t = (c - 512) >> 8, cc = (c - 512) & 255, kv = cc >> 7, g = (cc >> 6) & 1, p = cc & 63; return 512 + t * 256 + kv * 128 + g * 64 + (kv == 0 ? perm64(p) : p); }
    if (c < 1536) return 1304 + (c - 1280);
    if (c < 1792) { const int cc = c - 1536; if (cc < 128) return 1560 + cc; if (cc < 160) return 1688 + perm32r(cc - 128); if (cc < 184) return 1280 + (cc - 160); return -1; }
    if (c < 2816) return 1720 + (c - 1792);
    return 2744 + (c - 2816);
}
struct Wts {
    const float *w_in, *cmp_pe, *cmp_w1, *cmp_w2, *nsa_w_o, *q_norm, *kv_norm, *w_uq, *w_ukv, *mla_w_o, *w_out, *w_up, *w_down;
};
template <int JOB> DI float prep_get(const Wts& W, int n, int k) {
    if constexpr (JOB == 0) { const int c = map_in(n); return c >= 0 ? W.w_in[(size_t)k * IN_COLS + c] : 0.f; }
    if constexpr (JOB == 1) { const int j = n >> 8, h = n & 255, lp = k >> 6, p = k & 63, d = j == 0 ? perm64(p) : p; return W.cmp_w1[((size_t)j * 2048 + lp * 64 + d) * 256 + h]; }
    if constexpr (JOB == 2) { const int j = n >> 8, np = n & 255; return np < 64 ? W.cmp_w2[((size_t)j * 256 + k) * 64 + (j == 0 ? perm64(np) : np)] : 0.f; }
    if constexpr (JOB == 3) { return n < 1024 ? W.nsa_w_o[(size_t)k * 1024 + n] : W.mla_w_o[(size_t)k * 1024 + (n - 1024)]; }
    if constexpr (JOB == 4) { const int hh = n / 96, c = n - hh * 96; const int sc = c < 64 ? n : hh * 96 + 64 + perm32r(c - 64); return W.q_norm[k] * W.w_uq[(size_t)k * 768 + sc]; }
    if constexpr (JOB == 5) { return k < 128 ? W.kv_norm[k] * W.w_ukv[(size_t)k * 1024 + n] : 0.f; }
    if constexpr (JOB == 6) { return W.w_out[(size_t)k * 1024 + n]; }
    if constexpr (JOB == 7) { return W.w_up[(size_t)k * 4096 + n]; }
    if constexpr (JOB == 8) { return W.w_down[(size_t)k * 1024 + n]; }
    return 0.f;
}
template <int JOB> DI void prep_tile(const Wts& W, LAS float* scr, bf16_t* dst, int ldd, int n0, int k0) {
    const int tid = my_tid();
#pragma unroll
    for (int it = 0; it < 8; ++it) { const int kk = it * 8 + (tid >> 6), nn = tid & 63; scr[kk * 65 + nn] = prep_get<JOB>(W, n0 + nn, k0 + kk); }
    __syncthreads();
    { const int n = tid >> 3, kc = tid & 7; const LAS float* s = scr + (kc * 8) * 65 + n;
      u32x4 o = {pk2(s[0], s[65]), pk2(s[130], s[195]), pk2(s[260], s[325]), pk2(s[390], s[455])};
      *(u32x4*)(dst + (size_t)(n0 + n) * ldd + k0 + kc * 8) = o; }
    __syncthreads();
}
DI void prep_tile_vec(const float* src, int ldsrc, LAS float* scr, bf16_t* dst, int ldd, int n0, int k0) {
    const int tid = my_tid();
#pragma unroll
    for (int it = 0; it < 2; ++it) { const int kk = it * 32 + (tid >> 4), n4 = (tid & 15) * 4;
        const f32x4 v = *(const f32x4*)(src + (size_t)(k0 + kk) * ldsrc + n4);
        LAS float* d = scr + kk * 65 + n4; d[0] = v[0]; d[1] = v[1]; d[2] = v[2]; d[3] = v[3]; }
    __syncthreads();
    { const int n = tid >> 3, kc = tid & 7; const LAS float* s = scr + (kc * 8) * 65 + n;
      u32x4 o = {pk2(s[0], s[65]), pk2(s[130], s[195]), pk2(s[260], s[325]), pk2(s[390], s[455])};
      *(u32x4*)(dst + (size_t)(n0 + n) * ldd + k0 + kc * 8) = o; }
    __syncthreads();
}
DI void prep_phase(const Wts& W, unsigned char* ws, LAS unsigned char* lds, int layer) {
    LAS float* scr = (LAS float*)lds;
    const int tid = my_tid();
    constexpr int T0 = 960, T1 = T0 + 256, T2 = T1 + 32, T3 = T2 + 256, T4 = T3 + 48, T5 = T4 + 64, T6_ = T5 + 256, T7 = T6_ + 1024, T8 = T7 + 1024, TB = T8 + 8;
    for (int job = blockIdx.x; job < TB; job += gridDim.x) {
        int r = job;
        if (r < T0) { const int n0 = (r >> 4) * 64, k0 = (r & 15) * 64;
            if ((n0 >= 1280 && n0 < 1536) || n0 >= 1792) prep_tile_vec(W.w_in + map_in(n0), IN_COLS, scr, (bf16_t*)(ws + WS_WIN), 1024, n0, k0);
            else prep_tile<0>(W, scr, (bf16_t*)(ws + WS_WIN), 1024, n0, k0);
            continue; }
        if (r < T1) { r -= T0; prep_tile<1>(W, scr, (bf16_t*)(ws + WS_W1T), 2048, (r >> 5) * 64, (r & 31) * 64); continue; }
        if (r < T2) { r -= T1; prep_tile<2>(W, scr, (bf16_t*)(ws + WS_W2T), 256, (r >> 2) * 64, (r & 3) * 64); continue; }
        if (r < T3) { r -= T2; const int n0 = (r >> 3) * 64, k0 = (r & 7) * 64;
            prep_tile_vec(n0 < 1024 ? W.nsa_w_o + n0 : W.mla_w_o + (n0 - 1024), 1024, scr, (bf16_t*)(ws + WS_WOAB), 512, n0, k0); continue; }
        if (r < T4) { r -= T3; prep_tile<4>(W, scr, (bf16_t*)(ws + WS_WUQ), 256, (r >> 2) * 64, (r & 3) * 64); continue; }
        if (r < T5) { r -= T4; prep_tile<5>(W, scr, (bf16_t*)(ws + WS_WUKV), 256, (r >> 2) * 64, (r & 3) * 64); continue; }
        if (r < T6_) { r -= T5; const int n0 = (r >> 4) * 64; prep_tile_vec(W.w_out + n0, 1024, scr, (bf16_t*)(ws + WS_WOUT), 1024, n0, (r & 15) * 64); continue; }
        if (r < T7) { r -= T6_; const int n0 = (r >> 4) * 64; prep_tile_vec(W.w_up + n0, 4096, scr, (bf16_t*)(ws + WS_WUP), 1024, n0, (r & 15) * 64); continue; }
        if (r < T8) { r -= T7; const int n0 = (r >> 6) * 64; prep_tile_vec(W.w_down + n0, 1024, scr, (bf16_t*)(ws + WS_WDN), 4096, n0, (r & 63) * 64); continue; }
        {
            r -= T8; const int j = r >> 2, hc = r & 3, kk = tid >> 6, hx = tid & 63, h = hc * 64 + hx;
            float a = 0.f;
            for (int i = 0; i < 256; ++i) { const int k = kk + 8 * i; a += W.cmp_pe[j * 2048 + k] * W.cmp_w1[((size_t)j * 2048 + k) * 256 + h]; }
            scr[kk * 64 + hx] = a;
            __syncthreads();
            if (tid < 64) { float s = 0.f; for (int q = 0; q < 8; ++q) s += scr[q * 64 + tid]; ((float*)(ws + WS_CB1))[j * 256 + hc * 64 + tid] = s; }
            __syncthreads();
        }
    }
    if (layer == 0) {
        f32x2* cs64 = (f32x2*)(ws + WS_CS64); f32x2* cs32 = (f32x2*)(ws + WS_CS32);
        for (int idx = blockIdx.x * 512 + tid; idx < S * 48; idx += gridDim.x * 512) {
            int pos, i; float inv;
            if (idx < S * 32) { pos = idx >> 5; i = idx & 31; inv = (float)exp2(-(double)i * (13.287712379549449 / 32.0)); }
            else { const int e = idx - S * 32; pos = e >> 4; i = e & 15; inv = (float)exp2(-(double)i * (13.287712379549449 / 16.0)); }
            const float ang = (float)pos * inv;
            const double rev = (double)ang * 0.15915494309189535; const float fr = (float)(rev - floor(rev));
            const f32x2 v = {__builtin_amdgcn_cosf(fr), __builtin_amdgcn_sinf(fr)};
            if (idx < S * 32) cs64[idx] = v; else cs32[idx - S * 32] = v;
        }
    }
}

struct Params { const float* in[17]; float* out; unsigned char* ws; int ph_lo, ph_hi; };
typedef const __attribute__((address_space(4))) unsigned char* kaptr_t;
DI const float* karg_ptr(int byte_off) { kaptr_t ka = (kaptr_t)__builtin_amdgcn_kernarg_segment_ptr(); asm volatile("" : "+s"(ka)); return *(const float* const __attribute__((address_space(4)))*)(ka + byte_off); }
#define KIN(i) karg_ptr(8 * (i))

DI void grid_barrier_cg(cg::grid_group& grid) {
    asm volatile("s_waitcnt vmcnt(0) lgkmcnt(0)" ::: "memory");
    __syncthreads();
    if (threadIdx.x < 64) asm volatile("buffer_wbl2 sc1\n\ts_waitcnt vmcnt(0)" ::: "memory");
    __syncthreads();
    grid.sync();
    asm volatile("buffer_inv sc1\n\ts_waitcnt vmcnt(0)" ::: "memory");
}

#define XB_TMO      128
#define XB_XCNT(j)  (256  + 64 * (j))
#define XB_XSUB(j)  (1280 + 64 * (j))
#define XB_XGEN(j)  (2304 + 64 * (j))
#define XB_TOP      3328
#define XB_TOPGEN   3392
#define XCD_BAR_WORDS 3456
#define XB_SPIN_CAP (1u << 18)
DI unsigned xb_ld(unsigned* p)              { return __hip_atomic_load(p, __ATOMIC_RELAXED, __HIP_MEMORY_SCOPE_AGENT); }
DI unsigned xb_add(unsigned* p, unsigned v) { return __hip_atomic_fetch_add(p, v, __ATOMIC_RELAXED, __HIP_MEMORY_SCOPE_AGENT); }
DI unsigned xb_xcc_id() { return (unsigned)__builtin_amdgcn_s_getreg((3 << 11) | 20) & 0xFu; }
#define XB_SPIN(cond, bar) do { unsigned _sp = 0; while (cond) { __builtin_amdgcn_s_sleep(1); \
    if ((++_sp & 255u) == 0u) { if (xb_ld(&(bar)[XB_TMO])) break; if (_sp > XB_SPIN_CAP) { atomicAdd(&(bar)[XB_TMO], 1u); break; } } } } while (0)
DI void xcd_barrier_complete(unsigned* bar, unsigned x, unsigned& nloc, unsigned& nx) {
    const unsigned G = gridDim.x * gridDim.y * gridDim.z;
    unsigned sum, cnt, mine, sp = 0u;
    for (;;) {
        sum = 0u; cnt = 0u; mine = 0u;
#pragma unroll
        for (unsigned j = 0; j < 16; ++j) { const unsigned c = xb_ld(&bar[XB_XCNT(j)]); sum += c; cnt += (c > 0u) ? 1u : 0u; mine = (j == x) ? c : mine; }
        if (sum == G) break;
        __builtin_amdgcn_s_sleep(1);
        if ((++sp & 255u) == 0u) { if (xb_ld(&bar[XB_TMO])) break; if (sp > XB_SPIN_CAP) { atomicAdd(&bar[XB_TMO], 1u); break; } }
    }
    nloc = mine > 0u ? mine : 1u; nx = cnt > 0u ? cnt : 1u;
}
DI void xcd_barrier(unsigned* bar, volatile LAS unsigned* st) {
    asm volatile("s_waitcnt vmcnt(0)" ::: "memory");
    __syncthreads();
    if (threadIdx.x == 0) {
        const unsigned x = xb_xcc_id();
        __builtin_amdgcn_s_waitcnt(0);
        unsigned nloc = st[0], nx = st[1];
        if (nloc == 0u) { xcd_barrier_complete(bar, x, nloc, nx); st[0] = nloc; st[1] = nx; }
        const unsigned old = xb_add(&bar[XB_XSUB(x)], 1u);
        const unsigned gen = old / nloc;
        if (old + 1u == (gen + 1u) * nloc) {
            __builtin_amdgcn_fence(__ATOMIC_RELEASE, "agent");
            asm volatile("s_waitcnt vmcnt(0)" ::: "memory");
            const unsigned og = xb_add(&bar[XB_TOP], 1u);
            const unsigned tg = og / nx;
            if (og + 1u == (tg + 1u) * nx) xb_add(&bar[XB_TOPGEN], 1u);
            else XB_SPIN(xb_ld(&bar[XB_TOPGEN]) == tg, bar);
            __builtin_amdgcn_fence(__ATOMIC_ACQUIRE, "agent");
            xb_add(&bar[XB_XGEN(x)], 1u);
            asm volatile("s_waitcnt vmcnt(0)" ::: "memory");
        } else {
            XB_SPIN(xb_ld(&bar[XB_XGEN(x)]) == gen, bar);
            __builtin_amdgcn_fence(__ATOMIC_ACQUIRE, "agent");
            asm volatile("s_waitcnt vmcnt(0)" ::: "memory");
        }
    }
    __syncthreads();
}
template <bool FIRST> DI void grid_barrier(cg::grid_group& grid, LAS unsigned char* lds) {
    unsigned* bar = (unsigned*)((unsigned char*)karg_ptr(144) + WS_BAR);
    if constexpr (FIRST) {
        grid_barrier_cg(grid);
        if (threadIdx.x == 0) (void)xb_add(&bar[XB_XCNT(xb_xcc_id())], 1u);
    } else {
        xcd_barrier(bar, (volatile LAS unsigned*)(lds + MISC_OFF + 64));
    }
}

#define PH_IN(k) (lo <= (k) && (k) < hi)
#define PH_SEAM(k) do { if (PH_IN(k) && PH_IN((k) + 1)) grid_barrier<(k) == 0>(grid, lds); } while (0)
#define PH_ENV() int G = gridDim.x, bx = blockIdx.x; asm volatile("" : "+s"(G), "+s"(bx)); unsigned char* ws = (unsigned char*)karg_ptr(144); float* X = (float*)karg_ptr(136); \
                 const int tid = my_tid(); bf16_t* XN = (bf16_t*)(ws + WS_XN); (void)tid; (void)X; (void)XN; (void)G; (void)bx

template <int L> DI void run_layer(LAS unsigned char* lds, cg::grid_group& grid, int lo, int hi) {
    constexpr int P0 = 10 * L;
    if (PH_IN(P0 + 0)) for (int rep_ = 0; rep_ < ((((DUP_MASK >> 0) & 1) && L > 0) ? 2 : 1); ++rep_) { if (rep_) grid_barrier<false>(grid, lds);
        PH_ENV();
        Wts W;
        W.w_in = KIN(2) + (size_t)L * 1024 * IN_COLS; W.cmp_pe = KIN(3) + (size_t)L * 2 * 2048; W.cmp_w1 = KIN(4) + (size_t)L * 2 * 2048 * 256;
        W.cmp_w2 = KIN(5) + (size_t)L * 2 * 256 * 64; W.nsa_w_o = KIN(6) + (size_t)L * 512 * 1024; W.q_norm = KIN(7) + L * 256; W.kv_norm = KIN(8) + L * 128;
        W.w_uq = KIN(9) + (size_t)L * 256 * 768; W.w_ukv = KIN(10) + (size_t)L * 128 * 1024; W.mla_w_o = KIN(11) + (size_t)L * 512 * 1024;
        W.w_out = KIN(12) + (size_t)L * 1024 * 1024; W.w_up = KIN(14) + (size_t)L * 1024 * 4096; W.w_down = KIN(15) + (size_t)L * 4096 * 1024;
        prep_phase(W, ws, lds, L);
        unsigned* ctl = (unsigned*)(ws + WS_CTL);
        if (L == 0 && bx == 0 && tid < 2 * NL) atomicExch(ctl + tid * 64, 0u);
        norm_rows_bf16(L == 0 ? KIN(0) : X, KIN(1) + L * D, XN);
    }
    PH_SEAM(P0 + 0);
    if (PH_IN(P0 + 1)) for (int rep_ = 0; rep_ < (((DUP_MASK >> 1) & 1) ? 2 : 1); ++rep_) { if (rep_) grid_barrier<false>(grid, lds);
        PH_ENV();
        pg8::Gemm g{XN, (const bf16_t*)(ws + WS_WIN), 1024, 1024}; pg8::StaticOrder So; So.init(M, NIN, G, bx);
        EpiWrap<EpiInImpl> E; E.ws = ws;
        pg8::gemm_phase(lds, g, So, E);
    }
    PH_SEAM(P0 + 1);
    if (PH_IN(P0 + 2)) for (int rep_ = 0; rep_ < (((DUP_MASK >> 2) & 1) ? 2 : 1); ++rep_) { if (rep_) grid_barrier<false>(grid, lds);
        PH_ENV();
        if (bx < 32) {
            pg8::CmpOrder So{G, bx};
            { pg8::Gemm g{(const bf16_t*)(ws + WS_KCV), (const bf16_t*)(ws + WS_W1T), 1024, 2048}; EpiWrap<EpiC1Impl> E; E.ws = ws; pg8::gemm_phase(lds, g, So, E); }
            { pg8::Gemm g{(const bf16_t*)(ws + WS_HC), (const bf16_t*)(ws + WS_W2T), 256, 256}; EpiWrap<EpiC2Impl> E; E.ws = ws; pg8::gemm_phase(lds, g, So, E); }
        } else {
            { pg8::Gemm g{(const bf16_t*)(ws + WS_CQ), (const bf16_t*)(ws + WS_WUQ), 256, 256}; pg8::StaticOrder So; So.init(M, 768, G - 32, bx - 32);
              EpiWrap<EpiUQImpl> E; E.ws = ws;
              pg8::gemm_phase(lds, g, So, E); }
            { pg8::Gemm g{(const bf16_t*)(ws + WS_T6), (const bf16_t*)(ws + WS_WUKV), 256, 256}; pg8::StaticOrder So; So.init(M, 1024, G - 32, bx - 32);
              EpiWrap<EpiUKVImpl> E; E.ws = ws;
              pg8::gemm_phase(lds, g, So, E); }
        }
    }
    PH_SEAM(P0 + 2);
    if (PH_IN(P0 + 4)) for (int rep_ = 0; rep_ < (((DUP_MASK >> 4) & 1) ? 2 : 1); ++rep_) { if (rep_) grid_barrier<false>(grid, lds);
        PH_ENV();
        Bufs B; B.QN = (const bf16_t*)(ws + WS_QN); B.KS = (const bf16_t*)(ws + WS_KS); B.KW = (const bf16_t*)(ws + WS_KW); B.VST = (const bf16_t*)(ws + WS_VST);
        B.VWT = (const bf16_t*)(ws + WS_VWT); B.KCMP = (const bf16_t*)(ws + WS_KCMP); B.VCMPT = (const bf16_t*)(ws + WS_VCMPT); B.QM = (const bf16_t*)(ws + WS_QM);
        B.KM = (const bf16_t*)(ws + WS_KM); B.KPE = (const bf16_t*)(ws + WS_KPE); B.VMT = (const bf16_t*)(ws + WS_VMT); B.GN = (const float*)(ws + WS_GN); B.OAB = XN;
#if EXP_NOATTN
        { u32x4* o = (u32x4*)XN; for (size_t i = (size_t)bx * 512 + tid; i < (size_t)M * 1024 / 8; i += (size_t)G * 512) o[i] = (u32x4){0x3c003c00u, 0x3c003c00u, 0x3c003c00u, 0x3c003c00u}; (void)B; }
#else
        attn_phase(B, lds, (unsigned*)(ws + WS_CTL) + (L * 2 + rep_) * 64);
#endif
    }
    PH_SEAM(P0 + 4);
    if (PH_IN(P0 + 5)) for (int rep_ = 0; rep_ < (((DUP_MASK >> 5) & 1) ? 2 : 1); ++rep_) { if (rep_) grid_barrier<false>(grid, lds);
        PH_ENV();
        pg8::StaticOrder So; So.init(M, 1024, G, bx);
        { pg8::Gemm g{XN, (const bf16_t*)(ws + WS_WOAB), 1024, 512}; EpiWrap<EpiD1aImpl> E; E.ws = ws; pg8::gemm_phase(lds, g, So, E); }
        { pg8::Gemm g{XN + 512, (const bf16_t*)(ws + WS_WOAB) + 1024 * 512, 1024, 512}; EpiWrap<EpiD1bImpl> E; E.ws = ws; pg8::gemm_phase(lds, g, So, E); }
    }
    PH_SEAM(P0 + 5);
    if (PH_IN(P0 + 6)) for (int rep_ = 0; rep_ < (((DUP_MASK >> 6) & 1) ? 2 : 1); ++rep_) { if (rep_) grid_barrier<false>(grid, lds);
        PH_ENV();
        pg8::Gemm g{(const bf16_t*)(ws + WS_MG), (const bf16_t*)(ws + WS_WOUT), 1024, 1024}; pg8::StaticOrder So; So.init(M, 1024, G, bx);
        EpiWrap<EpiD2Impl> E; E.xin = (L == 0 ? KIN(0) : X); E.X = X;
        pg8::gemm_phase(lds, g, So, E);
    }
    PH_SEAM(P0 + 6);
    if (PH_IN(P0 + 7)) for (int rep_ = 0; rep_ < (((DUP_MASK >> 7) & 1) ? 2 : 1); ++rep_) { if (rep_) grid_barrier<false>(grid, lds);
        PH_ENV();
        norm_rows_bf16(X, KIN(13) + L * D, XN);
    }
    PH_SEAM(P0 + 7);
    if (PH_IN(P0 + 8)) for (int rep_ = 0; rep_ < (((DUP_MASK >> 8) & 1) ? 2 : 1); ++rep_) { if (rep_) grid_barrier<false>(grid, lds);
        PH_ENV();
        pg8::Gemm g{XN, (const bf16_t*)(ws + WS_WUP), 1024, 1024}; pg8::StaticOrder So; So.init(M, FF, G, bx);
        EpiWrap<EpiUpImpl> E; E.ws = ws;
        pg8::gemm_phase(lds, g, So, E);
    }
    PH_SEAM(P0 + 8);
    if (PH_IN(P0 + 9)) for (int rep_ = 0; rep_ < (((DUP_MASK >> 9) & 1) ? 2 : 1); ++rep_) { if (rep_) grid_barrier<false>(grid, lds);
        PH_ENV();
        pg8::Gemm g{(const bf16_t*)(ws + WS_HF), (const bf16_t*)(ws + WS_WDN), 4096, 4096}; pg8::StaticOrder So; So.init(M, 1024, G, bx);
        EpiWrap<EpiD2Impl> E; E.xin = X; E.X = X;
        pg8::gemm_phase(lds, g, So, E);
    }
    PH_SEAM(P0 + 9);
}

__global__ void __launch_bounds__(512, 2) mega(Params P) {
    extern __shared__ __attribute__((aligned(16))) unsigned char lds_raw[];
    LAS unsigned char* lds = (LAS unsigned char*)lds_raw;
    cg::grid_group grid = cg::this_grid();
    const int lo = P.ph_lo, hi = P.ph_hi;
    if (threadIdx.x < 2) ((volatile LAS unsigned*)(lds + MISC_OFF + 64))[threadIdx.x] = 0u;
    if (blockIdx.x == 0 && hi - lo > 1) { unsigned* bar = (unsigned*)((unsigned char*)karg_ptr(144) + WS_BAR);
        for (int i = threadIdx.x; i < XCD_BAR_WORDS; i += 512) __hip_atomic_store(bar + i, 0u, __ATOMIC_RELAXED, __HIP_MEMORY_SCOPE_AGENT); }
    __syncthreads();
    run_layer<0>(lds, grid, lo, hi);
    run_layer<1>(lds, grid, lo, hi);
    run_layer<2>(lds, grid, lo, hi);
    run_layer<3>(lds, grid, lo, hi);
    if (PH_IN(39) && PH_IN(40)) {   }
    if (PH_IN(40)) { float* X = (float*)karg_ptr(136); norm_rows_f32_inplace(X, KIN(16)); }
}

extern "C" void kernel_launch(void* const* d_in, const int* in_sizes, int n_in, void* d_out, int out_size, void* d_ws, size_t ws_size, hipStream_t stream) {
    static int grid = 0;
    if (grid == 0) {
        if (n_in != 17 || out_size != M * D || ws_size < WS_END) { fprintf(stderr, "kernel_launch: unexpected shapes (n_in %d out %d ws %zu)\n", n_in, out_size, ws_size); grid = -1; return; }
        int dev = 0, cus = 0, per_cu = 0;
        hipGetDevice(&dev);
        hipDeviceGetAttribute(&cus, hipDeviceAttributeMultiprocessorCount, dev);
        if (hipFuncSetAttribute((const void*)mega, hipFuncAttributeMaxDynamicSharedMemorySize, LDS_BYTES) != hipSuccess) { fprintf(stderr, "kernel_launch: hipFuncSetAttribute failed\n"); grid = -1; return; }
        if (hipOccupancyMaxActiveBlocksPerMultiprocessor(&per_cu, (const void*)mega, 512, LDS_BYTES) != hipSuccess || per_cu < 1) { fprintf(stderr, "kernel_launch: occupancy query gave %d\n", per_cu); per_cu = 1; }
        (void)hipGetLastError();
        grid = cus * per_cu;
        if (grid < 64) { fprintf(stderr, "kernel_launch: grid %d too small for the phase program\n", grid); grid = -1; return; }
    }
    if (grid < 0) return;
    Params p{};
    for (int i = 0; i < 17; ++i) p.in[i] = (const float*)d_in[i];
    p.out = (float*)d_out; p.ws = (unsigned char*)d_ws;
#if MK_MULTI
    for (int ph = 0; ph <= 40; ++ph) {
        p.ph_lo = ph; p.ph_hi = ph + 1;
        hipLaunchKernelGGL(mega, dim3(grid), dim3(512), LDS_BYTES, stream, p);
    }
#else
    p.ph_lo = 0; p.ph_hi = 41;
    void* args[] = {&p};
    hipError_t e = hipLaunchCooperativeKernel((const void*)mega, dim3(grid), dim3(512), args, LDS_BYTES, stream);
    if (e != hipSuccess) fprintf(stderr, "kernel_launch: cooperative launch failed: %s (grid %d)\n", hipGetErrorString(e), grid);
#endif
}
```

```cpp
#include <hip/hip_runtime.h>
#include <hip/hip_cooperative_groups.h>
#include <cstdio>
#include <cstdint>
namespace cg = cooperative_groups;

#ifndef EXP_NOATTN
#define EXP_NOATTN 0
#endif
#ifndef ATT_STATIC
#define ATT_STATIC 0
#endif
#ifndef EXP_ATT
#define EXP_ATT 0
#endif
#ifndef DUP_MASK
#define DUP_MASK 0
#endif
#ifndef ATT_DUP
#define ATT_DUP 0
#endif
#ifndef STAG_CMP
#define STAG_CMP false
#define STAG_SLC false
#define STAG_WIN true
#define STAG_MLA true
#endif
#ifndef MK_MULTI
#define MK_MULTI 0
#endif

#define LAS __attribute__((address_space(3)))
#define DI __device__ __forceinline__
typedef unsigned short bf16_t;
typedef short bf16x8 __attribute__((ext_vector_type(8)));
typedef float f32x4 __attribute__((ext_vector_type(4)));
typedef float f32x2 __attribute__((ext_vector_type(2)));
typedef float f32x16 __attribute__((ext_vector_type(16)));
typedef unsigned u32x4 __attribute__((ext_vector_type(4)));
typedef unsigned u32x2 __attribute__((ext_vector_type(2)));
typedef __bf16 bf16v2 __attribute__((ext_vector_type(2)));

DI unsigned pk2(float lo, float hi) { f32x2 v = {lo, hi}; return __builtin_bit_cast(unsigned, __builtin_convertvector(v, bf16v2)); }
DI bf16_t f2bf(float x) { return (bf16_t)(pk2(x, 0.f) & 0xffffu); }
DI float bflo(unsigned w) { return __uint_as_float(w << 16); }
DI float bfhi(unsigned w) { return __uint_as_float(w & 0xffff0000u); }
DI float sigmoidf_(float x) { return 1.f / (1.f + __expf(-x)); }
DI float ex2(float x) { return __builtin_amdgcn_exp2f(x); }
DI int my_tid() { int t = threadIdx.x; asm volatile("" : "+v"(t)); return t; }

constexpr int NB = 8, S = 4096, D = 1024, NL = 4, M = NB * S, FF = 4096;
constexpr int NIN = 3840;
constexpr int IN_COLS = 3768;
constexpr float EPS = 1e-6f;
constexpr float LOG2E = 1.4426950408889634f;

constexpr size_t MiB = 1u << 20;
constexpr size_t WS_CTL = 0;
constexpr size_t WS_BAR = 16384;
constexpr size_t WS_CB1 = 4096;
constexpr size_t WS_RSQ = 65536;
constexpr size_t WS_RSKV = 65536 + 131072;
constexpr size_t WS_CS64 = 1 * MiB;
constexpr size_t WS_CS32 = 2 * MiB;
constexpr size_t WS_WIN = 3 * MiB;
constexpr size_t WS_W1T = WS_WIN + (size_t)NIN * 1024 * 2;
constexpr size_t WS_W2T = WS_W1T + 2 * MiB;
constexpr size_t WS_WOAB = WS_W2T + 256 * 1024;
constexpr size_t WS_WUQ = WS_WOAB + 2 * MiB;
constexpr size_t WS_WUKV = WS_WUQ + 384 * 1024;
constexpr size_t WS_WOUT = 16 * MiB;
constexpr size_t WS_WUP = 18 * MiB;
constexpr size_t WS_WDN = 26 * MiB;
constexpr size_t WS_XN = 34 * MiB;
constexpr size_t WS_GA = 98 * MiB;
constexpr size_t WS_GB = 162 * MiB;
constexpr size_t WS_QN = 226 * MiB;
constexpr size_t WS_KCV = 258 * MiB;
constexpr size_t WS_KS = 274 * MiB, WS_KW = 282 * MiB, WS_VST = 290 * MiB, WS_VWT = 298 * MiB;
constexpr size_t WS_CQ = 306 * MiB, WS_T6 = 322 * MiB, WS_KPE = 338 * MiB, WS_GN = 340 * MiB;
constexpr size_t WS_QM = 343 * MiB, WS_KM = 391 * MiB, WS_VMT = 423 * MiB, WS_HC = 455 * MiB;
constexpr size_t WS_KCMP = 459 * MiB, WS_VCMPT = WS_KCMP + 512 * 1024;
constexpr size_t WS_MG = 226 * MiB;
constexpr size_t WS_HF = 98 * MiB;
constexpr size_t WS_PQ = 460 * MiB;
constexpr size_t WS_PKV = 461 * MiB;
constexpr size_t WS_END = 462 * MiB;
static_assert(WS_WUKV + 512 * 1024 <= WS_WOUT, "ws map");

constexpr int LDS_BYTES = 147456;
constexpr int MISC_OFF = 147200;
constexpr int AT_K = 0, AT_KB = 13312  , AT_V = 26624, AT_VB = 9216  , AT_IMP = 54272, AT_SEL = 70656, AT_LIST = 71168, AT_CNT = 71424, AT_ACC = 71680;

namespace pg8 {
constexpr int BM = 256, BK = 64, HALF = 128, HTB = HALF * BK * 2, NXCD = 8, WGM = 8;
__host__ __device__ __forceinline__ int lds_byte(int r, int c) { const int st = (r >> 4) * 2 + (c >> 5), rr = r & 15, cc = c & 31, ob = rr * 64 + cc * 2; return st * 1024 + (ob ^ (((ob >> 9) & 1) << 5)); }
__host__ __device__ __forceinline__ void stage_rc(int b, int& R, int& C) { const int st = b / 1024, sb = b % 1024, swz = sb ^ (((sb >> 9) & 1) << 5); R = (st >> 1) * 16 + swz / 64; C = (st & 1) * 32 + (swz % 64) / 2; }
__host__ __device__ __forceinline__ int perm32(int rho) { const int n = rho >> 4, i = rho & 15; return 8 * (i >> 2) + 4 * n + (i & 3); }

struct Unit { int pm, pn; };
struct Gemm { const bf16_t* A; const bf16_t* Bt; int lda; int K; };

struct StaticOrder {
    int nM, nN, nwg, G, c;
    __device__ void init(int M_, int N_, int G_, int c_) { nM = M_ / BM; nN = N_ / BM; nwg = nM * nN; G = G_; c = c_; }
    __device__ bool next(int i, Unit& u) const {
        const long L = (long)i * G + c; if (L >= nwg) return false;
        int wgid = (int)L; { const int q = nwg / NXCD, r = nwg % NXCD, xcd = wgid % NXCD, off = wgid / NXCD; wgid = (xcd < r ? xcd * (q + 1) : r * (q + 1) + (xcd - r) * q) + off; }
        const int nig = WGM * nN, gid = wgid / nig, fm = gid * WGM, gsz = (nM - fm) < WGM ? (nM - fm) : WGM;
        u.pm = fm + ((wgid % nig) % gsz); u.pn = (wgid % nig) / gsz; return true;
    }
};
struct CmpOrder {
    int G, c;
    __device__ bool next(int i, Unit& u) const { const int L = i * G + c; if (L >= 32) return false; u.pm = L; u.pn = L >> 4; return true; }
};

template <class Epi, class Sched>
__device__ __forceinline__ void gemm_phase(LAS unsigned char* lds, const Gemm g, const Sched& S, const Epi& E) {
    const int tid = my_tid(), wid = __builtin_amdgcn_readfirstlane(tid >> 6), lane = tid & 63, wr = wid >> 2, wc = wid & 3, fr = lane & 15, fq = lane >> 4;
    const int K = g.K, nt = K / BK, lda = g.lda;
    unsigned voffA, voffB;
    { int R, C; stage_rc(tid * 16, R, C); const int Rb = (R & ~31) + perm32(R & 31);
        voffA = (unsigned)(R * lda + C) * 2u; voffB = (unsigned)(Rb * K + C) * 2u; }
    const size_t qvoffA = (size_t)64 * lda * 2, qvoffB = (size_t)64 * K * 2;
    const size_t kstep = (size_t)(BK * 2);
    const size_t hstepA = (size_t)HALF * lda * 2, hstepB = (size_t)HALF * K * 2;
    const size_t tstepA = 2 * hstepA, tstepB = 2 * hstepB;
    const unsigned ldsw = (unsigned)wid * 1024u;
    const int aoff = lds_byte(wr * 64 + fr, fq * 8), boff = lds_byte(wc * 32 + fr, fq * 8);
#define PG8_SA(b, h) (((b) * 2 + (h)) * HTB)
#define PG8_SB(b, h) ((4 + (b) * 2 + (h)) * HTB)
#define PG8_STAGE(bufoff, gbase, voff) do { _Pragma("unroll") for (int _i = 0; _i < 2; ++_i) \
        __builtin_amdgcn_global_load_lds((const unsigned*)((const char*)(gbase) + (size_t)_i * q##voff + (voff)), (LAS unsigned*)(lds + (bufoff) + ldsw + _i * 8192), 16, 0, 0); } while (0)
#define PG8_LDA(dst, b, h) do { _Pragma("unroll") for (int m = 0; m < 4; ++m) _Pragma("unroll") for (int k = 0; k < 2; ++k) dst[m][k] = *(const LAS bf16x8*)(lds + PG8_SA(b, h) + aoff + m * 2048 + k * 1024); } while (0)
#define PG8_LDB(dst, b, h) do { _Pragma("unroll") for (int n = 0; n < 2; ++n) _Pragma("unroll") for (int k = 0; k < 2; ++k) dst[n][k] = *(const LAS bf16x8*)(lds + PG8_SB(b, h) + boff + n * 2048 + k * 1024); } while (0)
#define PG8_MMA(ai, bj, At, Bt) do { __builtin_amdgcn_s_setprio(1); _Pragma("unroll") for (int m = 0; m < 4; ++m) _Pragma("unroll") for (int n = 0; n < 2; ++n) _Pragma("unroll") for (int k = 0; k < 2; ++k) \
        acc[ai][bj][m][n] = __builtin_amdgcn_mfma_f32_16x16x32_bf16(Bt[n][k], At[m][k], acc[ai][bj][m][n], 0, 0, 0); __builtin_amdgcn_s_setprio(0); } while (0)
#define PG8_WAIT_V(n) asm volatile("s_waitcnt vmcnt(" #n ")" ::: "memory")
#define PG8_WAIT_L(n) asm volatile("s_waitcnt lgkmcnt(" #n ")" ::: "memory")
#define PG8_BAR __builtin_amdgcn_s_barrier()
#define PG8_SCHED __builtin_amdgcn_sched_barrier(0)
    Unit cur, nxt; int ui = 0;
    if (!S.next(0, cur)) return;
    f32x4 acc[2][2][4][2];
#pragma unroll
    for (int a = 0; a < 2; ++a)
#pragma unroll
        for (int b = 0; b < 2; ++b)
#pragma unroll
            for (int m = 0; m < 4; ++m)
#pragma unroll
                for (int n = 0; n < 2; ++n) acc[a][b][m][n] = (f32x4){0.f, 0.f, 0.f, 0.f};
    bf16x8 At[4][2], B0[2][2], B1[2][2];
    const char* cA = (const char*)g.A + (size_t)cur.pm * tstepA; const char* cB = (const char*)g.Bt + (size_t)cur.pn * tstepB;
    PG8_STAGE(PG8_SB(0, 0), cB, voffB); PG8_STAGE(PG8_SB(0, 1), cB + hstepB, voffB); PG8_STAGE(PG8_SA(0, 0), cA, voffA); PG8_STAGE(PG8_SA(0, 1), cA + hstepA, voffA);
    if (wr == 1) PG8_BAR;
    PG8_WAIT_V(2); PG8_BAR;
    PG8_STAGE(PG8_SB(1, 0), cB + kstep, voffB); PG8_STAGE(PG8_SA(1, 0), cA + kstep, voffA); PG8_STAGE(PG8_SB(1, 1), cB + hstepB + kstep, voffB);
    PG8_WAIT_V(6); PG8_BAR;
    for (;;) {
        const bool has_next = S.next(ui + 1, nxt);
        const char* nA = has_next ? (const char*)g.A + (size_t)nxt.pm * tstepA : cA; const char* nB = has_next ? (const char*)g.Bt + (size_t)nxt.pn * tstepB : cB;
        for (int t = 0; t < nt; t += 2) {
            const bool last = (t == nt - 2);
            const char* a1 = cA + (size_t)(t + 1) * kstep;
            const char* a2 = last ? nA : cA + (size_t)(t + 2) * kstep; const char* b2 = last ? nB : cB + (size_t)(t + 2) * kstep;
            const char* a3 = a2 + kstep; const char* b3 = b2 + kstep;
            PG8_LDB(B0, 0, 0); PG8_LDB(B1, 0, 1); PG8_SCHED; PG8_LDA(At, 0, 0); PG8_STAGE(PG8_SA(1, 1), a1 + hstepA, voffA);
            PG8_WAIT_V(8); PG8_WAIT_L(0); PG8_BAR; PG8_MMA(0, 0, At, B0); PG8_MMA(0, 1, At, B1); PG8_BAR; PG8_SCHED;
            PG8_LDA(At, 0, 1); PG8_STAGE(PG8_SB(0, 0), b2, voffB); PG8_STAGE(PG8_SB(0, 1), b2 + hstepB, voffB); PG8_STAGE(PG8_SA(0, 0), a2, voffA);
            PG8_WAIT_V(8); PG8_WAIT_L(0); PG8_BAR; PG8_MMA(1, 0, At, B0); PG8_MMA(1, 1, At, B1); PG8_BAR; PG8_SCHED;
            PG8_LDB(B0, 1, 0); PG8_LDB(B1, 1, 1); PG8_SCHED; PG8_LDA(At, 1, 0); PG8_STAGE(PG8_SA(0, 1), a2 + hstepA, voffA);
            PG8_WAIT_V(8); PG8_WAIT_L(0); PG8_BAR; PG8_MMA(0, 0, At, B0); PG8_MMA(0, 1, At, B1); PG8_BAR; PG8_SCHED;
            PG8_LDA(At, 1, 1); PG8_STAGE(PG8_SB(1, 0), b3, voffB); PG8_STAGE(PG8_SB(1, 1), b3 + hstepB, voffB); PG8_STAGE(PG8_SA(1, 0), a3, voffA);
            PG8_WAIT_V(8); PG8_WAIT_L(0); PG8_BAR; PG8_MMA(1, 0, At, B0); PG8_MMA(1, 1, At, B1); PG8_BAR; PG8_SCHED;
        }
        if (wr == 0) PG8_BAR;
        E(acc, cur, wr, wc, fr, fq);
        if (!has_next) break;
#pragma unroll
        for (int a = 0; a < 2; ++a)
#pragma unroll
            for (int b = 0; b < 2; ++b)
#pragma unroll
                for (int m = 0; m < 4; ++m)
#pragma unroll
                    for (int n = 0; n < 2; ++n) acc[a][b][m][n] = (f32x4){0.f, 0.f, 0.f, 0.f};
        cur = nxt; cA = nA; cB = nB; ++ui;
        if (wr == 1) PG8_BAR;
    }
    PG8_WAIT_V(0);
    PG8_BAR;
#undef PG8_SA
#undef PG8_SB
#undef PG8_STAGE
#undef PG8_LDA
#undef PG8_LDB
#undef PG8_MMA
#undef PG8_WAIT_V
#undef PG8_WAIT_L
#undef PG8_BAR
#undef PG8_SCHED
}
}
using pg8::Unit;

DI void store8(bf16_t* p, const float (&v)[8]) { u32x4 w = {pk2(v[0], v[1]), pk2(v[2], v[3]), pk2(v[4], v[5]), pk2(v[6], v[7])}; *(u32x4*)p = w; }
DI void rope8(float (&v)[8], const f32x2* cs) {
    const f32x4 c0 = *(const f32x4*)cs, c1 = *(const f32x4*)(cs + 2);
    const float co[4] = {c0[0], c0[2], c1[0], c1[2]}, si[4] = {c0[1], c0[3], c1[1], c1[3]};
#pragma unroll
    for (int k = 0; k < 4; ++k) { const float a = v[2 * k], b = v[2 * k + 1]; v[2 * k] = a * co[k] - b * si[k]; v[2 * k + 1] = a * si[k] + b * co[k]; }
}
DI float sumsq_fq(const float (&v)[8]) {
    float s = 0.f;
#pragma unroll
    for (int e = 0; e < 8; ++e) s += v[e] * v[e];
    s += __shfl_xor(s, 16); s += __shfl_xor(s, 32); return s;
}

template <class Impl> struct EpiWrap : Impl {
    static constexpr bool MID = false;
    DI void operator()(const f32x4 (&acc)[2][2][4][2], const Unit& u, int wr, int wc, int, int) const {
        const int t2 = my_tid(), fr = t2 & 15, fq = (t2 >> 4) & 3;
#pragma unroll
        for (int ai = 0; ai < 2; ++ai)
#pragma unroll
            for (int m = 0; m < 4; ++m)
#pragma unroll
                for (int bj = 0; bj < 2; ++bj) {
                    const f32x4 a0 = acc[ai][bj][m][0], a1 = acc[ai][bj][m][1];
                    float v[8] = {a0[0], a0[1], a0[2], a0[3], a1[0], a1[1], a1[2], a1[3]};
                    this->chunk(u.pm * 256 + ai * 128 + wr * 64 + m * 16 + fr, u.pn, bj * 128 + wc * 32 + 8 * fq, v);
                }
    }
};

#define WSP(T, off) ((T*)(ws + (off)))
struct EpiInImpl {
    unsigned char* ws;
    DI void chunk(int row, int pn, int cc, float (&v)[8]) const {
        const int pos = row & (S - 1), b = row >> 12;
        bf16_t* const QN = WSP(bf16_t, WS_QN); bf16_t* const KCV = WSP(bf16_t, WS_KCV); bf16_t* const CQ = WSP(bf16_t, WS_CQ); bf16_t* const T6 = WSP(bf16_t, WS_T6);
        bf16_t* const KPE = WSP(bf16_t, WS_KPE); float* const GN = WSP(float, WS_GN); float* const PQ = WSP(float, WS_PQ); float* const PKV = WSP(float, WS_PKV);
        const f32x2* const CS64 = WSP(const f32x2, WS_CS64); const f32x2* const CS32 = WSP(const f32x2, WS_CS32);
        if (pn < 2) {
            rope8(v, CS64 + pos * 32 + ((cc & 63) >> 1));
            store8(QN + (size_t)row * 512 + pn * 256 + cc, v);
        } else if (pn < 5) {
            const int kv = cc >> 7, g = (cc >> 6) & 1, p = cc & 63, bg = b * 2 + g;
            if (kv == 0) {
                rope8(v, CS64 + pos * 32 + (p >> 1));
                bf16_t* dst = WSP(bf16_t, pn == 2 ? WS_KCV : (pn == 3 ? WS_KS : WS_KW));
                store8(dst + ((size_t)bg * S + pos) * 64 + p, v);
            } else if (pn == 2) {
                store8(KCV + ((size_t)(16 + bg) * S + pos) * 64 + p, v);
            } else {
                bf16_t* dst = WSP(bf16_t, pn == 3 ? WS_VST : WS_VWT);
#pragma unroll
                for (int e = 0; e < 8; ++e) dst[((size_t)bg * 64 + p + e) * S + pos] = f2bf(v[e]);
            }
        } else if (pn == 5) {
            store8(CQ + (size_t)row * 256 + cc, v);
            const float s = sumsq_fq(v);
            if ((threadIdx.x & 48) == 0) PQ[(size_t)row * 8 + (cc >> 5)] = s;
        } else if (pn == 6) {
            store8(T6 + (size_t)row * 256 + cc, v);
            if (cc < 128) {
                const float s = sumsq_fq(v);
                if ((threadIdx.x & 48) == 0) PKV[(size_t)row * 4 + (cc >> 5)] = s;
            } else if (cc < 160) {
                rope8(v, CS32 + pos * 16 + ((cc - 128) >> 1));
                store8(KPE + (size_t)row * 32 + (cc - 128), v);
            } else if (cc < 184) {
#pragma unroll
                for (int e = 0; e < 8; ++e) GN[(size_t)row * 24 + (cc - 160) + e] = sigmoidf_(v[e]);
            }
        } else {
#pragma unroll
            for (int e = 0; e < 8; ++e) v[e] = sigmoidf_(v[e]);
            if (pn < 11) store8(WSP(bf16_t, WS_GA) + (size_t)row * 1024 + (pn - 7) * 256 + cc, v);
            else store8(WSP(bf16_t, WS_GB) + (size_t)row * 1024 + (pn - 11) * 256 + cc, v);
        }
    }
};
struct EpiC1Impl {
    unsigned char* ws;
    DI void chunk(int row, int pn, int cc, float (&v)[8]) const {
        bf16_t* const HC = WSP(bf16_t, WS_HC); const float* const CB1 = WSP(const float, WS_CB1);
        const f32x4 b0 = *(const f32x4*)(CB1 + pn * 256 + cc), b1 = *(const f32x4*)(CB1 + pn * 256 + cc + 4);
        const float bb[8] = {b0[0], b0[1], b0[2], b0[3], b1[0], b1[1], b1[2], b1[3]};
#pragma unroll
        for (int e = 0; e < 8; ++e) { const float x = v[e] + bb[e]; v[e] = x / (1.f + __expf(-x)); }
        store8(HC + (size_t)row * 256 + cc, v);
    }
};
struct EpiC2Impl {
    unsigned char* ws;
    DI void chunk(int row, int pn, int cc, float (&v)[8]) const {
        if (cc >= 64) return;
        bf16_t* const KCMP = WSP(bf16_t, WS_KCMP); bf16_t* const VCMPT = WSP(bf16_t, WS_VCMPT);
        const int bg = (row >> 8) & 15, n = row & 255;
        if (n == 255) {
#pragma unroll
            for (int e = 0; e < 8; ++e) v[e] = 0.f;
        }
        if (pn == 0) store8(KCMP + ((size_t)bg * 256 + n) * 64 + cc, v);
        else {
#pragma unroll
            for (int e = 0; e < 8; ++e) VCMPT[((size_t)bg * 64 + cc + e) * 256 + n] = f2bf(v[e]);
        }
    }
};
struct EpiUQImpl {
    unsigned char* ws;
    DI void chunk(int row, int pn, int cc, float (&v)[8]) const {
        bf16_t* const QM = WSP(bf16_t, WS_QM); const float* const PQ = WSP(const float, WS_PQ); const f32x2* const CS32 = WSP(const f32x2, WS_CS32);
        const int c = pn * 256 + cc, hh = c / 96, c96 = c - hh * 96, pos = row & (S - 1);
        const f32x4 p0 = *(const f32x4*)(PQ + (size_t)row * 8), p1 = *(const f32x4*)(PQ + (size_t)row * 8 + 4);
        const float rstd = rsqrtf((((p0[0] + p0[1]) + (p0[2] + p0[3])) + ((p1[0] + p1[1]) + (p1[2] + p1[3]))) * (1.f / 256.f) + EPS);
#pragma unroll
        for (int e = 0; e < 8; ++e) v[e] *= rstd;
        if (c96 >= 64) rope8(v, CS32 + pos * 16 + ((c96 - 64) >> 1));
        store8(QM + (size_t)row * 768 + c, v);
    }
};
struct EpiUKVImpl {
    unsigned char* ws;
    DI void chunk(int row, int pn, int cc, float (&v)[8]) const {
        bf16_t* const KM = WSP(bf16_t, WS_KM); bf16_t* const VMT = WSP(bf16_t, WS_VMT); const float* const PKV = WSP(const float, WS_PKV);
        const int c = pn * 256 + cc, hh = c >> 7, c128 = c & 127, pos = row & (S - 1), b = row >> 12;
        const f32x4 p0 = *(const f32x4*)(PKV + (size_t)row * 4);
        const float rstd = rsqrtf(((p0[0] + p0[1]) + (p0[2] + p0[3])) * (1.f / 128.f) + EPS);
#pragma unroll
        for (int e = 0; e < 8; ++e) v[e] *= rstd;
        if (c128 < 64) store8(KM + ((size_t)(b * 8 + hh) * S + pos) * 64 + c128, v);
        else {
#pragma unroll
            for (int e = 0; e < 8; ++e) VMT[((size_t)(b * 8 + hh) * 64 + (c128 - 64) + e) * S + pos] = f2bf(v[e]);
        }
    }
};
struct EpiD2Impl {
    const float* xin; float* X;
    DI void chunk(int row, int pn, int cc, float (&v)[8]) const {
        const size_t o = (size_t)row * 1024 + pn * 256 + cc;
        const f32x4 x0 = *(const f32x4*)(xin + o), x1 = *(const f32x4*)(xin + o + 4);
        *(f32x4*)(X + o) = (f32x4){x0[0] + v[0], x0[1] + v[1], x0[2] + v[2], x0[3] + v[3]};
        *(f32x4*)(X + o + 4) = (f32x4){x1[0] + v[4], x1[1] + v[5], x1[2] + v[6], x1[3] + v[7]};
    }
};
struct EpiUpImpl {
    unsigned char* ws;
    DI void chunk(int row, int pn, int cc, float (&v)[8]) const {
        bf16_t* const HF = WSP(bf16_t, WS_HF);
#pragma unroll
        for (int e = 0; e < 8; ++e) { const float r = fmaxf(v[e], 0.f); v[e] = r * r; }
        store8(HF + (size_t)row * FF + pn * 256 + cc, v);
    }
};
struct EpiD1aImpl {
    unsigned char* ws;
    DI void chunk(int row, int pn, int cc, float (&v)[8]) const {
        const size_t o = (size_t)row * 1024 + pn * 256 + cc;
        const u32x4 a = *(const u32x4*)(WSP(const bf16_t, WS_GA) + o);
        v[0] *= bflo(a[0]); v[1] *= bfhi(a[0]); v[2] *= bflo(a[1]); v[3] *= bfhi(a[1]); v[4] *= bflo(a[2]); v[5] *= bfhi(a[2]); v[6] *= bflo(a[3]); v[7] *= bfhi(a[3]);
        store8(WSP(bf16_t, WS_MG) + o, v);
    }
};
struct EpiD1bImpl {
    unsigned char* ws;
    DI void chunk(int row, int pn, int cc, float (&v)[8]) const {
        const size_t o = (size_t)row * 1024 + pn * 256 + cc;
        const u32x4 b = *(const u32x4*)(WSP(const bf16_t, WS_GB) + o), g = *(const u32x4*)(WSP(const bf16_t, WS_MG) + o);
        v[0] = bflo(g[0]) + v[0] * bflo(b[0]); v[1] = bfhi(g[0]) + v[1] * bfhi(b[0]); v[2] = bflo(g[1]) + v[2] * bflo(b[1]); v[3] = bfhi(g[1]) + v[3] * bfhi(b[1]);
        v[4] = bflo(g[2]) + v[4] * bflo(b[2]); v[5] = bfhi(g[2]) + v[5] * bfhi(b[2]); v[6] = bflo(g[3]) + v[6] * bflo(b[3]); v[7] = bfhi(g[3]) + v[7] * bfhi(b[3]);
        store8(WSP(bf16_t, WS_MG) + o, v);
    }
};

#define MFMA32(a, b, c) __builtin_amdgcn_mfma_f32_32x32x16_bf16((a), (b), (c), 0, 0, 0)

template <int DQK> DI void qk_tile(const LAS unsigned char* sK, const bf16x8 (&qf)[DQK / 16], f32x16 (&s)[2], int lane) {
    constexpr int KSTR = DQK * 2 + 16;
    const int r = lane & 31, h = lane >> 5;
    const int rp = (r & 0x13) | ((r & 4) << 1) | ((r & 8) >> 1);
    bf16x8 kf[2][DQK / 16];
#pragma unroll
    for (int kt = 0; kt < 2; ++kt)
#pragma unroll
        for (int ks = 0; ks < DQK / 16; ++ks) kf[kt][ks] = *(const LAS bf16x8*)(sK + (32 * kt + rp) * KSTR + ks * 32 + h * 16);
    __builtin_amdgcn_sched_barrier(0);
#pragma unroll
    for (int kt = 0; kt < 2; ++kt) {
        f32x16 a;
#pragma unroll
        for (int i = 0; i < 16; ++i) a[i] = 0.f;
#pragma unroll
        for (int ks = 0; ks < DQK / 16; ++ks) a = MFMA32(kf[kt][ks], qf[ks], a);
        s[kt] = a;
    }
}
DI void v_load(bf16x8 (&vf)[2][2][2], const LAS unsigned char* sV, int lane) {
    const int h = lane >> 5, r = lane & 31;
#pragma unroll
    for (int kt = 0; kt < 2; ++kt)
#pragma unroll
        for (int s2 = 0; s2 < 2; ++s2)
#pragma unroll
            for (int dt = 0; dt < 2; ++dt) vf[kt][s2][dt] = *(const LAS bf16x8*)(sV + (32 * dt + r) * 144 + (32 * kt + 16 * s2 + 8 * h) * 2);
}

template <bool LANEOFF> DI void pack_p(const f32x16 (&s)[2], unsigned keep, u32x4 (&pp)[4]) {
#pragma unroll
    for (int kt = 0; kt < 2; ++kt)
#pragma unroll
        for (int s2 = 0; s2 < 2; ++s2) {
            u32x4 pw = {pk2(s[kt][8 * s2 + 0], s[kt][8 * s2 + 1]), pk2(s[kt][8 * s2 + 2], s[kt][8 * s2 + 3]),
                        pk2(s[kt][8 * s2 + 4], s[kt][8 * s2 + 5]), pk2(s[kt][8 * s2 + 6], s[kt][8 * s2 + 7])};
            if constexpr (LANEOFF) { pw[0] &= keep; pw[1] &= keep; pw[2] &= keep; pw[3] &= keep; }
            pp[kt * 2 + s2] = pw;
        }
}
DI void pv_packed(const u32x4 (&pp)[4], const bf16x8 (&vf)[2][2][2], f32x16 (&o)[2]) {
#pragma unroll
    for (int kt = 0; kt < 2; ++kt)
#pragma unroll
        for (int s2 = 0; s2 < 2; ++s2) {
            const bf16x8 pb = __builtin_bit_cast(bf16x8, pp[kt * 2 + s2]);
#pragma unroll
            for (int dt = 0; dt < 2; ++dt) o[dt] = MFMA32(vf[kt][s2][dt], pb, o[dt]);
        }
}
template <class Mask> DI void softmax_masked(f32x16 (&s)[2], int tile, const Mask& mask, float c, float& m, float& l, f32x16 (&o)[2], int lane) {
    const int h = lane >> 5;
    float mx = -1e30f;
#pragma unroll
    for (int kt = 0; kt < 2; ++kt)
#pragma unroll
        for (int reg = 0; reg < 16; ++reg) {
            const int key = 32 * kt + (reg & 7) + 8 * h + 16 * (reg >> 3);
            const float x = mask(tile, key) ? s[kt][reg] : -1e30f;
            s[kt][reg] = x; mx = fmaxf(mx, x);
        }
    mx = fmaxf(mx, __shfl_xor(mx, 32));
    const float mn = fmaxf(m, mx), alpha = ex2((m - mn) * c), nmc = -mn * c;
    m = mn;
    float sum = 0.f;
#pragma unroll
    for (int kt = 0; kt < 2; ++kt)
#pragma unroll
        for (int reg = 0; reg < 16; ++reg) {
            const float x = s[kt][reg];
            const float p = (x > -5e29f) ? ex2(__builtin_fmaf(x, c, nmc)) : 0.f;
            s[kt][reg] = p; sum += p;
        }
    l = l * alpha + sum;
    o[0] *= alpha; o[1] *= alpha;
}
template <bool LANEOFF> DI void softmax_full(f32x16 (&s)[2], bool lane_on, float c, float& m, float& l, f32x16 (&o)[2]) {
    float mx0 = fmaxf(s[0][0], s[1][0]), mx1 = fmaxf(s[0][1], s[1][1]);
#pragma unroll
    for (int reg = 2; reg < 16; reg += 2) { mx0 = fmaxf(mx0, fmaxf(s[0][reg], s[1][reg])); mx1 = fmaxf(mx1, fmaxf(s[0][reg + 1], s[1][reg + 1])); }
    float mx = fmaxf(mx0, mx1);
    mx = fmaxf(mx, __shfl_xor(mx, 32));
    if constexpr (LANEOFF) mx = lane_on ? mx : -1e30f;
    const float mn = fmaxf(m, mx);
    if (__any(mn > m)) { const float alpha = ex2((m - mn) * c); l *= alpha; o[0] *= alpha; o[1] *= alpha; }
    m = mn;
    const float nmc = -mn * c;
    float sum0 = 0.f, sum1 = 0.f;
#pragma unroll
    for (int kt = 0; kt < 2; ++kt)
#pragma unroll
        for (int reg = 0; reg < 16; reg += 2) {
            const float p0 = ex2(__builtin_fmaf(s[kt][reg], c, nmc)), p1 = ex2(__builtin_fmaf(s[kt][reg + 1], c, nmc));
            s[kt][reg] = p0; s[kt][reg + 1] = p1; sum0 += p0; sum1 += p1;
        }
    float sum = sum0 + sum1;
    if constexpr (LANEOFF) sum = lane_on ? sum : 0.f;
    l += sum;
}

struct TileRegs { u32x4 k, v, p; };
template <int DQK, bool LANEOFF, bool STAG, class TileOf, class Mask, class Skip>
DI void attn_run(LAS unsigned char* lds, const bf16_t* Kg, const bf16_t* Kpe, const bf16_t* Vg, int ldv, int ntiles,
                 const TileOf& tile_of, const Mask& mask, const Skip& skip, float c, const bf16x8 (&qf)[DQK / 16], float& m, float& l, f32x16 (&o)[2]) {
    constexpr int KSTR = DQK * 2 + 16;
    const int tid = my_tid(), lane = tid & 63;
    const int krow = tid >> 3, kch = tid & 7, prow = (tid >> 2) & 63, pch = tid & 3;
    TileRegs RA, RB;
    asm volatile("" : "=v"(RA.k), "=v"(RA.v), "=v"(RA.p), "=v"(RB.k), "=v"(RB.v), "=v"(RB.p));
#define ATT_LOAD(R, tt) do { const int t_ = (tt); (R).k = *(const u32x4*)(Kg + ((size_t)(t_ * 64 + krow)) * 64 + kch * 8); (R).v = *(const u32x4*)(Vg + (size_t)krow * ldv + t_ * 64 + kch * 8); \
        if constexpr (DQK == 96) { if (tid < 256) (R).p = *(const u32x4*)(Kpe + ((size_t)(t_ * 64 + prow)) * 32 + pch * 8); } } while (0)
#define ATT_WRITE(R, kb_, vb_) do { *(LAS u32x4*)(lds + AT_K + (kb_) + krow * KSTR + kch * 16) = (R).k; *(LAS u32x4*)(lds + AT_V + (vb_) + krow * 144 + kch * 16) = (R).v; \
        if constexpr (DQK == 96) { if (tid < 256) *(LAS u32x4*)(lds + AT_K + (kb_) + prow * KSTR + 128 + pch * 16) = (R).p; } } while (0)
#define ATT_ITER(i_, RL, RW) do { const int t = tile_of(i_); const int kb = ((i_) & 1) * AT_KB, vb = ((i_) & 1) * AT_VB; \
        if ((i_) + 2 < ntiles) ATT_LOAD(RL, tile_of((i_) + 2)); \
        if (!skip(t)) { \
            f32x16 s[2]; \
            qk_tile<DQK>(lds + AT_K + kb, qf, s, lane); \
            bf16x8 vf[2][2][2]; v_load(vf, lds + AT_V + vb, lane); \
            unsigned keep = 0xffffffffu; \
            if (mask.full(t)) { const bool on = mask.lane_on(t); softmax_full<LANEOFF>(s, on, c, m, l, o); if constexpr (LANEOFF) keep = on ? 0xffffffffu : 0u; } \
            else softmax_masked(s, t, mask, c, m, l, o, lane); \
            u32x4 pp[4]; pack_p<LANEOFF>(s, keep, pp); pv_packed(pp, vf, o); \
        } \
        if ((i_) + 1 < ntiles) ATT_WRITE(RW, AT_KB - kb, AT_VB - vb); \
        __syncthreads(); } while (0)
    __syncthreads();
    if (ntiles > 0) { ATT_LOAD(RA, tile_of(0)); ATT_WRITE(RA, 0, 0); }
    if (ntiles > 1) ATT_LOAD(RB, tile_of(1));
    __syncthreads();
    for (int i = 0; i < ntiles; i += 2) {
        ATT_ITER(i, RA, RB);
        if (i + 1 < ntiles) ATT_ITER(i + 1, RB, RA);
    }
#undef ATT_LOAD
#undef ATT_WRITE
#undef ATT_ITER
}

struct TileId { DI int operator()(int i) const { return i; } };
struct TileOff { int off; DI int operator()(int i) const { return off + i; } };
struct TileList { const LAS int* lst; DI int operator()(int i) const { return lst[i]; } };
struct NoSkip { DI bool operator()(int) const { return false; } };
struct SkipAbove { int tmax; DI bool operator()(int t) const { return t * 64 > tmax; } };
struct MaskCmp { int tq;
    DI bool operator()(int t, int key) const { return 16 * (64 * t + key) + 31 <= tq; }
    DI bool full(int) const { return false; } DI bool lane_on(int) const { return true; } };
struct MaskSlc { int tq; unsigned lo, hi; int qt;
    DI bool bit(int t) const { return ((t < 32 ? (lo >> t) : (hi >> (t - 32))) & 1u) != 0u; }
    DI bool operator()(int t, int key) const { return bit(t) && (64 * t + key <= tq); }
    DI bool full(int t) const { return t < qt; } DI bool lane_on(int t) const { return bit(t); } };
struct MaskWin { int tq, tq0w;
    DI bool operator()(int t, int key) const { const int d = tq - (64 * t + key); return d >= 0 && d < 512; }
    DI bool full(int t) const { return (64 * t + 63 <= tq0w) && (tq0w + 31 - 64 * t <= 511); } DI bool lane_on(int) const { return true; } };
struct MaskCausal { int tq, tq0w;
    DI bool operator()(int t, int key) const { return 64 * t + key <= tq; }
    DI bool full(int t) const { return 64 * t + 63 <= tq0w; } DI bool lane_on(int) const { return true; } };

struct Bufs {
    const bf16_t *QN, *KS, *KW, *VST, *VWT, *KCMP, *VCMPT, *QM, *KM, *KPE, *VMT; const float* GN; bf16_t* OAB;
};

DI void zero16(f32x16& v) {
#pragma unroll
    for (int i = 0; i < 16; ++i) v[i] = 0.f;
}

DI void nsa_unit(const Bufs& B, LAS unsigned char* lds, int b, int g, int qt) {
    const int tid = my_tid(), lane = tid & 63, w = __builtin_amdgcn_readfirstlane(tid >> 6), r = w >> 1, hh = lane >> 5;
    const int qs = (w & 1) * 32 + (lane & 31), bg = b * 2 + g, tq = qt * 64 + qs, head = g * 4 + r;
    const size_t row = (size_t)b * S + tq;
    LAS unsigned* sImp = (LAS unsigned*)(lds + AT_IMP);
    LAS unsigned* sSel = (LAS unsigned*)(lds + AT_SEL);
    LAS int* sList = (LAS int*)(lds + AT_LIST);
    LAS int* sCnt = (LAS int*)(lds + AT_CNT);
    bf16x8 qf[4];
#pragma unroll
    for (int ks = 0; ks < 4; ++ks) qf[ks] = *(const bf16x8*)(B.QN + row * 512 + head * 64 + ks * 16 + hh * 8);
    for (int i = tid; i < 4096; i += 512) sImp[i] = 0u;
    const float c = 0.125f * LOG2E;
    LAS float* stash = (LAS float*)(lds + AT_ACC + w * 8192) + lane;
    float m, l; f32x16 o[2];
    const int nct = (4 * qt + 2) / 64 + 1;
    m = -1e30f; l = 0.f; zero16(o[0]); zero16(o[1]);
    attn_run<64, false, STAG_CMP>(lds, B.KCMP + (size_t)bg * 256 * 64, nullptr, B.VCMPT + (size_t)bg * 64 * 256, 256, nct, TileId{}, MaskCmp{tq}, NoSkip{}, c, qf, m, l, o);
    const float nmc = -m * c;
    float inv;
    { const float lt = l + __shfl_xor(l, 32); inv = lt > 0.f ? 1.f / lt : 0.f; }
    { const float ig0 = inv * B.GN[row * 24 + head];
#pragma unroll
    for (int dt = 0; dt < 2; ++dt)
#pragma unroll
        for (int e = 0; e < 16; ++e) stash[(dt * 16 + e) * 64] = o[dt][e] * ig0; }
    for (int ct = 0; ct < nct; ++ct) {
        __syncthreads();
        { const int krow = tid >> 3, kch = tid & 7;
          *(LAS u32x4*)(lds + AT_K + krow * 144 + kch * 16) = *(const u32x4*)(B.KCMP + ((size_t)bg * 256 + ct * 64 + krow) * 64 + kch * 8); }
        __syncthreads();
        f32x16 s[2];
        qk_tile<64>(lds + AT_K, qf, s, lane);
#pragma unroll
        for (int kt = 0; kt < 2; ++kt)
#pragma unroll
            for (int a = 0; a < 4; ++a) {
                float pv[4];
#pragma unroll
                for (int bb = 0; bb < 4; ++bb) {
                    const int reg = 4 * a + bb;
                    const int n = 64 * ct + 32 * kt + (reg & 7) + 8 * hh + 16 * (reg >> 3);
                    pv[bb] = (16 * n + 31 <= tq) ? ex2(__builtin_fmaf(s[kt][reg], c, nmc)) * inv : 0.f;
                }
                const int j = 16 * ct + 8 * kt + (a & 1) + 2 * hh + 4 * (a >> 1);
                const float carry = 0.5f * pv[3], direct = (pv[0] + pv[1]) + (pv[2] + carry);
                if (direct > 0.f) __hip_atomic_fetch_add(sImp + qs * 64 + j, (unsigned)(direct * 268435456.f + 0.5f), __ATOMIC_RELAXED, __HIP_MEMORY_SCOPE_WORKGROUP);
                if (carry > 0.f && j < 63) __hip_atomic_fetch_add(sImp + qs * 64 + j + 1, (unsigned)(carry * 268435456.f + 0.5f), __ATOMIC_RELAXED, __HIP_MEMORY_SCOPE_WORKGROUP);
            }
    }
    __syncthreads();
    {
        const int q = tid >> 3, sub = tid & 7;
        unsigned bits = 0;
        if (qt < 16) {
#pragma unroll
            for (int k = 0; k < 8; ++k) if (sub * 8 + k <= qt) bits |= 1u << k;
        } else {
            unsigned v[8]; int cnt[8];
#pragma unroll
            for (int k = 0; k < 8; ++k) { v[k] = sImp[q * 64 + sub * 8 + k]; cnt[k] = 0; }
            for (int jp = 1; jp <= qt - 2; ++jp) {
                const unsigned vp = sImp[q * 64 + jp];
#pragma unroll
                for (int k = 0; k < 8; ++k) cnt[k] += (vp > v[k] || (vp == v[k] && jp < sub * 8 + k)) ? 1 : 0;
            }
#pragma unroll
            for (int k = 0; k < 8; ++k) {
                const int j = sub * 8 + k;
                const bool forced = (j == 0) || (j == qt) || (j == qt - 1), cand = (j >= 1) && (j <= qt - 2);
                if (forced || (cand && cnt[k] < 13)) bits |= 1u << k;
            }
        }
        unsigned lo = sub < 4 ? bits << (sub * 8) : 0u, hi = sub >= 4 ? bits << ((sub - 4) * 8) : 0u;
        lo |= __shfl_xor(lo, 1); hi |= __shfl_xor(hi, 1); lo |= __shfl_xor(lo, 2); hi |= __shfl_xor(hi, 2); lo |= __shfl_xor(lo, 4); hi |= __shfl_xor(hi, 4);
        if (sub == 0) { sSel[q * 2] = lo; sSel[q * 2 + 1] = hi; }
    }
    __syncthreads();
    if (w == 0) {
        unsigned lo = sSel[lane * 2], hi = sSel[lane * 2 + 1];
#pragma unroll
        for (int x = 1; x < 64; x <<= 1) { lo |= __shfl_xor(lo, x); hi |= __shfl_xor(hi, x); }
        if (lane == 0) {
            int n = 0;
            for (int j = 0; j <= qt; ++j) { const unsigned bit = j < 32 ? (lo >> j) : (hi >> (j - 32)); if (bit & 1u) sList[n++] = j; }
            *sCnt = n;
        }
    }
    __syncthreads();
    {
        const int nsel = *sCnt;
        const unsigned lo = sSel[qs * 2], hi = sSel[qs * 2 + 1];
        m = -1e30f; l = 0.f; zero16(o[0]); zero16(o[1]);
        attn_run<64, true, STAG_SLC>(lds, B.KS + (size_t)bg * S * 64, nullptr, B.VST + (size_t)bg * 64 * S, S, nsel, TileList{sList}, MaskSlc{tq, lo, hi, qt}, NoSkip{}, c, qf, m, l, o);
        const float lt = l + __shfl_xor(l, 32); const float iv = (lt > 0.f ? 1.f / lt : 0.f) * B.GN[row * 24 + 8 + head];
#pragma unroll
        for (int dt = 0; dt < 2; ++dt)
#pragma unroll
            for (int e = 0; e < 16; ++e) stash[(dt * 16 + e) * 64] += o[dt][e] * iv;
    }
    {
        const int t0 = qt >= 8 ? qt - 8 : 0;
        m = -1e30f; l = 0.f; zero16(o[0]); zero16(o[1]);
        attn_run<64, false, STAG_WIN>(lds, B.KW + (size_t)bg * S * 64, nullptr, B.VWT + (size_t)bg * 64 * S, S, qt - t0 + 1, TileOff{t0}, MaskWin{tq, qt * 64 + (w & 1) * 32}, NoSkip{}, c, qf, m, l, o);
        const float lt = l + __shfl_xor(l, 32); const float iv = (lt > 0.f ? 1.f / lt : 0.f) * B.GN[row * 24 + 16 + head];
#pragma unroll
        for (int dt = 0; dt < 2; ++dt)
#pragma unroll
            for (int e = 0; e < 16; ++e) o[dt][e] = stash[(dt * 16 + e) * 64] + o[dt][e] * iv;
    }
    bf16_t* orow = B.OAB + row * 1024 + head * 64;
#pragma unroll
    for (int dt = 0; dt < 2; ++dt)
#pragma unroll
        for (int a = 0; a < 4; ++a) {
            u32x2 w2 = {pk2(o[dt][4 * a], o[dt][4 * a + 1]), pk2(o[dt][4 * a + 2], o[dt][4 * a + 3])};
            *(u32x2*)(orow + 32 * dt + 8 * a + 4 * hh) = w2;
        }
}

DI void mla_unit(const Bufs& B, LAS unsigned char* lds, int b, int h, int qb) {
    const int tid = my_tid(), lane = tid & 63, w = __builtin_amdgcn_readfirstlane(tid >> 6), hh = lane >> 5;
    const int tq = qb * 256 + w * 32 + (lane & 31);
    const size_t row = (size_t)b * S + tq;
    bf16x8 qf[6];
#pragma unroll
    for (int ks = 0; ks < 6; ++ks) qf[ks] = *(const bf16x8*)(B.QM + row * 768 + h * 96 + ks * 16 + hh * 8);
    const float c = 0.10206207261596575f * LOG2E;
    float m = -1e30f, l = 0.f; f32x16 o[2]; zero16(o[0]); zero16(o[1]);
    attn_run<96, false, STAG_MLA>(lds, B.KM + (size_t)(b * 8 + h) * S * 64, B.KPE + (size_t)b * S * 32, B.VMT + (size_t)(b * 8 + h) * 64 * S, S, 4 * (qb + 1),
                 TileId{}, MaskCausal{tq, qb * 256 + w * 32}, SkipAbove{qb * 256 + w * 32 + 31}, c, qf, m, l, o);
    const float lt = l + __shfl_xor(l, 32); const float iv = lt > 0.f ? 1.f / lt : 0.f;
    bf16_t* orow = B.OAB + row * 1024 + 512 + h * 64;
#pragma unroll
    for (int dt = 0; dt < 2; ++dt)
#pragma unroll
        for (int a = 0; a < 4; ++a) {
            u32x2 w2 = {pk2(o[dt][4 * a] * iv, o[dt][4 * a + 1] * iv), pk2(o[dt][4 * a + 2] * iv, o[dt][4 * a + 3] * iv)};
            *(u32x2*)(orow + 32 * dt + 8 * a + 4 * hh) = w2;
        }
}

DI void attn_phase(const Bufs& B, LAS unsigned char* lds, unsigned* counter) {
    LAS int* sUnit = (LAS int*)(lds + MISC_OFF); int it_ = 0; (void)sUnit; (void)it_; (void)counter;
    for (;;) {
#if ATT_STATIC
        __syncthreads();
        const int u = (int)blockIdx.x + 256 * it_; ++it_;
        if (u >= 2048) break;
#else
        __syncthreads();
        if (threadIdx.x == 0) *sUnit = (int)atomicAdd(counter, 1u);
        __syncthreads();
        const int u = *sUnit;
        if (u >= 2048) break;
#endif
        const int i = u >> 1;
        if ((u & 1) == 0) {
#if EXP_ATT == 2
            { const int b = (i & 63) >> 3, h = i & 7, qb = 15 - (i >> 6);
              for (int e = threadIdx.x; e < 2048; e += 512) *(u32x4*)(B.OAB + ((size_t)b * S + qb * 256 + (e >> 3)) * 1024 + 512 + h * 64 + (e & 7) * 8) = (u32x4){0x3c003c00u, 0x3c003c00u, 0x3c003c00u, 0x3c003c00u}; }
#else
            mla_unit(B, lds, (i & 63) >> 3, i & 7, 15 - (i >> 6));
#if ATT_DUP == 1
            __syncthreads(); mla_unit(B, lds, (i & 63) >> 3, i & 7, 15 - (i >> 6));
#endif
#endif
        } else {
#if EXP_ATT == 1
            { const int b = (i & 15) >> 1, g = i & 1, qt = 63 - (i >> 4);
              for (int e = threadIdx.x; e < 2048; e += 512) *(u32x4*)(B.OAB + ((size_t)b * S + qt * 64 + (e >> 5)) * 1024 + g * 256 + (e & 31) * 8) = (u32x4){0x3c003c00u, 0x3c003c00u, 0x3c003c00u, 0x3c003c00u}; }
#else
            nsa_unit(B, lds, (i & 15) >> 1, i & 1, 63 - (i >> 4));
#if ATT_DUP == 2
            __syncthreads(); nsa_unit(B, lds, (i & 15) >> 1, i & 1, 63 - (i >> 4));
#endif
#endif
        }
    }
}

DI float wave_sum(float v) {
#pragma unroll
    for (int o = 1; o < 64; o <<= 1) v += __shfl_xor(v, o);
    return v;
}
DI void norm_rows_bf16(const float* x, const float* g, bf16_t* xn) {
    const int tid_ = my_tid(), lane = tid_ & 63, gw = blockIdx.x * 8 + (tid_ >> 6), ngw = gridDim.x * 8;
    f32x4 gv[4];
#pragma unroll
    for (int j = 0; j < 4; ++j) gv[j] = ((const f32x4*)g)[lane + 64 * j];
    for (int r = gw; r < M; r += ngw) {
        const f32x4* xr = (const f32x4*)(x + (size_t)r * D) + lane;
        f32x4 v[4]; float s = 0.f;
#pragma unroll
        for (int j = 0; j < 4; ++j) { v[j] = xr[64 * j]; s += (v[j][0] * v[j][0] + v[j][1] * v[j][1]) + (v[j][2] * v[j][2] + v[j][3] * v[j][3]); }
        const float rstd = rsqrtf(wave_sum(s) * (1.f / D) + EPS);
        u32x2* o8 = (u32x2*)(xn + (size_t)r * D) + lane;
#pragma unroll
        for (int j = 0; j < 4; ++j) o8[64 * j] = (u32x2){pk2(v[j][0] * rstd * gv[j][0], v[j][1] * rstd * gv[j][1]), pk2(v[j][2] * rstd * gv[j][2], v[j][3] * rstd * gv[j][3])};
    }
}
DI void norm_rows_f32_inplace(float* x, const float* g) {
    const int tid_ = my_tid(), lane = tid_ & 63, gw = blockIdx.x * 8 + (tid_ >> 6), ngw = gridDim.x * 8;
    f32x4 gv[4];
#pragma unroll
    for (int j = 0; j < 4; ++j) gv[j] = ((const f32x4*)g)[lane + 64 * j];
    for (int r = gw; r < M; r += ngw) {
        f32x4* xr = (f32x4*)(x + (size_t)r * D) + lane;
        f32x4 v[4]; float s = 0.f;
#pragma unroll
        for (int j = 0; j < 4; ++j) { v[j] = xr[64 * j]; s += (v[j][0] * v[j][0] + v[j][1] * v[j][1]) + (v[j][2] * v[j][2] + v[j][3] * v[j][3]); }
        const float rstd = rsqrtf(wave_sum(s) * (1.f / D) + EPS);
#pragma unroll
        for (int j = 0; j < 4; ++j) xr[64 * j] = (f32x4){v[j][0] * rstd * gv[j][0], v[j][1] * rstd * gv[j][1], v[j][2] * rstd * gv[j][2], v[j][3] * rstd * gv[j][3]};
    }
}

DI int perm64(int p) { return (p >> 1) + 32 * (p & 1); }
DI int perm32r(int p) { return (p >> 1) + 16 * (p & 1); }
DI int map_in(int c) {
    if (c < 512) return (c & ~63) + perm64(c & 63);
    if (c < 1280) { const int t = (c - 512) >> 8, cc = (c - 512) & 255, kv = cc >> 7, g = (cc >> 6) & 1, p = cc & 63; return 512 + t * 256 + kv * 128 + g * 64 + (kv == 0 ? perm64(p) : p); }
    if (c < 1536) return 1304 + (c - 1280);
    if (c < 1792) { const int cc = c - 1536; if (cc < 128) return 1560 + cc; if (cc < 160) return 1688 + perm32r(cc - 128); if (cc < 184) return 1280 + (cc - 160); return -1; }
    if (c < 2816) return 1720 + (c - 1792);
    return 2744 + (c - 2816);
}
struct Wts {
    const float *w_in, *cmp_pe, *cmp_w1, *cmp_w2, *nsa_w_o, *q_norm, *kv_norm, *w_uq, *w_ukv, *mla_w_o, *w_out, *w_up, *w_down;
};
template <int JOB> DI float prep_get(const Wts& W, int n, int k) {
    if constexpr (JOB == 0) { const int c = map_in(n); return c >= 0 ? W.w_in[(size_t)k * IN_COLS + c] : 0.f; }
    if constexpr (JOB == 1) { const int j = n >> 8, h = n & 255, lp = k >> 6, p = k & 63, d = j == 0 ? perm64(p) : p; return W.cmp_w1[((size_t)j * 2048 + lp * 64 + d) * 256 + h]; }
    if constexpr (JOB == 2) { const int j = n >> 8, np = n & 255; return np < 64 ? W.cmp_w2[((size_t)j * 256 + k) * 64 + (j == 0 ? perm64(np) : np)] : 0.f; }
    if constexpr (JOB == 3) { return n < 1024 ? W.nsa_w_o[(size_t)k * 1024 + n] : W.mla_w_o[(size_t)k * 1024 + (n - 1024)]; }
    if constexpr (JOB == 4) { const int hh = n / 96, c = n - hh * 96; const int sc = c < 64 ? n : hh * 96 + 64 + perm32r(c - 64); return W.q_norm[k] * W.w_uq[(size_t)k * 768 + sc]; }
    if constexpr (JOB == 5) { return k < 128 ? W.kv_norm[k] * W.w_ukv[(size_t)k * 1024 + n] : 0.f; }
    if constexpr (JOB == 6) { return W.w_out[(size_t)k * 1024 + n]; }
    if constexpr (JOB == 7) { return W.w_up[(size_t)k * 4096 + n]; }
    if constexpr (JOB == 8) { return W.w_down[(size_t)k * 1024 + n]; }
    return 0.f;
}
template <int JOB> DI void prep_tile(const Wts& W, LAS float* scr, bf16_t* dst, int ldd, int n0, int k0) {
    const int tid = my_tid();
#pragma unroll
    for (int it = 0; it < 8; ++it) { const int kk = it * 8 + (tid >> 6), nn = tid & 63; scr[kk * 65 + nn] = prep_get<JOB>(W, n0 + nn, k0 + kk); }
    __syncthreads();
    { const int n = tid >> 3, kc = tid & 7; const LAS float* s = scr + (kc * 8) * 65 + n;
      u32x4 o = {pk2(s[0], s[65]), pk2(s[130], s[195]), pk2(s[260], s[325]), pk2(s[390], s[455])};
      *(u32x4*)(dst + (size_t)(n0 + n) * ldd + k0 + kc * 8) = o; }
    __syncthreads();
}
DI void prep_tile_vec(const float* src, int ldsrc, LAS float* scr, bf16_t* dst, int ldd, int n0, int k0) {
    const int tid = my_tid();
    f32x4 v[4];
#pragma unroll
    for (int it = 0; it < 4; ++it) v[it] = *(const f32x4*)(src + (size_t)(k0 + it * 32 + (tid >> 4)) * ldsrc + (tid & 15) * 4);
#pragma unroll
    for (int it = 0; it < 4; ++it) { LAS float* d = scr + (it * 32 + (tid >> 4)) * 65 + (tid & 15) * 4; d[0] = v[it][0]; d[1] = v[it][1]; d[2] = v[it][2]; d[3] = v[it][3]; }
    __syncthreads();
    { const int n = tid >> 3, kc = tid & 7;
#pragma unroll
      for (int hh = 0; hh < 2; ++hh) { const LAS float* s = scr + (hh * 64 + kc * 8) * 65 + n;
        u32x4 o = {pk2(s[0], s[65]), pk2(s[130], s[195]), pk2(s[260], s[325]), pk2(s[390], s[455])};
        *(u32x4*)(dst + (size_t)(n0 + n) * ldd + k0 + hh * 64 + kc * 8) = o; } }
    __syncthreads();
}
DI void prep_phase(const Wts& W, unsigned char* ws, LAS unsigned char* lds, int layer) {
    LAS float* scr = (LAS float*)lds;
    const int tid = my_tid();
    constexpr int T0a = 384, T0 = T0a + 288, T1 = T0 + 256, T2 = T1 + 32, T3 = T2 + 128, T4 = T3 + 48, T5 = T4 + 64, T6_ = T5 + 128, T7 = T6_ + 512, T8 = T7 + 512, TB = T8 + 8;
    for (int job = blockIdx.x; job < TB; job += gridDim.x) {
        int r = job;
        if (r < T0a) { const int ix = r >> 4, n0 = (ix < 20 ? ix : ix + 4) * 64;
            prep_tile<0>(W, scr, (bf16_t*)(ws + WS_WIN), 1024, n0, (r & 15) * 64); continue; }
        if (r < T0) { r -= T0a; const int ix = r >> 3, n0 = (ix < 4 ? 20 + ix : 24 + ix) * 64;
            prep_tile_vec(W.w_in + map_in(n0), IN_COLS, scr, (bf16_t*)(ws + WS_WIN), 1024, n0, (r & 7) * 128); continue; }
        if (r < T1) { r -= T0; prep_tile<1>(W, scr, (bf16_t*)(ws + WS_W1T), 2048, (r >> 5) * 64, (r & 31) * 64); continue; }
        if (r < T2) { r -= T1; prep_tile<2>(W, scr, (bf16_t*)(ws + WS_W2T), 256, (r >> 2) * 64, (r & 3) * 64); continue; }
        if (r < T3) { r -= T2; const int n0 = (r >> 2) * 64, k0 = (r & 3) * 128;
            prep_tile_vec(n0 < 1024 ? W.nsa_w_o + n0 : W.mla_w_o + (n0 - 1024), 1024, scr, (bf16_t*)(ws + WS_WOAB), 512, n0, k0); continue; }
        if (r < T4) { r -= T3; prep_tile<4>(W, scr, (bf16_t*)(ws + WS_WUQ), 256, (r >> 2) * 64, (r & 3) * 64); continue; }
        if (r < T5) { r -= T4; prep_tile<5>(W, scr, (bf16_t*)(ws + WS_WUKV), 256, (r >> 2) * 64, (r & 3) * 64); continue; }
        if (r < T6_) { r -= T5; const int n0 = (r >> 3) * 64; prep_tile_vec(W.w_out + n0, 1024, scr, (bf16_t*)(ws + WS_WOUT), 1024, n0, (r & 7) * 128); continue; }
        if (r < T7) { r -= T6_; const int n0 = (r >> 3) * 64; prep_tile_vec(W.w_up + n0, 4096, scr, (bf16_t*)(ws + WS_WUP), 1024, n0, (r & 7) * 128); continue; }
        if (r < T8) { r -= T7; const int n0 = (r >> 5) * 64; prep_tile_vec(W.w_down + n0, 1024, scr, (bf16_t*)(ws + WS_WDN), 4096, n0, (r & 31) * 128); continue; }
        {
            r -= T8; const int j = r >> 2, hc = r & 3, kk = tid >> 6, hx = tid & 63, h = hc * 64 + hx;
            float a = 0.f;
            for (int i = 0; i < 256; ++i) { const int k = kk + 8 * i; a += W.cmp_pe[j * 2048 + k] * W.cmp_w1[((size_t)j * 2048 + k) * 256 + h]; }
            scr[kk * 64 + hx] = a;
            __syncthreads();
            if (tid < 64) { float s = 0.f; for (int q = 0; q < 8; ++q) s += scr[q * 64 + tid]; ((float*)(ws + WS_CB1))[j * 256 + hc * 64 + tid] = s; }
            __syncthreads();
        }
    }
    if (layer == 0) {
        f32x2* cs64 = (f32x2*)(ws + WS_CS64); f32x2* cs32 = (f32x2*)(ws + WS_CS32);
        for (int idx = blockIdx.x * 512 + tid; idx < S * 48; idx += gridDim.x * 512) {
            int pos, i; float inv;
            if (idx < S * 32) { pos = idx >> 5; i = idx & 31; inv = (float)exp2(-(double)i * (13.287712379549449 / 32.0)); }
            else { const int e = idx - S * 32; pos = e >> 4; i = e & 15; inv = (float)exp2(-(double)i * (13.287712379549449 / 16.0)); }
            const float ang = (float)pos * inv;
            const double rev = (double)ang * 0.15915494309189535; const float fr = (float)(rev - floor(rev));
            const f32x2 v = {__builtin_amdgcn_cosf(fr), __builtin_amdgcn_sinf(fr)};
            if (idx < S * 32) cs64[idx] = v; else cs32[idx - S * 32] = v;
        }
    }
}

struct Params { const float* in[17]; float* out; unsigned char* ws; int ph_lo, ph_hi; };
typedef const __attribute__((address_space(4))) unsigned char* kaptr_t;
DI const float* karg_ptr(int byte_off) { kaptr_t ka = (kaptr_t)__builtin_amdgcn_kernarg_segment_ptr(); asm volatile("" : "+s"(ka)); return *(const float* const __attribute__((address_space(4)))*)(ka + byte_off); }
#define KIN(i) karg_ptr(8 * (i))

DI void grid_barrier_cg(cg::grid_group& grid) {
    asm volatile("s_waitcnt vmcnt(0) lgkmcnt(0)" ::: "memory");
    __syncthreads();
    if (threadIdx.x < 64) asm volatile("buffer_wbl2 sc1\n\ts_waitcnt vmcnt(0)" ::: "memory");
    __syncthreads();
    grid.sync();
    asm volatile("buffer_inv sc1\n\ts_waitcnt vmcnt(0)" ::: "memory");
}

#define XB_TMO      128
#define XB_XCNT(j)  (256  + 64 * (j))
#define XB_XSUB(j)  (1280 + 64 * (j))
#define XB_XGEN(j)  (2304 + 64 * (j))
#define XB_TOP      3328
#define XB_TOPGEN   3392
#define XCD_BAR_WORDS 3456
#define XB_SPIN_CAP (1u << 18)
DI unsigned xb_ld(unsigned* p)              { return __hip_atomic_load(p, __ATOMIC_RELAXED, __HIP_MEMORY_SCOPE_AGENT); }
DI unsigned xb_add(unsigned* p, unsigned v) { return __hip_atomic_fetch_add(p, v, __ATOMIC_RELAXED, __HIP_MEMORY_SCOPE_AGENT); }
DI unsigned xb_xcc_id() { return (unsigned)__builtin_amdgcn_s_getreg((3 << 11) | 20) & 0xFu; }
#define XB_SPIN(cond, bar) do { unsigned _sp = 0; while (cond) { __builtin_amdgcn_s_sleep(1); \
    if ((++_sp & 255u) == 0u) { if (xb_ld(&(bar)[XB_TMO])) break; if (_sp > XB_SPIN_CAP) { atomicAdd(&(bar)[XB_TMO], 1u); break; } } } } while (0)
DI void xcd_barrier_complete(unsigned* bar, unsigned x, unsigned& nloc, unsigned& nx) {
    const unsigned G = gridDim.x * gridDim.y * gridDim.z;
    unsigned sum, cnt, mine, sp = 0u;
    for (;;) {
        sum = 0u; cnt = 0u; mine = 0u;
#pragma unroll
        for (unsigned j = 0; j < 16; ++j) { const unsigned c = xb_ld(&bar[XB_XCNT(j)]); sum += c; cnt += (c > 0u) ? 1u : 0u; mine = (j == x) ? c : mine; }
        if (sum == G) break;
        __builtin_amdgcn_s_sleep(1);
        if ((++sp & 255u) == 0u) { if (xb_ld(&bar[XB_TMO])) break; if (sp > XB_SPIN_CAP) { atomicAdd(&bar[XB_TMO], 1u); break; } }
    }
    nloc = mine > 0u ? mine : 1u; nx = cnt > 0u ? cnt : 1u;
}
DI void xcd_barrier(unsigned* bar, volatile LAS unsigned* st) {
    asm volatile("s_waitcnt vmcnt(0)" ::: "memory");
    __syncthreads();
    if (threadIdx.x == 0) {
        const unsigned x = xb_xcc_id();
        __builtin_amdgcn_s_waitcnt(0);
        unsigned nloc = st[0], nx = st[1];
        if (nloc == 0u) { xcd_barrier_complete(bar, x, nloc, nx); st[0] = nloc; st[1] = nx; }
        const unsigned old = xb_add(&bar[XB_XSUB(x)], 1u);
        const unsigned gen = old / nloc;
        if (old + 1u == (gen + 1u) * nloc) {
            __builtin_amdgcn_fence(__ATOMIC_RELEASE, "agent");
            asm volatile("s_waitcnt vmcnt(0)" ::: "memory");
            const unsigned og = xb_add(&bar[XB_TOP], 1u);
            const unsigned tg = og / nx;
            if (og + 1u == (tg + 1u) * nx) xb_add(&bar[XB_TOPGEN], 1u);
            else XB_SPIN(xb_ld(&bar[XB_TOPGEN]) == tg, bar);
            __builtin_amdgcn_fence(__ATOMIC_ACQUIRE, "agent");
            xb_add(&bar[XB_XGEN(x)], 1u);
            asm volatile("s_waitcnt vmcnt(0)" ::: "memory");
        } else {
            XB_SPIN(xb_ld(&bar[XB_XGEN(x)]) == gen, bar);
            __builtin_amdgcn_fence(__ATOMIC_ACQUIRE, "agent");
            asm volatile("s_waitcnt vmcnt(0)" ::: "memory");
        }
    }
    __syncthreads();
}
template <bool FIRST> DI void grid_barrier(cg::grid_group& grid, LAS unsigned char* lds) {
    unsigned* bar = (unsigned*)((unsigned char*)karg_ptr(144) + WS_BAR);
    if constexpr (FIRST) {
        grid_barrier_cg(grid);
        if (threadIdx.x == 0) (void)xb_add(&bar[XB_XCNT(xb_xcc_id())], 1u);
    } else {
        xcd_barrier(bar, (volatile LAS unsigned*)(lds + MISC_OFF + 64));
    }
}

#define PH_IN(k) (lo <= (k) && (k) < hi)
#define PH_SEAM(k) do { if (PH_IN(k) && PH_IN((k) + 1)) grid_barrier<(k) == 0>(grid, lds); } while (0)
#define PH_ENV() int G = gridDim.x, bx = blockIdx.x; asm volatile("" : "+s"(G), "+s"(bx)); unsigned char* ws = (unsigned char*)karg_ptr(144); float* X = (float*)karg_ptr(136); \
                 const int tid = my_tid(); bf16_t* XN = (bf16_t*)(ws + WS_XN); (void)tid; (void)X; (void)XN; (void)G; (void)bx

template <int L> DI void run_layer(LAS unsigned char* lds, cg::grid_group& grid, int lo, int hi) {
    constexpr int P0 = 10 * L;
    if (PH_IN(P0 + 0)) for (int rep_ = 0; rep_ < ((((DUP_MASK >> 0) & 1) && L > 0) ? 2 : 1); ++rep_) { if (rep_) grid_barrier<false>(grid, lds);
        PH_ENV();
        Wts W;
        W.w_in = KIN(2) + (size_t)L * 1024 * IN_COLS; W.cmp_pe = KIN(3) + (size_t)L * 2 * 2048; W.cmp_w1 = KIN(4) + (size_t)L * 2 * 2048 * 256;
        W.cmp_w2 = KIN(5) + (size_t)L * 2 * 256 * 64; W.nsa_w_o = KIN(6) + (size_t)L * 512 * 1024; W.q_norm = KIN(7) + L * 256; W.kv_norm = KIN(8) + L * 128;
        W.w_uq = KIN(9) + (size_t)L * 256 * 768; W.w_ukv = KIN(10) + (size_t)L * 128 * 1024; W.mla_w_o = KIN(11) + (size_t)L * 512 * 1024;
        W.w_out = KIN(12) + (size_t)L * 1024 * 1024; W.w_up = KIN(14) + (size_t)L * 1024 * 4096; W.w_down = KIN(15) + (size_t)L * 4096 * 1024;
        prep_phase(W, ws, lds, L);
        unsigned* ctl = (unsigned*)(ws + WS_CTL);
        if (L == 0 && bx == 0 && tid < 2 * NL) atomicExch(ctl + tid * 64, 0u);
        norm_rows_bf16(L == 0 ? KIN(0) : X, KIN(1) + L * D, XN);
    }
    PH_SEAM(P0 + 0);
    if (PH_IN(P0 + 1)) for (int rep_ = 0; rep_ < (((DUP_MASK >> 1) & 1) ? 2 : 1); ++rep_) { if (rep_) grid_barrier<false>(grid, lds);
        PH_ENV();
        pg8::Gemm g{XN, (const bf16_t*)(ws + WS_WIN), 1024, 1024}; pg8::StaticOrder So; So.init(M, NIN, G, bx);
        EpiWrap<EpiInImpl> E; E.ws = ws;
        pg8::gemm_phase(lds, g, So, E);
    }
    PH_SEAM(P0 + 1);
    if (PH_IN(P0 + 2)) for (int rep_ = 0; rep_ < (((DUP_MASK >> 2) & 1) ? 2 : 1); ++rep_) { if (rep_) grid_barrier<false>(grid, lds);
        PH_ENV();
        if (bx < 32) {
            pg8::CmpOrder So{G, bx};
            { pg8::Gemm g{(const bf16_t*)(ws + WS_KCV), (const bf16_t*)(ws + WS_W1T), 1024, 2048}; EpiWrap<EpiC1Impl> E; E.ws = ws; pg8::gemm_phase(lds, g, So, E); }
            { pg8::Gemm g{(const bf16_t*)(ws + WS_HC), (const bf16_t*)(ws + WS_W2T), 256, 256}; EpiWrap<EpiC2Impl> E; E.ws = ws; pg8::gemm_phase(lds, g, So, E); }
        } else {
            { pg8::Gemm g{(const bf16_t*)(ws + WS_CQ), (const bf16_t*)(ws + WS_WUQ), 256, 256}; pg8::StaticOrder So; So.init(M, 768, G - 32, bx - 32);
              EpiWrap<EpiUQImpl> E; E.ws = ws;
              pg8::gemm_phase(lds, g, So, E); }
            { pg8::Gemm g{(const bf16_t*)(ws + WS_T6), (const bf16_t*)(ws + WS_WUKV), 256, 256}; pg8::StaticOrder So; So.init(M, 1024, G - 32, bx - 32);
              EpiWrap<EpiUKVImpl> E; E.ws = ws;
              pg8::gemm_phase(lds, g, So, E); }
        }
    }
    PH_SEAM(P0 + 2);
    if (PH_IN(P0 + 4)) for (int rep_ = 0; rep_ < (((DUP_MASK >> 4) & 1) ? 2 : 1); ++rep_) { if (rep_) grid_barrier<false>(grid, lds);
        PH_ENV();
        Bufs B; B.QN = (const bf16_t*)(ws + WS_QN); B.KS = (const bf16_t*)(ws + WS_KS); B.KW = (const bf16_t*)(ws + WS_KW); B.VST = (const bf16_t*)(ws + WS_VST);
        B.VWT = (const bf16_t*)(ws + WS_VWT); B.KCMP = (const bf16_t*)(ws + WS_KCMP); B.VCMPT = (const bf16_t*)(ws + WS_VCMPT); B.QM = (const bf16_t*)(ws + WS_QM);
        B.KM = (const bf16_t*)(ws + WS_KM); B.KPE = (const bf16_t*)(ws + WS_KPE); B.VMT = (const bf16_t*)(ws + WS_VMT); B.GN = (const float*)(ws + WS_GN); B.OAB = XN;
#if EXP_NOATTN
        { u32x4* o = (u32x4*)XN; for (size_t i = (size_t)bx * 512 + tid; i < (size_t)M * 1024 / 8; i += (size_t)G * 512) o[i] = (u32x4){0x3c003c00u, 0x3c003c00u, 0x3c003c00u, 0x3c003c00u}; (void)B; }
#else
        attn_phase(B, lds, (unsigned*)(ws + WS_CTL) + (L * 2 + rep_) * 64);
#endif
    }
    PH_SEAM(P0 + 4);
    if (PH_IN(P0 + 5)) for (int rep_ = 0; rep_ < (((DUP_MASK >> 5) & 1) ? 2 : 1); ++rep_) { if (rep_) grid_barrier<false>(grid, lds);
        PH_ENV();
        pg8::StaticOrder So; So.init(M, 1024, G, bx);
        { pg8::Gemm g{XN, (const bf16_t*)(ws + WS_WOAB), 1024, 512}; EpiWrap<EpiD1aImpl> E; E.ws = ws; pg8::gemm_phase(lds, g, So, E); }
        { pg8::Gemm g{XN + 512, (const bf16_t*)(ws + WS_WOAB) + 1024 * 512, 1024, 512}; EpiWrap<EpiD1bImpl> E; E.ws = ws; pg8::gemm_phase(lds, g, So, E); }
    }
    PH_SEAM(P0 + 5);
    if (PH_IN(P0 + 6)) for (int rep_ = 0; rep_ < (((DUP_MASK >> 6) & 1) ? 2 : 1); ++rep_) { if (rep_) grid_barrier<false>(grid, lds);
        PH_ENV();
        pg8::Gemm g{(const bf16_t*)(ws + WS_MG), (const bf16_t*)(ws + WS_WOUT), 1024, 1024}; pg8::StaticOrder So; So.init(M, 1024, G, bx);
        EpiWrap<EpiD2Impl> E; E.xin = (L == 0 ? KIN(0) : X); E.X = X;
        pg8::gemm_phase(lds, g, So, E);
    }
    PH_SEAM(P0 + 6);
    if (PH_IN(P0 + 7)) for (int rep_ = 0; rep_ < (((DUP_MASK >> 7) & 1) ? 2 : 1); ++rep_) { if (rep_) grid_barrier<false>(grid, lds);
        PH_ENV();
        norm_rows_bf16(X, KIN(13) + L * D, XN);
    }
    PH_SEAM(P0 + 7);
    if (PH_IN(P0 + 8)) for (int rep_ = 0; rep_ < (((DUP_MASK >> 8) & 1) ? 2 : 1); ++rep_) { if (rep_) grid_barrier<false>(grid, lds);
        PH_ENV();
        pg8::Gemm g{XN, (const bf16_t*)(ws + WS_WUP), 1024, 1024}; pg8::StaticOrder So; So.init(M, FF, G, bx);
        EpiWrap<EpiUpImpl> E; E.ws = ws;
        pg8::gemm_phase(lds, g, So, E);
    }
    PH_SEAM(P0 + 8);
    if (PH_IN(P0 + 9)) for (int rep_ = 0; rep_ < (((DUP_MASK >> 9) & 1) ? 2 : 1); ++rep_) { if (rep_) grid_barrier<false>(grid, lds);
        PH_ENV();
        pg8::Gemm g{(const bf16_t*)(ws + WS_HF), (const bf16_t*)(ws + WS_WDN), 4096, 4096}; pg8::StaticOrder So; So.init(M, 1024, G, bx);
        EpiWrap<EpiD2Impl> E; E.xin = X; E.X = X;
        pg8::gemm_phase(lds, g, So, E);
    }
    PH_SEAM(P0 + 9);
}

__global__ void __launch_bounds__(512, 2) mega(Params P) {
    extern __shared__ __attribute__((aligned(16))) unsigned char lds_raw[];
    LAS unsigned char* lds = (LAS unsigned char*)lds_raw;
    cg::grid_group grid = cg::this_grid();
    const int lo = P.ph_lo, hi = P.ph_hi;
    if (threadIdx.x < 2) ((volatile LAS unsigned*)(lds + MISC_OFF + 64))[threadIdx.x] = 0u;
    if (blockIdx.x == 0 && hi - lo > 1) { unsigned* bar = (unsigned*)((unsigned char*)karg_ptr(144) + WS_BAR);
        for (int i = threadIdx.x; i < XCD_BAR_WORDS; i += 512) __hip_atomic_store(bar + i, 0u, __ATOMIC_RELAXED, __HIP_MEMORY_SCOPE_AGENT); }
    __syncthreads();
    run_layer<0>(lds, grid, lo, hi);
    run_layer<1>(lds, grid, lo, hi);
    run_layer<2>(lds, grid, lo, hi);
    run_layer<3>(lds, grid, lo, hi);
    if (PH_IN(39) && PH_IN(40)) {   }
    if (PH_IN(40)) { float* X = (float*)karg_ptr(136); norm_rows_f32_inplace(X, KIN(16)); }
}

extern "C" void kernel_launch(void* const* d_in, const int* in_sizes, int n_in, void* d_out, int out_size, void* d_ws, size_t ws_size, hipStream_t stream) {
    static int grid = 0;
    if (grid == 0) {
        if (n_in != 17 || out_size != M * D || ws_size < WS_END) { fprintf(stderr, "kernel_launch: unexpected shapes (n_in %d out %d ws %zu)\n", n_in, out_size, ws_size); grid = -1; return; }
        int dev = 0, cus = 0, per_cu = 0;
        hipGetDevice(&dev);
        hipDeviceGetAttribute(&cus, hipDeviceAttributeMultiprocessorCount, dev);
        if (hipFuncSetAttribute((const void*)mega, hipFuncAttributeMaxDynamicSharedMemorySize, LDS_BYTES) != hipSuccess) { fprintf(stderr, "kernel_launch: hipFuncSetAttribute failed\n"); grid = -1; return; }
        if (hipOccupancyMaxActiveBlocksPerMultiprocessor(&per_cu, (const void*)mega, 512, LDS_BYTES) != hipSuccess || per_cu < 1) { fprintf(stderr, "kernel_launch: occupancy query gave %d\n", per_cu); per_cu = 1; }
        (void)hipGetLastError();
        grid = cus * per_cu;
        if (grid < 64) { fprintf(stderr, "kernel_launch: grid %d too small for the phase program\n", grid); grid = -1; return; }
    }
    if (grid < 0) return;
    Params p{};
    for (int i = 0; i < 17; ++i) p.in[i] = (const float*)d_in[i];
    p.out = (float*)d_out; p.ws = (unsigned char*)d_ws;
#if MK_MULTI
    for (int ph = 0; ph <= 40; ++ph) {
        p.ph_lo = ph; p.ph_hi = ph + 1;
        hipLaunchKernelGGL(mega, dim3(grid), dim3(512), LDS_BYTES, stream, p);
    }
#else
    p.ph_lo = 0; p.ph_hi = 41;
    void* args[] = {&p};
    hipError_t e = hipLaunchCooperativeKernel((const void*)mega, dim3(grid), dim3(512), args, LDS_BYTES, stream);
    if (e != hipSuccess) fprintf(stderr, "kernel_launch: cooperative launch failed: %s (grid %d)\n", hipGetErrorString(e), grid);
#endif
}
```

```cpp
#include <hip/hip_runtime.h>
#include <hip/hip_cooperative_groups.h>
#include <cstdio>
#include <cstdint>
namespace cg = cooperative_groups;

#ifndef EXP_NOATTN
#define EXP_NOATTN 0
#endif
#ifndef ATT_STATIC
#define ATT_STATIC 0
#endif
#ifndef EXP_ATT
#define EXP_ATT 0
#endif
#ifndef DUP_MASK
#define DUP_MASK 0
#endif
#ifndef ATT_DUP
#define ATT_DUP 0
#endif
#ifndef STAG_CMP
#define STAG_CMP false
#define STAG_SLC false
#define STAG_WIN true
#define STAG_MLA true
#endif
#ifndef MK_MULTI
#define MK_MULTI 0
#endif

#define LAS __attribute__((address_space(3)))
#define DI __device__ __forceinline__
typedef unsigned short bf16_t;
typedef short bf16x8 __attribute__((ext_vector_type(8)));
typedef float f32x4 __attribute__((ext_vector_type(4)));
typedef float f32x2 __attribute__((ext_vector_type(2)));
typedef float f32x16 __attribute__((ext_vector_type(16)));
typedef unsigned u32x4 __attribute__((ext_vector_type(4)));
typedef unsigned u32x2 __attribute__((ext_vector_type(2)));
typedef __bf16 bf16v2 __attribute__((ext_vector_type(2)));

DI unsigned pk2(float lo, float hi) { f32x2 v = {lo, hi}; return __builtin_bit_cast(unsigned, __builtin_convertvector(v, bf16v2)); }
DI bf16_t f2bf(float x) { return (bf16_t)(pk2(x, 0.f) & 0xffffu); }
DI float bflo(unsigned w) { return __uint_as_float(w << 16); }
DI float bfhi(unsigned w) { return __uint_as_float(w & 0xffff0000u); }
DI float sigmoidf_(float x) { return 1.f / (1.f + __expf(-x)); }
DI float ex2(float x) { return __builtin_amdgcn_exp2f(x); }
DI int my_tid() { int t = threadIdx.x; asm volatile("" : "+v"(t)); return t; }

constexpr int NB = 8, S = 4096, D = 1024, NL = 4, M = NB * S, FF = 4096;
constexpr int NIN = 3840;
constexpr int IN_COLS = 3768;
constexpr float EPS = 1e-6f;
constexpr float LOG2E = 1.4426950408889634f;

constexpr size_t MiB = 1u << 20;
constexpr size_t WS_CTL = 0;
constexpr size_t WS_BAR = 16384;
constexpr size_t WS_CB1 = 4096;
constexpr size_t WS_RSQ = 65536;
constexpr size_t WS_RSKV = 65536 + 131072;
constexpr size_t WS_CS64 = 1 * MiB;
constexpr size_t WS_CS32 = 2 * MiB;
constexpr size_t WS_WIN = 3 * MiB;
constexpr size_t WS_W1T = WS_WIN + (size_t)NIN * 1024 * 2;
constexpr size_t WS_W2T = WS_W1T + 2 * MiB;
constexpr size_t WS_WOAB = WS_W2T + 256 * 1024;
constexpr size_t WS_WUQ = WS_WOAB + 2 * MiB;
constexpr size_t WS_WUKV = WS_WUQ + 384 * 1024;
constexpr size_t WS_WOUT = 16 * MiB;
constexpr size_t WS_WUP = 18 * MiB;
constexpr size_t WS_WDN = 26 * MiB;
constexpr size_t WS_XN = 34 * MiB;
constexpr size_t WS_GA = 98 * MiB;
constexpr size_t WS_GB = 162 * MiB;
constexpr size_t WS_QN = 226 * MiB;
constexpr size_t WS_KCV = 258 * MiB;
constexpr size_t WS_KS = 274 * MiB, WS_KW = 282 * MiB, WS_VST = 290 * MiB, WS_VWT = 298 * MiB;
constexpr size_t WS_CQ = 306 * MiB, WS_T6 = 322 * MiB, WS_KPE = 338 * MiB, WS_GN = 340 * MiB;
constexpr size_t WS_QM = 343 * MiB, WS_KM = 391 * MiB, WS_VMT = 423 * MiB, WS_HC = 455 * MiB;
constexpr size_t WS_KCMP = 459 * MiB, WS_VCMPT = WS_KCMP + 512 * 1024;
constexpr size_t WS_MG = 226 * MiB;
constexpr size_t WS_HF = 98 * MiB;
constexpr size_t WS_PQ = 460 * MiB;
constexpr size_t WS_PKV = 461 * MiB;
constexpr size_t WS_END = 462 * MiB;
static_assert(WS_WUKV + 512 * 1024 <= WS_WOUT, "ws map");

constexpr int LDS_BYTES = 147456;
constexpr int MISC_OFF = 147200;
constexpr int AT_K = 0, AT_KB = 13312  , AT_V = 26624, AT_VB = 9216  , AT_IMP = 54272, AT_SEL = 70656, AT_LIST = 71168, AT_CNT = 71424, AT_ACC = 71680;

namespace pg8 {
constexpr int BM = 256, BK = 64, HALF = 128, HTB = HALF * BK * 2, NXCD = 8, WGM = 8;
__host__ __device__ __forceinline__ int lds_byte(int r, int c) { const int st = (r >> 4) * 2 + (c >> 5), rr = r & 15, cc = c & 31, ob = rr * 64 + cc * 2; return st * 1024 + (ob ^ (((ob >> 9) & 1) << 5)); }
__host__ __device__ __forceinline__ void stage_rc(int b, int& R, int& C) { const int st = b / 1024, sb = b % 1024, swz = sb ^ (((sb >> 9) & 1) << 5); R = (st >> 1) * 16 + swz / 64; C = (st & 1) * 32 + (swz % 64) / 2; }
__host__ __device__ __forceinline__ int perm32(int rho) { const int n = rho >> 4, i = rho & 15; return 8 * (i >> 2) + 4 * n + (i & 3); }

struct Unit { int pm, pn; };
struct Gemm { const bf16_t* A; const bf16_t* Bt; int lda; int K; };

struct StaticOrder {
    int nM, nN, nwg, G, c;
    __device__ void init(int M_, int N_, int G_, int c_) { nM = M_ / BM; nN = N_ / BM; nwg = nM * nN; G = G_; c = c_; }
    __device__ bool next(int i, Unit& u) const {
        const long L = (long)i * G + c; if (L >= nwg) return false;
        int wgid = (int)L; { const int q = nwg / NXCD, r = nwg % NXCD, xcd = wgid % NXCD, off = wgid / NXCD; wgid = (xcd < r ? xcd * (q + 1) : r * (q + 1) + (xcd - r) * q) + off; }
        const int nig = WGM * nN, gid = wgid / nig, fm = gid * WGM, gsz = (nM - fm) < WGM ? (nM - fm) : WGM;
        u.pm = fm + ((wgid % nig) % gsz); u.pn = (wgid % nig) / gsz; return true;
    }
};
struct CmpOrder {
    int G, c;
    __device__ bool next(int i, Unit& u) const { const int L = i * G + c; if (L >= 32) return false; u.pm = L; u.pn = L >> 4; return true; }
};

template <class Epi, class Sched>
__device__ __forceinline__ void gemm_phase(LAS unsigned char* lds, const Gemm g, const Sched& S, const Epi& E) {
    const int tid = my_tid(), wid = __builtin_amdgcn_readfirstlane(tid >> 6), lane = tid & 63, wr = wid >> 2, wc = wid & 3, fr = lane & 15, fq = lane >> 4;
    const int K = g.K, nt = K / BK, lda = g.lda;
    unsigned voffA, voffB;
    { int R, C; stage_rc(tid * 16, R, C); const int Rb = (R & ~31) + perm32(R & 31);
        voffA = (unsigned)(R * lda + C) * 2u; voffB = (unsigned)(Rb * K + C) * 2u; }
    const size_t qvoffA = (size_t)64 * lda * 2, qvoffB = (size_t)64 * K * 2;
    const size_t kstep = (size_t)(BK * 2);
    const size_t hstepA = (size_t)HALF * lda * 2, hstepB = (size_t)HALF * K * 2;
    const size_t tstepA = 2 * hstepA, tstepB = 2 * hstepB;
    const unsigned ldsw = (unsigned)wid * 1024u;
    const int aoff = lds_byte(wr * 64 + fr, fq * 8), boff = lds_byte(wc * 32 + fr, fq * 8);
#define PG8_SA(b, h) (((b) * 2 + (h)) * HTB)
#define PG8_SB(b, h) ((4 + (b) * 2 + (h)) * HTB)
#define PG8_STAGE(bufoff, gbase, voff) do { _Pragma("unroll") for (int _i = 0; _i < 2; ++_i) \
        __builtin_amdgcn_global_load_lds((const unsigned*)((const char*)(gbase) + (size_t)_i * q##voff + (voff)), (LAS unsigned*)(lds + (bufoff) + ldsw + _i * 8192), 16, 0, 0); } while (0)
#define PG8_LDA(dst, b, h) do { _Pragma("unroll") for (int m = 0; m < 4; ++m) _Pragma("unroll") for (int k = 0; k < 2; ++k) dst[m][k] = *(const LAS bf16x8*)(lds + PG8_SA(b, h) + aoff + m * 2048 + k * 1024); } while (0)
#define PG8_LDB(dst, b, h) do { _Pragma("unroll") for (int n = 0; n < 2; ++n) _Pragma("unroll") for (int k = 0; k < 2; ++k) dst[n][k] = *(const LAS bf16x8*)(lds + PG8_SB(b, h) + boff + n * 2048 + k * 1024); } while (0)
#define PG8_MMA(ai, bj, At, Bt) do { __builtin_amdgcn_s_setprio(1); _Pragma("unroll") for (int m = 0; m < 4; ++m) _Pragma("unroll") for (int n = 0; n < 2; ++n) _Pragma("unroll") for (int k = 0; k < 2; ++k) \
        acc[ai][bj][m][n] = __builtin_amdgcn_mfma_f32_16x16x32_bf16(Bt[n][k], At[m][k], acc[ai][bj][m][n], 0, 0, 0); __builtin_amdgcn_s_setprio(0); } while (0)
#define PG8_WAIT_V(n) asm volatile("s_waitcnt vmcnt(" #n ")" ::: "memory")
#define PG8_WAIT_L(n) asm volatile("s_waitcnt lgkmcnt(" #n ")" ::: "memory")
#define PG8_BAR __builtin_amdgcn_s_barrier()
#define PG8_SCHED __builtin_amdgcn_sched_barrier(0)
    Unit cur, nxt; int ui = 0;
    if (!S.next(0, cur)) return;
    f32x4 acc[2][2][4][2];
#pragma unroll
    for (int a = 0; a < 2; ++a)
#pragma unroll
        for (int b = 0; b < 2; ++b)
#pragma unroll
            for (int m = 0; m < 4; ++m)
#pragma unroll
                for (int n = 0; n < 2; ++n) acc[a][b][m][n] = (f32x4){0.f, 0.f, 0.f, 0.f};
    bf16x8 At[4][2], B0[2][2], B1[2][2];
    const char* cA = (const char*)g.A + (size_t)cur.pm * tstepA; const char* cB = (const char*)g.Bt + (size_t)cur.pn * tstepB;
    PG8_STAGE(PG8_SB(0, 0), cB, voffB); PG8_STAGE(PG8_SB(0, 1), cB + hstepB, voffB); PG8_STAGE(PG8_SA(0, 0), cA, voffA); PG8_STAGE(PG8_SA(0, 1), cA + hstepA, voffA);
    if (wr == 1) PG8_BAR;
    PG8_WAIT_V(2); PG8_BAR;
    PG8_STAGE(PG8_SB(1, 0), cB + kstep, voffB); PG8_STAGE(PG8_SA(1, 0), cA + kstep, voffA); PG8_STAGE(PG8_SB(1, 1), cB + hstepB + kstep, voffB);
    PG8_WAIT_V(6); PG8_BAR;
    for (;;) {
        const bool has_next = S.next(ui + 1, nxt);
        const char* nA = has_next ? (const char*)g.A + (size_t)nxt.pm * tstepA : cA; const char* nB = has_next ? (const char*)g.Bt + (size_t)nxt.pn * tstepB : cB;
        for (int t = 0; t < nt; t += 2) {
            const bool last = (t == nt - 2);
            const char* a1 = cA + (size_t)(t + 1) * kstep;
            const char* a2 = last ? nA : cA + (size_t)(t + 2) * kstep; const char* b2 = last ? nB : cB + (size_t)(t + 2) * kstep;
            const char* a3 = a2 + kstep; const char* b3 = b2 + kstep;
            PG8_LDB(B0, 0, 0); PG8_LDB(B1, 0, 1); PG8_SCHED; PG8_LDA(At, 0, 0); PG8_STAGE(PG8_SA(1, 1), a1 + hstepA, voffA);
            PG8_WAIT_V(8); PG8_WAIT_L(0); PG8_BAR; PG8_MMA(0, 0, At, B0); PG8_MMA(0, 1, At, B1); PG8_BAR; PG8_SCHED;
            PG8_LDA(At, 0, 1); PG8_STAGE(PG8_SB(0, 0), b2, voffB); PG8_STAGE(PG8_SB(0, 1), b2 + hstepB, voffB); PG8_STAGE(PG8_SA(0, 0), a2, voffA);
            PG8_WAIT_V(8); PG8_WAIT_L(0); PG8_BAR; PG8_MMA(1, 0, At, B0); PG8_MMA(1, 1, At, B1); PG8_BAR; PG8_SCHED;
            PG8_LDB(B0, 1, 0); PG8_LDB(B1, 1, 1); PG8_SCHED; PG8_LDA(At, 1, 0); PG8_STAGE(PG8_SA(0, 1), a2 + hstepA, voffA);
            PG8_WAIT_V(8); PG8_WAIT_L(0); PG8_BAR; PG8_MMA(0, 0, At, B0); PG8_MMA(0, 1, At, B1); PG8_BAR; PG8_SCHED;
            PG8_LDA(At, 1, 1); PG8_STAGE(PG8_SB(1, 0), b3, voffB); PG8_STAGE(PG8_SB(1, 1), b3 + hstepB, voffB); PG8_STAGE(PG8_SA(1, 0), a3, voffA);
            PG8_WAIT_V(8); PG8_WAIT_L(0); PG8_BAR; PG8_MMA(1, 0, At, B0); PG8_MMA(1, 1, At, B1); PG8_BAR; PG8_SCHED;
        }
        if (wr == 0) PG8_BAR;
        E(acc, cur, wr, wc, fr, fq);
        if (!has_next) break;
#pragma unroll
        for (int a = 0; a < 2; ++a)
#pragma unroll
            for (int b = 0; b < 2; ++b)
#pragma unroll
                for (int m = 0; m < 4; ++m)
#pragma unroll
                    for (int n = 0; n < 2; ++n) acc[a][b][m][n] = (f32x4){0.f, 0.f, 0.f, 0.f};
        cur = nxt; cA = nA; cB = nB; ++ui;
        if (wr == 1) PG8_BAR;
    }
    PG8_WAIT_V(0);
    PG8_BAR;
#undef PG8_SA
#undef PG8_SB
#undef PG8_STAGE
#undef PG8_LDA
#undef PG8_LDB
#undef PG8_MMA
#undef PG8_WAIT_V
#undef PG8_WAIT_L
#undef PG8_BAR
#undef PG8_SCHED
}
}
using pg8::Unit;

DI void store8(bf16_t* p, const float (&v)[8]) { u32x4 w = {pk2(v[0], v[1]), pk2(v[2], v[3]), pk2(v[4], v[5]), pk2(v[6], v[7])}; *(u32x4*)p = w; }
DI void rope8(float (&v)[8], const f32x2* cs) {
    const f32x4 c0 = *(const f32x4*)cs, c1 = *(const f32x4*)(cs + 2);
    const float co[4] = {c0[0], c0[2], c1[0], c1[2]}, si[4] = {c0[1], c0[3], c1[1], c1[3]};
#pragma unroll
    for (int k = 0; k < 4; ++k) { const float a = v[2 * k], b = v[2 * k + 1]; v[2 * k] = a * co[k] - b * si[k]; v[2 * k + 1] = a * si[k] + b * co[k]; }
}
DI float sumsq_fq(const float (&v)[8]) {
    float s = 0.f;
#pragma unroll
    for (int e = 0; e < 8; ++e) s += v[e] * v[e];
    s += __shfl_xor(s, 16); s += __shfl_xor(s, 32); return s;
}

template <class Impl> struct EpiWrap : Impl {
    static constexpr bool MID = false;
    DI void operator()(const f32x4 (&acc)[2][2][4][2], const Unit& u, int wr, int wc, int, int) const {
        const int t2 = my_tid(), fr = t2 & 15, fq = (t2 >> 4) & 3;
#pragma unroll
        for (int ai = 0; ai < 2; ++ai)
#pragma unroll
            for (int m = 0; m < 4; ++m)
#pragma unroll
                for (int bj = 0; bj < 2; ++bj) {
                    const f32x4 a0 = acc[ai][bj][m][0], a1 = acc[ai][bj][m][1];
                    float v[8] = {a0[0], a0[1], a0[2], a0[3], a1[0], a1[1], a1[2], a1[3]};
                    this->chunk(u.pm * 256 + ai * 128 + wr * 64 + m * 16 + fr, u.pn, bj * 128 + wc * 32 + 8 * fq, v);
                }
    }
};

#define WSP(T, off) ((T*)(ws + (off)))
struct EpiInImpl {
    unsigned char* ws;
    DI void chunk(int row, int pn, int cc, float (&v)[8]) const {
        const int pos = row & (S - 1), b = row >> 12;
        bf16_t* const QN = WSP(bf16_t, WS_QN); bf16_t* const KCV = WSP(bf16_t, WS_KCV); bf16_t* const CQ = WSP(bf16_t, WS_CQ); bf16_t* const T6 = WSP(bf16_t, WS_T6);
        bf16_t* const KPE = WSP(bf16_t, WS_KPE); float* const GN = WSP(float, WS_GN); float* const PQ = WSP(float, WS_PQ); float* const PKV = WSP(float, WS_PKV);
        const f32x2* const CS64 = WSP(const f32x2, WS_CS64); const f32x2* const CS32 = WSP(const f32x2, WS_CS32);
        if (pn < 2) {
            rope8(v, CS64 + pos * 32 + ((cc & 63) >> 1));
            store8(QN + (size_t)row * 512 + pn * 256 + cc, v);
        } else if (pn < 5) {
            const int kv = cc >> 7, g = (cc >> 6) & 1, p = cc & 63, bg = b * 2 + g;
            if (kv == 0) {
                rope8(v, CS64 + pos * 32 + (p >> 1));
                bf16_t* dst = WSP(bf16_t, pn == 2 ? WS_KCV : (pn == 3 ? WS_KS : WS_KW));
                store8(dst + ((size_t)bg * S + pos) * 64 + p, v);
            } else if (pn == 2) {
                store8(KCV + ((size_t)(16 + bg) * S + pos) * 64 + p, v);
            } else {
                bf16_t* dst = WSP(bf16_t, pn == 3 ? WS_VST : WS_VWT);
#pragma unroll
                for (int e = 0; e < 8; ++e) dst[((size_t)bg * 64 + p + e) * S + pos] = f2bf(v[e]);
            }
        } else if (pn == 5) {
            store8(CQ + (size_t)row * 256 + cc, v);
            const float s = sumsq_fq(v);
            if ((threadIdx.x & 48) == 0) PQ[(size_t)row * 8 + (cc >> 5)] = s;
        } else if (pn == 6) {
            store8(T6 + (size_t)row * 256 + cc, v);
            if (cc < 128) {
                const float s = sumsq_fq(v);
                if ((threadIdx.x & 48) == 0) PKV[(size_t)row * 4 + (cc >> 5)] = s;
            } else if (cc < 160) {
                rope8(v, CS32 + pos * 16 + ((cc - 128) >> 1));
                store8(KPE + (size_t)row * 32 + (cc - 128), v);
            } else if (cc < 184) {
#pragma unroll
                for (int e = 0; e < 8; ++e) GN[(size_t)row * 24 + (cc - 160) + e] = sigmoidf_(v[e]);
            }
        } else {
#pragma unroll
            for (int e = 0; e < 8; ++e) v[e] = sigmoidf_(v[e]);
            if (pn < 11) store8(WSP(bf16_t, WS_GA) + (size_t)row * 1024 + (pn - 7) * 256 + cc, v);
            else store8(WSP(bf16_t, WS_GB) + (size_t)row * 1024 + (pn - 11) * 256 + cc, v);
        }
    }
};
struct EpiC1Impl {
    unsigned char* ws;
    DI void chunk(int row, int pn, int cc, float (&v)[8]) const {
        bf16_t* const HC = WSP(bf16_t, WS_HC); const float* const CB1 = WSP(const float, WS_CB1);
        const f32x4 b0 = *(const f32x4*)(CB1 + pn * 256 + cc), b1 = *(const f32x4*)(CB1 + pn * 256 + cc + 4);
        const float bb[8] = {b0[0], b0[1], b0[2], b0[3], b1[0], b1[1], b1[2], b1[3]};
#pragma unroll
        for (int e = 0; e < 8; ++e) { const float x = v[e] + bb[e]; v[e] = x / (1.f + __expf(-x)); }
        store8(HC + (size_t)row * 256 + cc, v);
    }
};
struct EpiC2Impl {
    unsigned char* ws;
    DI void chunk(int row, int pn, int cc, float (&v)[8]) const {
        if (cc >= 64) return;
        bf16_t* const KCMP = WSP(bf16_t, WS_KCMP); bf16_t* const VCMPT = WSP(bf16_t, WS_VCMPT);
        const int bg = (row >> 8) & 15, n = row & 255;
        if (n == 255) {
#pragma unroll
            for (int e = 0; e < 8; ++e) v[e] = 0.f;
        }
        if (pn == 0) store8(KCMP + ((size_t)bg * 256 + n) * 64 + cc, v);
        else {
#pragma unroll
            for (int e = 0; e < 8; ++e) VCMPT[((size_t)bg * 64 + cc + e) * 256 + n] = f2bf(v[e]);
        }
    }
};
struct EpiUQImpl {
    unsigned char* ws;
    DI void chunk(int row, int pn, int cc, float (&v)[8]) const {
        bf16_t* const QM = WSP(bf16_t, WS_QM); const float* const PQ = WSP(const float, WS_PQ); const f32x2* const CS32 = WSP(const f32x2, WS_CS32);
        const int c = pn * 256 + cc, hh = c / 96, c96 = c - hh * 96, pos = row & (S - 1);
        const f32x4 p0 = *(const f32x4*)(PQ + (size_t)row * 8), p1 = *(const f32x4*)(PQ + (size_t)row * 8 + 4);
        const float rstd = rsqrtf((((p0[0] + p0[1]) + (p0[2] + p0[3])) + ((p1[0] + p1[1]) + (p1[2] + p1[3]))) * (1.f / 256.f) + EPS);
#pragma unroll
        for (int e = 0; e < 8; ++e) v[e] *= rstd;
        if (c96 >= 64) rope8(v, CS32 + pos * 16 + ((c96 - 64) >> 1));
        store8(QM + (size_t)row * 768 + c, v);
    }
};
struct EpiUKVImpl {
    unsigned char* ws;
    DI void chunk(int row, int pn, int cc, float (&v)[8]) const {
        bf16_t* const KM = WSP(bf16_t, WS_KM); bf16_t* const VMT = WSP(bf16_t, WS_VMT); const float* const PKV = WSP(const float, WS_PKV);
        const int c = pn * 256 + cc, hh = c >> 7, c128 = c & 127, pos = row & (S - 1), b = row >> 12;
        const f32x4 p0 = *(const f32x4*)(PKV + (size_t)row * 4);
        const float rstd = rsqrtf(((p0[0] + p0[1]) + (p0[2] + p0[3])) * (1.f / 128.f) + EPS);
#pragma unroll
        for (int e = 0; e < 8; ++e) v[e] *= rstd;
        if (c128 < 64) store8(KM + ((size_t)(b * 8 + hh) * S + pos) * 64 + c128, v);
        else {
#pragma unroll
            for (int e = 0; e < 8; ++e) VMT[((size_t)(b * 8 + hh) * 64 + (c128 - 64) + e) * S + pos] = f2bf(v[e]);
        }
    }
};
struct EpiD2Impl {
    const float* xin; float* X;
    DI void chunk(int row, int pn, int cc, float (&v)[8]) const {
        const size_t o = (size_t)row * 1024 + pn * 256 + cc;
        const f32x4 x0 = *(const f32x4*)(xin + o), x1 = *(const f32x4*)(xin + o + 4);
        *(f32x4*)(X + o) = (f32x4){x0[0] + v[0], x0[1] + v[1], x0[2] + v[2], x0[3] + v[3]};
        *(f32x4*)(X + o + 4) = (f32x4){x1[0] + v[4], x1[1] + v[5], x1[2] + v[6], x1[3] + v[7]};
    }
};
struct EpiUpImpl {
    unsigned char* ws;
    DI void chunk(int row, int pn, int cc, float (&v)[8]) const {
        bf16_t* const HF = WSP(bf16_t, WS_HF);
#pragma unroll
        for (int e = 0; e < 8; ++e) { const float r = fmaxf(v[e], 0.f); v[e] = r * r; }
        store8(HF + (size_t)row * FF + pn * 256 + cc, v);
    }
};
struct EpiD1aImpl {
    unsigned char* ws;
    DI void chunk(int row, int pn, int cc, float (&v)[8]) const {
        const size_t o = (size_t)row * 1024 + pn * 256 + cc;
        const u32x4 a = *(const u32x4*)(WSP(const bf16_t, WS_GA) + o);
        v[0] *= bflo(a[0]); v[1] *= bfhi(a[0]); v[2] *= bflo(a[1]); v[3] *= bfhi(a[1]); v[4] *= bflo(a[2]); v[5] *= bfhi(a[2]); v[6] *= bflo(a[3]); v[7] *= bfhi(a[3]);
        store8(WSP(bf16_t, WS_MG) + o, v);
    }
};
struct EpiD1bImpl {
    unsigned char* ws;
    DI void chunk(int row, int pn, int cc, float (&v)[8]) const {
        const size_t o = (size_t)row * 1024 + pn * 256 + cc;
        const u32x4 b = *(const u32x4*)(WSP(const bf16_t, WS_GB) + o), g = *(const u32x4*)(WSP(const bf16_t, WS_MG) + o);
        v[0] = bflo(g[0]) + v[0] * bflo(b[0]); v[1] = bfhi(g[0]) + v[1] * bfhi(b[0]); v[2] = bflo(g[1]) + v[2] * bflo(b[1]); v[3] = bfhi(g[1]) + v[3] * bfhi(b[1]);
        v[4] = bflo(g[2]) + v[4] * bflo(b[2]); v[5] = bfhi(g[2]) + v[5] * bfhi(b[2]); v[6] = bflo(g[3]) + v[6] * bflo(b[3]); v[7] = bfhi(g[3]) + v[7] * bfhi(b[3]);
        store8(WSP(bf16_t, WS_MG) + o, v);
    }
};

#define MFMA32(a, b, c) __builtin_amdgcn_mfma_f32_32x32x16_bf16((a), (b), (c), 0, 0, 0)

template <int DQK> DI void qk_tile(const LAS unsigned char* sK, const bf16x8 (&qf)[DQK / 16], f32x16 (&s)[2], int lane) {
    constexpr int KSTR = DQK * 2 + 16;
    const int r = lane & 31, h = lane >> 5;
    const int rp = (r & 0x13) | ((r & 4) << 1) | ((r & 8) >> 1);
    bf16x8 kf[2][DQK / 16];
#pragma unroll
    for (int kt = 0; kt < 2; ++kt)
#pragma unroll
        for (int ks = 0; ks < DQK / 16; ++ks) kf[kt][ks] = *(const LAS bf16x8*)(sK + (32 * kt + rp) * KSTR + ks * 32 + h * 16);
    __builtin_amdgcn_sched_barrier(0);
#pragma unroll
    for (int kt = 0; kt < 2; ++kt) {
        f32x16 a;
#pragma unroll
        for (int i = 0; i < 16; ++i) a[i] = 0.f;
#pragma unroll
        for (int ks = 0; ks < DQK / 16; ++ks) a = MFMA32(kf[kt][ks], qf[ks], a);
        s[kt] = a;
    }
}
DI void v_load(bf16x8 (&vf)[2][2][2], const LAS unsigned char* sV, int lane) {
    const int h = lane >> 5, r = lane & 31;
#pragma unroll
    for (int kt = 0; kt < 2; ++kt)
#pragma unroll
        for (int s2 = 0; s2 < 2; ++s2)
#pragma unroll
            for (int dt = 0; dt < 2; ++dt) vf[kt][s2][dt] = *(const LAS bf16x8*)(sV + (32 * dt + r) * 144 + (32 * kt + 16 * s2 + 8 * h) * 2);
}

template <bool LANEOFF> DI void pack_p(const f32x16 (&s)[2], unsigned keep, u32x4 (&pp)[4]) {
#pragma unroll
    for (int kt = 0; kt < 2; ++kt)
#pragma unroll
        for (int s2 = 0; s2 < 2; ++s2) {
            u32x4 pw = {pk2(s[kt][8 * s2 + 0], s[kt][8 * s2 + 1]), pk2(s[kt][8 * s2 + 2], s[kt][8 * s2 + 3]),
                        pk2(s[kt][8 * s2 + 4], s[kt][8 * s2 + 5]), pk2(s[kt][8 * s2 + 6], s[kt][8 * s2 + 7])};
            if constexpr (LANEOFF) { pw[0] &= keep; pw[1] &= keep; pw[2] &= keep; pw[3] &= keep; }
            pp[kt * 2 + s2] = pw;
        }
}
DI void pv_packed(const u32x4 (&pp)[4], const bf16x8 (&vf)[2][2][2], f32x16 (&o)[2]) {
#pragma unroll
    for (int kt = 0; kt < 2; ++kt)
#pragma unroll
        for (int s2 = 0; s2 < 2; ++s2) {
            const bf16x8 pb = __builtin_bit_cast(bf16x8, pp[kt * 2 + s2]);
#pragma unroll
            for (int dt = 0; dt < 2; ++dt) o[dt] = MFMA32(vf[kt][s2][dt], pb, o[dt]);
        }
}
template <class Mask> DI void softmax_masked(f32x16 (&s)[2], int tile, const Mask& mask, float c, float& m, float& l, f32x16 (&o)[2], int lane) {
    const int h = lane >> 5;
    float mx = -1e30f;
#pragma unroll
    for (int kt = 0; kt < 2; ++kt)
#pragma unroll
        for (int reg = 0; reg < 16; ++reg) {
            const int key = 32 * kt + (reg & 7) + 8 * h + 16 * (reg >> 3);
            const float x = mask(tile, key) ? s[kt][reg] : -1e30f;
            s[kt][reg] = x; mx = fmaxf(mx, x);
        }
    mx = fmaxf(mx, __shfl_xor(mx, 32));
    const float mn = fmaxf(m, mx), alpha = ex2((m - mn) * c), nmc = -mn * c;
    m = mn;
    float sum = 0.f;
#pragma unroll
    for (int kt = 0; kt < 2; ++kt)
#pragma unroll
        for (int reg = 0; reg < 16; ++reg) {
            const float x = s[kt][reg];
            const float p = (x > -5e29f) ? ex2(__builtin_fmaf(x, c, nmc)) : 0.f;
            s[kt][reg] = p; sum += p;
        }
    l = l * alpha + sum;
    o[0] *= alpha; o[1] *= alpha;
}
template <bool LANEOFF> DI void softmax_full(f32x16 (&s)[2], bool lane_on, float c, float& m, float& l, f32x16 (&o)[2]) {
    float mx0 = fmaxf(s[0][0], s[1][0]), mx1 = fmaxf(s[0][1], s[1][1]);
#pragma unroll
    for (int reg = 2; reg < 16; reg += 2) { mx0 = fmaxf(mx0, fmaxf(s[0][reg], s[1][reg])); mx1 = fmaxf(mx1, fmaxf(s[0][reg + 1], s[1][reg + 1])); }
    float mx = fmaxf(mx0, mx1);
    mx = fmaxf(mx, __shfl_xor(mx, 32));
    if constexpr (LANEOFF) mx = lane_on ? mx : -1e30f;
    const float mn = fmaxf(m, mx);
    if (__any(mn > m)) { const float alpha = ex2((m - mn) * c); l *= alpha; o[0] *= alpha; o[1] *= alpha; }
    m = mn;
    const float nmc = -mn * c;
    float sum0 = 0.f, sum1 = 0.f;
#pragma unroll
    for (int kt = 0; kt < 2; ++kt)
#pragma unroll
        for (int reg = 0; reg < 16; reg += 2) {
            const float p0 = ex2(__builtin_fmaf(s[kt][reg], c, nmc)), p1 = ex2(__builtin_fmaf(s[kt][reg + 1], c, nmc));
            s[kt][reg] = p0; s[kt][reg + 1] = p1; sum0 += p0; sum1 += p1;
        }
    float sum = sum0 + sum1;
    if constexpr (LANEOFF) sum = lane_on ? sum : 0.f;
    l += sum;
}

struct TileRegs { u32x4 k, v, p; };
template <int DQK, bool LANEOFF, bool STAG, class TileOf, class Mask, class Skip>
DI void attn_run(LAS unsigned char* lds, const bf16_t* Kg, const bf16_t* Kpe, const bf16_t* Vg, int ldv, int ntiles,
                 const TileOf& tile_of, const Mask& mask, const Skip& skip, float c, const bf16x8 (&qf)[DQK / 16], float& m, float& l, f32x16 (&o)[2]) {
    constexpr int KSTR = DQK * 2 + 16;
    const int tid = my_tid(), lane = tid & 63;
    const int krow = tid >> 3, kch = tid & 7, prow = (tid >> 2) & 63, pch = tid & 3;
    TileRegs RA, RB;
    asm volatile("" : "=v"(RA.k), "=v"(RA.v), "=v"(RA.p), "=v"(RB.k), "=v"(RB.v), "=v"(RB.p));
#define ATT_LOAD(R, tt) do { const int t_ = (tt); (R).k = *(const u32x4*)(Kg + ((size_t)(t_ * 64 + krow)) * 64 + kch * 8); (R).v = *(const u32x4*)(Vg + (size_t)krow * ldv + t_ * 64 + kch * 8); \
        if constexpr (DQK == 96) { if (tid < 256) (R).p = *(const u32x4*)(Kpe + ((size_t)(t_ * 64 + prow)) * 32 + pch * 8); } } while (0)
#define ATT_WRITE(R, kb_, vb_) do { *(LAS u32x4*)(lds + AT_K + (kb_) + krow * KSTR + kch * 16) = (R).k; *(LAS u32x4*)(lds + AT_V + (vb_) + krow * 144 + kch * 16) = (R).v; \
        if constexpr (DQK == 96) { if (tid < 256) *(LAS u32x4*)(lds + AT_K + (kb_) + prow * KSTR + 128 + pch * 16) = (R).p; } } while (0)
#define ATT_ITER(i_, RL, RW) do { const int t = tile_of(i_); const int kb = ((i_) & 1) * AT_KB, vb = ((i_) & 1) * AT_VB; \
        if ((i_) + 2 < ntiles) ATT_LOAD(RL, tile_of((i_) + 2)); \
        if (!skip(t)) { \
            f32x16 s[2]; \
            qk_tile<DQK>(lds + AT_K + kb, qf, s, lane); \
            bf16x8 vf[2][2][2]; v_load(vf, lds + AT_V + vb, lane); \
            unsigned keep = 0xffffffffu; \
            if (mask.full(t)) { const bool on = mask.lane_on(t); softmax_full<LANEOFF>(s, on, c, m, l, o); if constexpr (LANEOFF) keep = on ? 0xffffffffu : 0u; } \
            else softmax_masked(s, t, mask, c, m, l, o, lane); \
            u32x4 pp[4]; pack_p<LANEOFF>(s, keep, pp); pv_packed(pp, vf, o); \
        } \
        if ((i_) + 1 < ntiles) ATT_WRITE(RW, AT_KB - kb, AT_VB - vb); \
        __syncthreads(); } while (0)
    __syncthreads();
    if (ntiles > 0) { ATT_LOAD(RA, tile_of(0)); ATT_WRITE(RA, 0, 0); }
    if (ntiles > 1) ATT_LOAD(RB, tile_of(1));
    __syncthreads();
    for (int i = 0; i < ntiles; i += 2) {
        ATT_ITER(i, RA, RB);
        if (i + 1 < ntiles) ATT_ITER(i + 1, RB, RA);
    }
#undef ATT_LOAD
#undef ATT_WRITE
#undef ATT_ITER
}

struct TileId { DI int operator()(int i) const { return i; } };
struct TileOff { int off; DI int operator()(int i) const { return off + i; } };
struct TileList { const LAS int* lst; DI int operator()(int i) const { return lst[i]; } };
struct NoSkip { DI bool operator()(int) const { return false; } };
struct SkipAbove { int tmax; DI bool operator()(int t) const { return t * 64 > tmax; } };
struct MaskCmp { int tq;
    DI bool operator()(int t, int key) const { return 16 * (64 * t + key) + 31 <= tq; }
    DI bool full(int) const { return false; } DI bool lane_on(int) const { return true; } };
struct MaskSlc { int tq; unsigned lo, hi; int qt;
    DI bool bit(int t) const { return ((t < 32 ? (lo >> t) : (hi >> (t - 32))) & 1u) != 0u; }
    DI bool operator()(int t, int key) const { return bit(t) && (64 * t + key <= tq); }
    DI bool full(int t) const { return t < qt; } DI bool lane_on(int t) const { return bit(t); } };
struct MaskWin { int tq, tq0w;
    DI bool operator()(int t, int key) const { const int d = tq - (64 * t + key); return d >= 0 && d < 512; }
    DI bool full(int t) const { return (64 * t + 63 <= tq0w) && (tq0w + 31 - 64 * t <= 511); } DI bool lane_on(int) const { return true; } };
struct MaskCausal { int tq, tq0w;
    DI bool operator()(int t, int key) const { return 64 * t + key <= tq; }
    DI bool full(int t) const { return 64 * t + 63 <= tq0w; } DI bool lane_on(int) const { return true; } };

struct Bufs {
    const bf16_t *QN, *KS, *KW, *VST, *VWT, *KCMP, *VCMPT, *QM, *KM, *KPE, *VMT; const float* GN; bf16_t* OAB;
};

DI void zero16(f32x16& v) {
#pragma unroll
    for (int i = 0; i < 16; ++i) v[i] = 0.f;
}

DI void nsa_unit(const Bufs& B, LAS unsigned char* lds, int b, int g, int qt) {
    const int tid = my_tid(), lane = tid & 63, w = __builtin_amdgcn_readfirstlane(tid >> 6), r = w >> 1, hh = lane >> 5;
    const int qs = (w & 1) * 32 + (lane & 31), bg = b * 2 + g, tq = qt * 64 + qs, head = g * 4 + r;
    const size_t row = (size_t)b * S + tq;
    LAS unsigned* sImp = (LAS unsigned*)(lds + AT_IMP);
    LAS unsigned* sSel = (LAS unsigned*)(lds + AT_SEL);
    LAS int* sList = (LAS int*)(lds + AT_LIST);
    LAS int* sCnt = (LAS int*)(lds + AT_CNT);
    bf16x8 qf[4];
#pragma unroll
    for (int ks = 0; ks < 4; ++ks) qf[ks] = *(const bf16x8*)(B.QN + row * 512 + head * 64 + ks * 16 + hh * 8);
    for (int i = tid; i < 4096; i += 512) sImp[i] = 0u;
    const float c = 0.125f * LOG2E;
    LAS float* stash = (LAS float*)(lds + AT_ACC + w * 8192) + lane;
    float m, l; f32x16 o[2];
    const int nct = (4 * qt + 2) / 64 + 1;
    m = -1e30f; l = 0.f; zero16(o[0]); zero16(o[1]);
    attn_run<64, false, STAG_CMP>(lds, B.KCMP + (size_t)bg * 256 * 64, nullptr, B.VCMPT + (size_t)bg * 64 * 256, 256, nct, TileId{}, MaskCmp{tq}, NoSkip{}, c, qf, m, l, o);
    const float nmc = -m * c;
    float inv;
    { const float lt = l + __shfl_xor(l, 32); inv = lt > 0.f ? 1.f / lt : 0.f; }
    { const float ig0 = inv * B.GN[row * 24 + head];
#pragma unroll
    for (int dt = 0; dt < 2; ++dt)
#pragma unroll
        for (int e = 0; e < 16; ++e) stash[(dt * 16 + e) * 64] = o[dt][e] * ig0; }
    for (int ct = 0; ct < nct; ++ct) {
        __syncthreads();
        { const int krow = tid >> 3, kch = tid & 7;
          *(LAS u32x4*)(lds + AT_K + krow * 144 + kch * 16) = *(const u32x4*)(B.KCMP + ((size_t)bg * 256 + ct * 64 + krow) * 64 + kch * 8); }
        __syncthreads();
        f32x16 s[2];
        qk_tile<64>(lds + AT_K, qf, s, lane);
#pragma unroll
        for (int kt = 0; kt < 2; ++kt)
#pragma unroll
            for (int a = 0; a < 4; ++a) {
                float pv[4];
#pragma unroll
                for (int bb = 0; bb < 4; ++bb) {
                    const int reg = 4 * a + bb;
                    const int n = 64 * ct + 32 * kt + (reg & 7) + 8 * hh + 16 * (reg >> 3);
                    pv[bb] = (16 * n + 31 <= tq) ? ex2(__builtin_fmaf(s[kt][reg], c, nmc)) * inv : 0.f;
                }
                const int j = 16 * ct + 8 * kt + (a & 1) + 2 * hh + 4 * (a >> 1);
                const float carry = 0.5f * pv[3], direct = (pv[0] + pv[1]) + (pv[2] + carry);
                if (direct > 0.f) __hip_atomic_fetch_add(sImp + qs * 64 + j, (unsigned)(direct * 268435456.f + 0.5f), __ATOMIC_RELAXED, __HIP_MEMORY_SCOPE_WORKGROUP);
                if (carry > 0.f && j < 63) __hip_atomic_fetch_add(sImp + qs * 64 + j + 1, (unsigned)(carry * 268435456.f + 0.5f), __ATOMIC_RELAXED, __HIP_MEMORY_SCOPE_WORKGROUP);
            }
    }
    __syncthreads();
    {
        const int q = tid >> 3, sub = tid & 7;
        unsigned bits = 0;
        if (qt < 16) {
#pragma unroll
            for (int k = 0; k < 8; ++k) if (sub * 8 + k <= qt) bits |= 1u << k;
        } else {
            unsigned v[8]; int cnt[8];
#pragma unroll
            for (int k = 0; k < 8; ++k) { v[k] = sImp[q * 64 + sub * 8 + k]; cnt[k] = 0; }
            for (int jp = 1; jp <= qt - 2; ++jp) {
                const unsigned vp = sImp[q * 64 + jp];
#pragma unroll
                for (int k = 0; k < 8; ++k) cnt[k] += (vp > v[k] || (vp == v[k] && jp < sub * 8 + k)) ? 1 : 0;
            }
#pragma unroll
            for (int k = 0; k < 8; ++k) {
                const int j = sub * 8 + k;
                const bool forced = (j == 0) || (j == qt) || (j == qt - 1), cand = (j >= 1) && (j <= qt - 2);
                if (forced || (cand && cnt[k] < 13)) bits |= 1u << k;
            }
        }
        unsigned lo = sub < 4 ? bits << (sub * 8) : 0u, hi = sub >= 4 ? bits << ((sub - 4) * 8) : 0u;
        lo |= __shfl_xor(lo, 1); hi |= __shfl_xor(hi, 1); lo |= __shfl_xor(lo, 2); hi |= __shfl_xor(hi, 2); lo |= __shfl_xor(lo, 4); hi |= __shfl_xor(hi, 4);
        if (sub == 0) { sSel[q * 2] = lo; sSel[q * 2 + 1] = hi; }
    }
    __syncthreads();
    if (w == 0) {
        unsigned lo = sSel[lane * 2], hi = sSel[lane * 2 + 1];
#pragma unroll
        for (int x = 1; x < 64; x <<= 1) { lo |= __shfl_xor(lo, x); hi |= __shfl_xor(hi, x); }
        if (lane == 0) {
            int n = 0;
            for (int j = 0; j <= qt; ++j) { const unsigned bit = j < 32 ? (lo >> j) : (hi >> (j - 32)); if (bit & 1u) sList[n++] = j; }
            *sCnt = n;
        }
    }
    __syncthreads();
    {
        const int nsel = *sCnt;
        const unsigned lo = sSel[qs * 2], hi = sSel[qs * 2 + 1];
        m = -1e30f; l = 0.f; zero16(o[0]); zero16(o[1]);
        attn_run<64, true, STAG_SLC>(lds, B.KS + (size_t)bg * S * 64, nullptr, B.VST + (size_t)bg * 64 * S, S, nsel, TileList{sList}, MaskSlc{tq, lo, hi, qt}, NoSkip{}, c, qf, m, l, o);
        const float lt = l + __shfl_xor(l, 32); const float iv = (lt > 0.f ? 1.f / lt : 0.f) * B.GN[row * 24 + 8 + head];
#pragma unroll
        for (int dt = 0; dt < 2; ++dt)
#pragma unroll
            for (int e = 0; e < 16; ++e) stash[(dt * 16 + e) * 64] += o[dt][e] * iv;
    }
    {
        const int t0 = qt >= 8 ? qt - 8 : 0;
        m = -1e30f; l = 0.f; zero16(o[0]); zero16(o[1]);
        attn_run<64, false, STAG_WIN>(lds, B.KW + (size_t)bg * S * 64, nullptr, B.VWT + (size_t)bg * 64 * S, S, qt - t0 + 1, TileOff{t0}, MaskWin{tq, qt * 64 + (w & 1) * 32}, NoSkip{}, c, qf, m, l, o);
        const float lt = l + __shfl_xor(l, 32); const float iv = (lt > 0.f ? 1.f / lt : 0.f) * B.GN[row * 24 + 16 + head];
#pragma unroll
        for (int dt = 0; dt < 2; ++dt)
#pragma unroll
            for (int e = 0; e < 16; ++e) o[dt][e] = stash[(dt * 16 + e) * 64] + o[dt][e] * iv;
    }
    bf16_t* orow = B.OAB + row * 1024 + head * 64;
#pragma unroll
    for (int dt = 0; dt < 2; ++dt)
#pragma unroll
        for (int a = 0; a < 4; ++a) {
            u32x2 w2 = {pk2(o[dt][4 * a], o[dt][4 * a + 1]), pk2(o[dt][4 * a + 2], o[dt][4 * a + 3])};
            *(u32x2*)(orow + 32 * dt + 8 * a + 4 * hh) = w2;
        }
}

DI void mla_unit(const Bufs& B, LAS unsigned char* lds, int b, int h, int qb) {
    const int tid = my_tid(), lane = tid & 63, w = __builtin_amdgcn_readfirstlane(tid >> 6), hh = lane >> 5;
    const int tq = qb * 256 + w * 32 + (lane & 31);
    const size_t row = (size_t)b * S + tq;
    bf16x8 qf[6];
#pragma unroll
    for (int ks = 0; ks < 6; ++ks) qf[ks] = *(const bf16x8*)(B.QM + row * 768 + h * 96 + ks * 16 + hh * 8);
    const float c = 0.10206207261596575f * LOG2E;
    float m = -1e30f, l = 0.f; f32x16 o[2]; zero16(o[0]); zero16(o[1]);
    attn_run<96, false, STAG_MLA>(lds, B.KM + (size_t)(b * 8 + h) * S * 64, B.KPE + (size_t)b * S * 32, B.VMT + (size_t)(b * 8 + h) * 64 * S, S, 4 * (qb + 1),
                 TileId{}, MaskCausal{tq, qb * 256 + w * 32}, SkipAbove{qb * 256 + w * 32 + 31}, c, qf, m, l, o);
    const float lt = l + __shfl_xor(l, 32); const float iv = lt > 0.f ? 1.f / lt : 0.f;
    bf16_t* orow = B.OAB + row * 1024 + 512 + h * 64;
#pragma unroll
    for (int dt = 0; dt < 2; ++dt)
#pragma unroll
        for (int a = 0; a < 4; ++a) {
            u32x2 w2 = {pk2(o[dt][4 * a] * iv, o[dt][4 * a + 1] * iv), pk2(o[dt][4 * a + 2] * iv, o[dt][4 * a + 3] * iv)};
            *(u32x2*)(orow + 32 * dt + 8 * a + 4 * hh) = w2;
        }
}

DI void attn_phase(const Bufs& B, LAS unsigned char* lds, unsigned* counter) {
    LAS int* sUnit = (LAS int*)(lds + MISC_OFF); int it_ = 0; (void)sUnit; (void)it_; (void)counter;
    for (;;) {
#if ATT_STATIC
        __syncthreads();
        const int u = (int)blockIdx.x + 256 * it_; ++it_;
        if (u >= 2048) break;
#else
        __syncthreads();
        if (threadIdx.x == 0) *sUnit = (int)atomicAdd(counter, 1u);
        __syncthreads();
        const int u = *sUnit;
        if (u >= 2048) break;
#endif
        const int i = u >> 1;
        if ((u & 1) == 0) {
#if EXP_ATT == 2
            { const int b = (i & 63) >> 3, h = i & 7, qb = 15 - (i >> 6);
              for (int e = threadIdx.x; e < 2048; e += 512) *(u32x4*)(B.OAB + ((size_t)b * S + qb * 256 + (e >> 3)) * 1024 + 512 + h * 64 + (e & 7) * 8) = (u32x4){0x3c003c00u, 0x3c003c00u, 0x3c003c00u, 0x3c003c00u}; }
#else
            mla_unit(B, lds, (i & 63) >> 3, i & 7, 15 - (i >> 6));
#if ATT_DUP == 1
            __syncthreads(); mla_unit(B, lds, (i & 63) >> 3, i & 7, 15 - (i >> 6));
#endif
#endif
        } else {
#if EXP_ATT == 1
            { const int b = (i & 15) >> 1, g = i & 1, qt = 63 - (i >> 4);
              for (int e = threadIdx.x; e < 2048; e += 512) *(u32x4*)(B.OAB + ((size_t)b * S + qt * 64 + (e >> 5)) * 1024 + g * 256 + (e & 31) * 8) = (u32x4){0x3c003c00u, 0x3c003c00u, 0x3c003c00u, 0x3c003c00u}; }
#else
            nsa_unit(B, lds, (i & 15) >> 1, i & 1, 63 - (i >> 4));
#if ATT_DUP == 2
            __syncthreads(); nsa_unit(B, lds, (i & 15) >> 1, i & 1, 63 - (i >> 4));
#endif
#endif
        }
    }
}

DI float wave_sum(float v) {
#pragma unroll
    for (int o = 1; o < 64; o <<= 1) v += __shfl_xor(v, o);
    return v;
}
DI void norm_rows_bf16(const float* x, const float* g, bf16_t* xn) {
    const int tid_ = my_tid(), lane = tid_ & 63, gw = blockIdx.x * 8 + (tid_ >> 6), ngw = gridDim.x * 8;
    f32x4 gv[4];
#pragma unroll
    for (int j = 0; j < 4; ++j) gv[j] = ((const f32x4*)g)[lane + 64 * j];
    for (int r = gw; r < M; r += ngw) {
        const f32x4* xr = (const f32x4*)(x + (size_t)r * D) + lane;
        f32x4 v[4]; float s = 0.f;
#pragma unroll
        for (int j = 0; j < 4; ++j) { v[j] = xr[64 * j]; s += (v[j][0] * v[j][0] + v[j][1] * v[j][1]) + (v[j][2] * v[j][2] + v[j][3] * v[j][3]); }
        const float rstd = rsqrtf(wave_sum(s) * (1.f / D) + EPS);
        u32x2* o8 = (u32x2*)(xn + (size_t)r * D) + lane;
#pragma unroll
        for (int j = 0; j < 4; ++j) o8[64 * j] = (u32x2){pk2(v[j][0] * rstd * gv[j][0], v[j][1] * rstd * gv[j][1]), pk2(v[j][2] * rstd * gv[j][2], v[j][3] * rstd * gv[j][3])};
    }
}
DI void norm_rows_f32_inplace(float* x, const float* g) {
    const int tid_ = my_tid(), lane = tid_ & 63, gw = blockIdx.x * 8 + (tid_ >> 6), ngw = gridDim.x * 8;
    f32x4 gv[4];
#pragma unroll
    for (int j = 0; j < 4; ++j) gv[j] = ((const f32x4*)g)[lane + 64 * j];
    for (int r = gw; r < M; r += ngw) {
        f32x4* xr = (f32x4*)(x + (size_t)r * D) + lane;
        f32x4 v[4]; float s = 0.f;
#pragma unroll
        for (int j = 0; j < 4; ++j) { v[j] = xr[64 * j]; s += (v[j][0] * v[j][0] + v[j][1] * v[j][1]) + (v[j][2] * v[j][2] + v[j][3] * v[j][3]); }
        const float rstd = rsqrtf(wave_sum(s) * (1.f / D) + EPS);
#pragma unroll
        for (int j = 0; j < 4; ++j) xr[64 * j] = (f32x4){v[j][0] * rstd * gv[j][0], v[j][1] * rstd * gv[j][1], v[j][2] * rstd * gv[j][2], v[j][3] * rstd * gv[j][3]};
    }
}

DI int perm64(int p) { return (p >> 1) + 32 * (p & 1); }
DI int perm32r(int p) { return (p >> 1) + 16 * (p & 1); }
DI int map_in(int c) {
    if (c < 512) return (c & ~63) + perm64(c & 63);
    if (c < 1280) { const int t = (c - 512) >> 8, cc = (c - 512) & 255, kv = cc >> 7, g = (cc >> 6) & 1, p = cc & 63; return 512 + t * 256 + kv * 128 + g * 64 + (kv == 0 ? perm64(p) : p); }
    if (c < 1536) return 1304 + (c - 1280);
    if (c < 1792) { const int cc = c - 1536; if (cc < 128) return 1560 + cc; if (cc < 160) return 1688 + perm32r(cc - 128); if (cc < 184) return 1280 + (cc - 160); return -1; }
    if (c < 2816) return 1720 + (c - 1792);
    return 2744 + (c - 2816);
}
struct Wts {
    const float *w_in, *cmp_pe, *cmp_w1, *cmp_w2, *nsa_w_o, *q_norm, *kv_norm, *w_uq, *w_ukv, *mla_w_o, *w_out, *w_up, *w_down;
};
template <int JOB> DI float prep_get(const Wts& W, int n, int k) {
    if constexpr (JOB == 0) { const int c = map_in(n); return c >= 0 ? W.w_in[(size_t)k * IN_COLS + c] : 0.f; }
    if constexpr (JOB == 1) { const int j = n >> 8, h = n & 255, lp = k >> 6, p = k & 63, d = j == 0 ? perm64(p) : p; return W.cmp_w1[((size_t)j * 2048 + lp * 64 + d) * 256 + h]; }
    if constexpr (JOB == 2) { const int j = n >> 8, np = n & 255; return np < 64 ? W.cmp_w2[((size_t)j * 256 + k) * 64 + (j == 0 ? perm64(np) : np)] : 0.f; }
    if constexpr (JOB == 3) { return n < 1024 ? W.nsa_w_o[(size_t)k * 1024 + n] : W.mla_w_o[(size_t)k * 1024 + (n - 1024)]; }
    if constexpr (JOB == 4) { const int hh = n / 96, c = n - hh * 96; const int sc = c < 64 ? n : hh * 96 + 64 + perm32r(c - 64); return W.q_norm[k] * W.w_uq[(size_t)k * 768 + sc]; }
    if constexpr (JOB == 5) { return k < 128 ? W.kv_norm[k] * W.w_ukv[(size_t)k * 1024 + n] : 0.f; }
    if constexpr (JOB == 6) { return W.w_out[(size_t)k * 1024 + n]; }
    if constexpr (JOB == 7) { return W.w_up[(size_t)k * 4096 + n]; }
    if constexpr (JOB == 8) { return W.w_down[(size_t)k * 1024 + n]; }
    return 0.f;
}
template <int JOB> DI void prep_tile(const Wts& W, LAS float* scr, bf16_t* dst, int ldd, int n0, int k0) {
    const int tid = my_tid();
#pragma unroll
    for (int it = 0; it < 8; ++it) { const int kk = it * 8 + (tid >> 6), nn = tid & 63; scr[kk * 65 + nn] = prep_get<JOB>(W, n0 + nn, k0 + kk); }
    __syncthreads();
    { const int n = tid >> 3, kc = tid & 7; const LAS float* s = scr + (kc * 8) * 65 + n;
      u32x4 o = {pk2(s[0], s[65]), pk2(s[130], s[195]), pk2(s[260], s[325]), pk2(s[390], s[455])};
      *(u32x4*)(dst + (size_t)(n0 + n) * ldd + k0 + kc * 8) = o; }
    __syncthreads();
}
DI void prep_tile_vec(const float* src, int ldsrc, LAS float* scr, bf16_t* dst, int ldd, int n0, int k0) {
    const int tid = my_tid();
    f32x4 v[4];
#pragma unroll
    for (int it = 0; it < 4; ++it) v[it] = *(const f32x4*)(src + (size_t)(k0 + it * 32 + (tid >> 4)) * ldsrc + (tid & 15) * 4);
#pragma unroll
    for (int it = 0; it < 4; ++it) { LAS float* d = scr + (it * 32 + (tid >> 4)) * 65 + (tid & 15) * 4; d[0] = v[it][0]; d[1] = v[it][1]; d[2] = v[it][2]; d[3] = v[it][3]; }
    __syncthreads();
    { const int n = tid >> 3, kc = tid & 7;
#pragma unroll
      for (int hh = 0; hh < 2; ++hh) { const LAS float* s = scr + (hh * 64 + kc * 8) * 65 + n;
        u32x4 o = {pk2(s[0], s[65]), pk2(s[130], s[195]), pk2(s[260], s[325]), pk2(s[390], s[455])};
        *(u32x4*)(dst + (size_t)(n0 + n) * ldd + k0 + hh * 64 + kc * 8) = o; } }
    __syncthreads();
}
DI void prep_phase(const Wts& W, unsigned char* ws, LAS unsigned char* lds, int layer) {
    LAS float* scr = (LAS float*)lds;
    const int tid = my_tid();
    constexpr int T0a = 384, T0 = T0a + 288, T1 = T0 + 256, T2 = T1 + 32, T3 = T2 + 128, T4 = T3 + 48, T5 = T4 + 64, T6_ = T5 + 128, T7 = T6_ + 512, T8 = T7 + 512, TB = T8 + 8;
    for (int job = blockIdx.x; job < TB; job += gridDim.x) {
        int r = job;
        if (r < T0a) { const int ix = r >> 4, n0 = (ix < 20 ? ix : ix + 4) * 64;
            prep_tile<0>(W, scr, (bf16_t*)(ws + WS_WIN), 1024, n0, (r & 15) * 64); continue; }
        if (r < T0) { r -= T0a; const int ix = r >> 3, n0 = (ix < 4 ? 20 + ix : 24 + ix) * 64;
            prep_tile_vec(W.w_in + map_in(n0), IN_COLS, scr, (bf16_t*)(ws + WS_WIN), 1024, n0, (r & 7) * 128); continue; }
        if (r < T1) { r -= T0; prep_tile<1>(W, scr, (bf16_t*)(ws + WS_W1T), 2048, (r >> 5) * 64, (r & 31) * 64); continue; }
        if (r < T2) { r -= T1; prep_tile<2>(W, scr, (bf16_t*)(ws + WS_W2T), 256, (r >> 2) * 64, (r & 3) * 64); continue; }
        if (r < T3) { r -= T2; const int n0 = (r >> 2) * 64, k0 = (r & 3) * 128;
            prep_tile_vec(n0 < 1024 ? W.nsa_w_o + n0 : W.mla_w_o + (n0 - 1024), 1024, scr, (bf16_t*)(ws + WS_WOAB), 512, n0, k0); continue; }
        if (r < T4) { r -= T3; prep_tile<4>(W, scr, (bf16_t*)(ws + WS_WUQ), 256, (r >> 2) * 64, (r & 3) * 64); continue; }
        if (r < T5) { r -= T4; prep_tile<5>(W, scr, (bf16_t*)(ws + WS_WUKV), 256, (r >> 2) * 64, (r & 3) * 64); continue; }
        if (r < T6_) { r -= T5; const int n0 = (r >> 3) * 64; prep_tile_vec(W.w_out + n0, 1024, scr, (bf16_t*)(ws + WS_WOUT), 1024, n0, (r & 7) * 128); continue; }
        if (r < T7) { r -= T6_; const int n0 = (r >> 3) * 64; prep_tile_vec(W.w_up + n0, 4096, scr, (bf16_t*)(ws + WS_WUP), 1024, n0, (r & 7) * 128); continue; }
        if (r < T8) { r -= T7; const int n0 = (r >> 5) * 64; prep_tile_vec(W.w_down + n0, 1024, scr, (bf16_t*)(ws + WS_WDN), 4096, n0, (r & 31) * 128); continue; }
        {
            r -= T8; const int j = r >> 2, hc = r & 3, kk = tid >> 4, h4 = (tid & 15) * 4;
            const float* pe = W.cmp_pe + j * 2048; const float* w1 = W.cmp_w1 + (size_t)j * 2048 * 256 + hc * 64 + h4;
            f32x4 a = {0.f, 0.f, 0.f, 0.f};
#pragma unroll 8
            for (int i = 0; i < 64; ++i) { const int k = kk + 32 * i; const f32x4 wv = *(const f32x4*)(w1 + (size_t)k * 256); a += wv * pe[k]; }
            LAS float* d = scr + kk * 64 + h4; d[0] = a[0]; d[1] = a[1]; d[2] = a[2]; d[3] = a[3];
            __syncthreads();
            if (tid < 64) { float sm = 0.f; for (int q = 0; q < 32; ++q) sm += scr[q * 64 + tid]; ((float*)(ws + WS_CB1))[j * 256 + hc * 64 + tid] = sm; }
            __syncthreads();
        }
    }
    if (layer == 0) {
        f32x2* cs64 = (f32x2*)(ws + WS_CS64); f32x2* cs32 = (f32x2*)(ws + WS_CS32);
        for (int idx = blockIdx.x * 512 + tid; idx < S * 48; idx += gridDim.x * 512) {
            int pos, i; float inv;
            if (idx < S * 32) { pos = idx >> 5; i = idx & 31; inv = (float)exp2(-(double)i * (13.287712379549449 / 32.0)); }
            else { const int e = idx - S * 32; pos = e >> 4; i = e & 15; inv = (float)exp2(-(double)i * (13.287712379549449 / 16.0)); }
            const float ang = (float)pos * inv;
            const double rev = (double)ang * 0.15915494309189535; const float fr = (float)(rev - floor(rev));
            const f32x2 v = {__builtin_amdgcn_cosf(fr), __builtin_amdgcn_sinf(fr)};
            if (idx < S * 32) cs64[idx] = v; else cs32[idx - S * 32] = v;
        }
    }
}

struct Params { const float* in[17]; float* out; unsigned char* ws; int ph_lo, ph_hi; };
typedef const __attribute__((address_space(4))) unsigned char* kaptr_t;
DI const float* karg_ptr(int byte_off) { kaptr_t ka = (kaptr_t)__builtin_amdgcn_kernarg_segment_ptr(); asm volatile("" : "+s"(ka)); return *(const float* const __attribute__((address_space(4)))*)(ka + byte_off); }
#define KIN(i) karg_ptr(8 * (i))

DI void grid_barrier_cg(cg::grid_group& grid) {
    asm volatile("s_waitcnt vmcnt(0) lgkmcnt(0)" ::: "memory");
    __syncthreads();
    if (threadIdx.x < 64) asm volatile("buffer_wbl2 sc1\n\ts_waitcnt vmcnt(0)" ::: "memory");
    __syncthreads();
    grid.sync();
    asm volatile("buffer_inv sc1\n\ts_waitcnt vmcnt(0)" ::: "memory");
}

#define XB_TMO      128
#define XB_XCNT(j)  (256  + 64 * (j))
#define XB_XSUB(j)  (1280 + 64 * (j))
#define XB_XGEN(j)  (2304 + 64 * (j))
#define XB_TOP      3328
#define XB_TOPGEN   3392
#define XCD_BAR_WORDS 3456
#define XB_SPIN_CAP (1u << 18)
DI unsigned xb_ld(unsigned* p)              { return __hip_atomic_load(p, __ATOMIC_RELAXED, __HIP_MEMORY_SCOPE_AGENT); }
DI unsigned xb_add(unsigned* p, unsigned v) { return __hip_atomic_fetch_add(p, v, __ATOMIC_RELAXED, __HIP_MEMORY_SCOPE_AGENT); }
DI unsigned xb_xcc_id() { return (unsigned)__builtin_amdgcn_s_getreg((3 << 11) | 20) & 0xFu; }
#define XB_SPIN(cond, bar) do { unsigned _sp = 0; while (cond) { __builtin_amdgcn_s_sleep(1); \
    if ((++_sp & 255u) == 0u) { if (xb_ld(&(bar)[XB_TMO])) break; if (_sp > XB_SPIN_CAP) { atomicAdd(&(bar)[XB_TMO], 1u); break; } } } } while (0)
DI void xcd_barrier_complete(unsigned* bar, unsigned x, unsigned& nloc, unsigned& nx) {
    const unsigned G = gridDim.x * gridDim.y * gridDim.z;
    unsigned sum, cnt, mine, sp = 0u;
    for (;;) {
        sum = 0u; cnt = 0u; mine = 0u;
#pragma unroll
        for (unsigned j = 0; j < 16; ++j) { const unsigned c = xb_ld(&bar[XB_XCNT(j)]); sum += c; cnt += (c > 0u) ? 1u : 0u; mine = (j == x) ? c : mine; }
        if (sum == G) break;
        __builtin_amdgcn_s_sleep(1);
        if ((++sp & 255u) == 0u) { if (xb_ld(&bar[XB_TMO])) break; if (sp > XB_SPIN_CAP) { atomicAdd(&bar[XB_TMO], 1u); break; } }
    }
    nloc = mine > 0u ? mine : 1u; nx = cnt > 0u ? cnt : 1u;
}
DI void xcd_barrier(unsigned* bar, volatile LAS unsigned* st) {
    asm volatile("s_waitcnt vmcnt(0)" ::: "memory");
    __syncthreads();
    if (threadIdx.x == 0) {
        const unsigned x = xb_xcc_id();
        __builtin_amdgcn_s_waitcnt(0);
        unsigned nloc = st[0], nx = st[1];
        if (nloc == 0u) { xcd_barrier_complete(bar, x, nloc, nx); st[0] = nloc; st[1] = nx; }
        const unsigned old = xb_add(&bar[XB_XSUB(x)], 1u);
        const unsigned gen = old / nloc;
        if (old + 1u == (gen + 1u) * nloc) {
            __builtin_amdgcn_fence(__ATOMIC_RELEASE, "agent");
            asm volatile("s_waitcnt vmcnt(0)" ::: "memory");
            const unsigned og = xb_add(&bar[XB_TOP], 1u);
            const unsigned tg = og / nx;
            if (og + 1u == (tg + 1u) * nx) xb_add(&bar[XB_TOPGEN], 1u);
            else XB_SPIN(xb_ld(&bar[XB_TOPGEN]) == tg, bar);
            __builtin_amdgcn_fence(__ATOMIC_ACQUIRE, "agent");
            xb_add(&bar[XB_XGEN(x)], 1u);
            asm volatile("s_waitcnt vmcnt(0)" ::: "memory");
        } else {
            XB_SPIN(xb_ld(&bar[XB_XGEN(x)]) == gen, bar);
            __builtin_amdgcn_fence(__ATOMIC_ACQUIRE, "agent");
            asm volatile("s_waitcnt vmcnt(0)" ::: "memory");
        }
    }
    __syncthreads();
}
template <bool FIRST> DI void grid_barrier(cg::grid_group& grid, LAS unsigned char* lds) {
    unsigned* bar = (unsigned*)((unsigned char*)karg_ptr(144) + WS_BAR);
    if constexpr (FIRST) {
        grid_barrier_cg(grid);
        if (threadIdx.x == 0) (void)xb_add(&bar[XB_XCNT(xb_xcc_id())], 1u);
    } else {
        xcd_barrier(bar, (volatile LAS unsigned*)(lds + MISC_OFF + 64));
    }
}

#define PH_IN(k) (lo <= (k) && (k) < hi)
#define PH_SEAM(k) do { if (PH_IN(k) && PH_IN((k) + 1)) grid_barrier<(k) == 0>(grid, lds); } while (0)
#define PH_ENV() int G = gridDim.x, bx = blockIdx.x; asm volatile("" : "+s"(G), "+s"(bx)); unsigned char* ws = (unsigned char*)karg_ptr(144); float* X = (float*)karg_ptr(136); \
                 const int tid = my_tid(); bf16_t* XN = (bf16_t*)(ws + WS_XN); (void)tid; (void)X; (void)XN; (void)G; (void)bx

template <int L> DI void run_layer(LAS unsigned char* lds, cg::grid_group& grid, int lo, int hi) {
    constexpr int P0 = 10 * L;
    if (PH_IN(P0 + 0)) for (int rep_ = 0; rep_ < ((((DUP_MASK >> 0) & 1) && L > 0) ? 2 : 1); ++rep_) { if (rep_) grid_barrier<false>(grid, lds);
        PH_ENV();
        Wts W;
        W.w_in = KIN(2) + (size_t)L * 1024 * IN_COLS; W.cmp_pe = KIN(3) + (size_t)L * 2 * 2048; W.cmp_w1 = KIN(4) + (size_t)L * 2 * 2048 * 256;
        W.cmp_w2 = KIN(5) + (size_t)L * 2 * 256 * 64; W.nsa_w_o = KIN(6) + (size_t)L * 512 * 1024; W.q_norm = KIN(7) + L * 256; W.kv_norm = KIN(8) + L * 128;
        W.w_uq = KIN(9) + (size_t)L * 256 * 768; W.w_ukv = KIN(10) + (size_t)L * 128 * 1024; W.mla_w_o = KIN(11) + (size_t)L * 512 * 1024;
        W.w_out = KIN(12) + (size_t)L * 1024 * 1024; W.w_up = KIN(14) + (size_t)L * 1024 * 4096; W.w_down = KIN(15) + (size_t)L * 4096 * 1024;
        prep_phase(W, ws, lds, L);
        unsigned* ctl = (unsigned*)(ws + WS_CTL);
        if (L == 0 && bx == 0 && tid < 2 * NL) atomicExch(ctl + tid * 64, 0u);
        norm_rows_bf16(L == 0 ? KIN(0) : X, KIN(1) + L * D, XN);
    }
    PH_SEAM(P0 + 0);
    if (PH_IN(P0 + 1)) for (int rep_ = 0; rep_ < (((DUP_MASK >> 1) & 1) ? 2 : 1); ++rep_) { if (rep_) grid_barrier<false>(grid, lds);
        PH_ENV();
        pg8::Gemm g{XN, (const bf16_t*)(ws + WS_WIN), 1024, 1024}; pg8::StaticOrder So; So.init(M, NIN, G, bx);
        EpiWrap<EpiInImpl> E; E.ws = ws;
        pg8::gemm_phase(lds, g, So, E);
    }
    PH_SEAM(P0 + 1);
    if (PH_IN(P0 + 2)) for (int rep_ = 0; rep_ < (((DUP_MASK >> 2) & 1) ? 2 : 1); ++rep_) { if (rep_) grid_barrier<false>(grid, lds);
        PH_ENV();
        if (bx < 32) {
            pg8::CmpOrder So{G, bx};
            { pg8::Gemm g{(const bf16_t*)(ws + WS_KCV), (const bf16_t*)(ws + WS_W1T), 1024, 2048}; EpiWrap<EpiC1Impl> E; E.ws = ws; pg8::gemm_phase(lds, g, So, E); }
            { pg8::Gemm g{(const bf16_t*)(ws + WS_HC), (const bf16_t*)(ws + WS_W2T), 256, 256}; EpiWrap<EpiC2Impl> E; E.ws = ws; pg8::gemm_phase(lds, g, So, E); }
        } else {
            { pg8::Gemm g{(const bf16_t*)(ws + WS_CQ), (const bf16_t*)(ws + WS_WUQ), 256, 256}; pg8::StaticOrder So; So.init(M, 768, G - 32, bx - 32);
              EpiWrap<EpiUQImpl> E; E.ws = ws;
              pg8::gemm_phase(lds, g, So, E); }
            { pg8::Gemm g{(const bf16_t*)(ws + WS_T6), (const bf16_t*)(ws + WS_WUKV), 256, 256}; pg8::StaticOrder So; So.init(M, 1024, G - 32, bx - 32);
              EpiWrap<EpiUKVImpl> E; E.ws = ws;
              pg8::gemm_phase(lds, g, So, E); }
        }
    }
    PH_SEAM(P0 + 2);
    if (PH_IN(P0 + 4)) for (int rep_ = 0; rep_ < (((DUP_MASK >> 4) & 1) ? 2 : 1); ++rep_) { if (rep_) grid_barrier<false>(grid, lds);
        PH_ENV();
        Bufs B; B.QN = (const bf16_t*)(ws + WS_QN); B.KS = (const bf16_t*)(ws + WS_KS); B.KW = (const bf16_t*)(ws + WS_KW); B.VST = (const bf16_t*)(ws + WS_VST);
        B.VWT = (const bf16_t*)(ws + WS_VWT); B.KCMP = (const bf16_t*)(ws + WS_KCMP); B.VCMPT = (const bf16_t*)(ws + WS_VCMPT); B.QM = (const bf16_t*)(ws + WS_QM);
        B.KM = (const bf16_t*)(ws + WS_KM); B.KPE = (const bf16_t*)(ws + WS_KPE); B.VMT = (const bf16_t*)(ws + WS_VMT); B.GN = (const float*)(ws + WS_GN); B.OAB = XN;
#if EXP_NOATTN
        { u32x4* o = (u32x4*)XN; for (size_t i = (size_t)bx * 512 + tid; i < (size_t)M * 1024 / 8; i += (size_t)G * 512) o[i] = (u32x4){0x3c003c00u, 0x3c003c00u, 0x3c003c00u, 0x3c003c00u}; (void)B; }
#else
        attn_phase(B, lds, (unsigned*)(ws + WS_CTL) + (L * 2 + rep_) * 64);
#endif
    }
    PH_SEAM(P0 + 4);
    if (PH_IN(P0 + 5)) for (int rep_ = 0; rep_ < (((DUP_MASK >> 5) & 1) ? 2 : 1); ++rep_) { if (rep_) grid_barrier<false>(grid, lds);
        PH_ENV();
        pg8::StaticOrder So; So.init(M, 1024, G, bx);
        { pg8::Gemm g{XN, (const bf16_t*)(ws + WS_WOAB), 1024, 512}; EpiWrap<EpiD1aImpl> E; E.ws = ws; pg8::gemm_phase(lds, g, So, E); }
        { pg8::Gemm g{XN + 512, (const bf16_t*)(ws + WS_WOAB) + 1024 * 512, 1024, 512}; EpiWrap<EpiD1bImpl> E; E.ws = ws; pg8::gemm_phase(lds, g, So, E); }
    }
    PH_SEAM(P0 + 5);
    if (PH_IN(P0 + 6)) for (int rep_ = 0; rep_ < (((DUP_MASK >> 6) & 1) ? 2 : 1); ++rep_) { if (rep_) grid_barrier<false>(grid, lds);
        PH_ENV();
        pg8::Gemm g{(const bf16_t*)(ws + WS_MG), (const bf16_t*)(ws + WS_WOUT), 1024, 1024}; pg8::StaticOrder So; So.init(M, 1024, G, bx);
        EpiWrap<EpiD2Impl> E; E.xin = (L == 0 ? KIN(0) : X); E.X = X;
        pg8::gemm_phase(lds, g, So, E);
    }
    PH_SEAM(P0 + 6);
    if (PH_IN(P0 + 7)) for (int rep_ = 0; rep_ < (((DUP_MASK >> 7) & 1) ? 2 : 1); ++rep_) { if (rep_) grid_barrier<false>(grid, lds);
        PH_ENV();
        norm_rows_bf16(X, KIN(13) + L * D, XN);
    }
    PH_SEAM(P0 + 7);
    if (PH_IN(P0 + 8)) for (int rep_ = 0; rep_ < (((DUP_MASK >> 8) & 1) ? 2 : 1); ++rep_) { if (rep_) grid_barrier<false>(grid, lds);
        PH_ENV();
        pg8::Gemm g{XN, (const bf16_t*)(ws + WS_WUP), 1024, 1024}; pg8::StaticOrder So; So.init(M, FF, G, bx);
        EpiWrap<EpiUpImpl> E; E.ws = ws;
        pg8::gemm_phase(lds, g, So, E);
    }
    PH_SEAM(P0 + 8);
    if (PH_IN(P0 + 9)) for (int rep_ = 0; rep_ < (((DUP_MASK >> 9) & 1) ? 2 : 1); ++rep_) { if (rep_) grid_barrier<false>(grid, lds);
        PH_ENV();
        pg8::Gemm g{(const bf16_t*)(ws + WS_HF), (const bf16_t*)(ws + WS_WDN), 4096, 4096}; pg8::StaticOrder So; So.init(M, 1024, G, bx);
        EpiWrap<EpiD2Impl> E; E.xin = X; E.X = X;
        pg8::gemm_phase(lds, g, So, E);
    }
    PH_SEAM(P0 + 9);
}

__global__ void __launch_bounds__(512, 2) mega(Params P) {
    extern __shared__ __attribute__((aligned(16))) unsigned char lds_raw[];
    LAS unsigned char* lds = (LAS unsigned char*)lds_raw;
    cg::grid_group grid = cg::this_grid();
    const int lo = P.ph_lo, hi = P.ph_hi;
    if (threadIdx.x < 2) ((volatile LAS unsigned*)(lds + MISC_OFF + 64))[threadIdx.x] = 0u;
    if (blockIdx.x == 0 && hi - lo > 1) { unsigned* bar = (unsigned*)((unsigned char*)karg_ptr(144) + WS_BAR);
        for (int i = threadIdx.x; i < XCD_BAR_WORDS; i += 512) __hip_atomic_store(bar + i, 0u, __ATOMIC_RELAXED, __HIP_MEMORY_SCOPE_AGENT); }
    __syncthreads();
    run_layer<0>(lds, grid, lo, hi);
    run_layer<1>(lds, grid, lo, hi);
    run_layer<2>(lds, grid, lo, hi);
    run_layer<3>(lds, grid, lo, hi);
    if (PH_IN(39) && PH_IN(40)) {   }
    if (PH_IN(40)) { float* X = (float*)karg_ptr(136); norm_rows_f32_inplace(X, KIN(16)); }
}

extern "C" void kernel_launch(void* const* d_in, const int* in_sizes, int n_in, void* d_out, int out_size, void* d_ws, size_t ws_size, hipStream_t stream) {
    static int grid = 0;
    if (grid == 0) {
        if (n_in != 17 || out_size != M * D || ws_size < WS_END) { fprintf(stderr, "kernel_launch: unexpected shapes (n_in %d out %d ws %zu)\n", n_in, out_size, ws_size); grid = -1; return; }
        int dev = 0, cus = 0, per_cu = 0;
        hipGetDevice(&dev);
        hipDeviceGetAttribute(&cus, hipDeviceAttributeMultiprocessorCount, dev);
        if (hipFuncSetAttribute((const void*)mega, hipFuncAttributeMaxDynamicSharedMemorySize, LDS_BYTES) != hipSuccess) { fprintf(stderr, "kernel_launch: hipFuncSetAttribute failed\n"); grid = -1; return; }
        if (hipOccupancyMaxActiveBlocksPerMultiprocessor(&per_cu, (const void*)mega, 512, LDS_BYTES) != hipSuccess || per_cu < 1) { fprintf(stderr, "kernel_launch: occupancy query gave %d\n", per_cu); per_cu = 1; }
        (void)hipGetLastError();
        grid = cus * per_cu;
        if (grid < 64) { fprintf(stderr, "kernel_launch: grid %d too small for the phase program\n", grid); grid = -1; return; }
    }
    if (grid < 0) return;
    Params p{};
    for (int i = 0; i < 17; ++i) p.in[i] = (const float*)d_in[i];
    p.out = (float*)d_out; p.ws = (unsigned char*)d_ws;
#if MK_MULTI
    for (int ph = 0; ph <= 40; ++ph) {
        p.ph_lo = ph; p.ph_hi = ph + 1;
        hipLaunchKernelGGL(mega, dim3(grid), dim3(512), LDS_BYTES, stream, p);
    }
#else
    p.ph_lo = 0; p.ph_hi = 41;
    void* args[] = {&p};
    hipError_t e = hipLaunchCooperativeKernel((const void*)mega, dim3(grid), dim3(512), args, LDS_BYTES, stream);
    if (e != hipSuccess) fprintf(stderr, "kernel_launch: cooperative launch failed: %s (grid %d)\n", hipGetErrorString(e), grid);
#endif
}
```

```cpp
#include <hip/hip_runtime.h>
#include <hip/hip_cooperative_groups.h>
#include <cstdio>
#include <cstdint>
namespace cg = cooperative_groups;

#ifndef EXP_NOATTN
#define EXP_NOATTN 0
#endif
#ifndef ATT_STATIC
#define ATT_STATIC 0
#endif
#ifndef EXP_ATT
#define EXP_ATT 0
#endif
#ifndef DUP_MASK
#define DUP_MASK 0
#endif
#ifndef ATT_DUP
#define ATT_DUP 0
#endif
#ifndef STAG_CMP
#define STAG_CMP false
#define STAG_SLC false
#define STAG_WIN true
#define STAG_MLA true
#endif
#ifndef MK_MULTI
#define MK_MULTI 0
#endif

#define LAS __attribute__((address_space(3)))
#define DI __device__ __forceinline__
typedef unsigned short bf16_t;
typedef short bf16x8 __attribute__((ext_vector_type(8)));
typedef float f32x4 __attribute__((ext_vector_type(4)));
typedef float f32x2 __attribute__((ext_vector_type(2)));
typedef float f32x16 __attribute__((ext_vector_type(16)));
typedef unsigned u32x4 __attribute__((ext_vector_type(4)));
typedef unsigned u32x2 __attribute__((ext_vector_type(2)));
typedef __bf16 bf16v2 __attribute__((ext_vector_type(2)));

DI unsigned pk2(float lo, float hi) { f32x2 v = {lo, hi}; return __builtin_bit_cast(unsigned, __builtin_convertvector(v, bf16v2)); }
DI bf16_t f2bf(float x) { return (bf16_t)(pk2(x, 0.f) & 0xffffu); }
DI float bflo(unsigned w) { return __uint_as_float(w << 16); }
DI float bfhi(unsigned w) { return __uint_as_float(w & 0xffff0000u); }
DI float sigmoidf_(float x) { return 1.f / (1.f + __expf(-x)); }
DI float ex2(float x) { return __builtin_amdgcn_exp2f(x); }
DI int my_tid() { int t = threadIdx.x; asm volatile("" : "+v"(t)); return t; }

constexpr int NB = 8, S = 4096, D = 1024, NL = 4, M = NB * S, FF = 4096;
constexpr int NIN = 3840;
constexpr int IN_COLS = 3768;
constexpr float EPS = 1e-6f;
constexpr float LOG2E = 1.4426950408889634f;

constexpr size_t MiB = 1u << 20;
constexpr size_t WS_CTL = 0;
constexpr size_t WS_BAR = 16384;
constexpr size_t WS_CB1 = 4096;
constexpr size_t WS_RSQ = 65536;
constexpr size_t WS_RSKV = 65536 + 131072;
constexpr size_t WS_CS64 = 1 * MiB;
constexpr size_t WS_CS32 = 2 * MiB;
constexpr size_t WS_WIN = 3 * MiB;
constexpr size_t WS_W1T = WS_WIN + (size_t)NIN * 1024 * 2;
constexpr size_t WS_W2T = WS_W1T + 2 * MiB;
constexpr size_t WS_WOAB = WS_W2T + 256 * 1024;
constexpr size_t WS_WUQ = WS_WOAB + 2 * MiB;
constexpr size_t WS_WUKV = WS_WUQ + 384 * 1024;
constexpr size_t WS_WOUT = 16 * MiB;
constexpr size_t WS_WUP = 18 * MiB;
constexpr size_t WS_WDN = 26 * MiB;
constexpr size_t WS_XN = 34 * MiB;
constexpr size_t WS_GA = 98 * MiB;
constexpr size_t WS_GB = 162 * MiB;
constexpr size_t WS_QN = 226 * MiB;
constexpr size_t WS_KCV = 258 * MiB;
constexpr size_t WS_KS = 274 * MiB, WS_KW = 282 * MiB, WS_VST = 290 * MiB, WS_VWT = 298 * MiB;
constexpr size_t WS_CQ = 306 * MiB, WS_T6 = 322 * MiB, WS_KPE = 338 * MiB, WS_GN = 340 * MiB;
constexpr size_t WS_QM = 343 * MiB, WS_KM = 391 * MiB, WS_VMT = 423 * MiB, WS_HC = 455 * MiB;
constexpr size_t WS_KCMP = 459 * MiB, WS_VCMPT = WS_KCMP + 512 * 1024;
constexpr size_t WS_MG = 226 * MiB;
constexpr size_t WS_HF = 98 * MiB;
constexpr size_t WS_PQ = 460 * MiB;
constexpr size_t WS_PKV = 461 * MiB;
constexpr size_t WS_END = 462 * MiB;
static_assert(WS_WUKV + 512 * 1024 <= WS_WOUT, "ws map");

constexpr int LDS_BYTES = 147456;
constexpr int MISC_OFF = 147200;
constexpr int AT_K = 0, AT_KB = 13312  , AT_V = 26624, AT_VB = 9216  , AT_IMP = 54272, AT_SEL = 70656, AT_LIST = 71168, AT_CNT = 71424, AT_ACC = 71680;

namespace pg8 {
constexpr int BM = 256, BK = 64, HALF = 128, HTB = HALF * BK * 2, NXCD = 8, WGM = 8;
__host__ __device__ __forceinline__ int lds_byte(int r, int c) { const int st = (r >> 4) * 2 + (c >> 5), rr = r & 15, cc = c & 31, ob = rr * 64 + cc * 2; return st * 1024 + (ob ^ (((ob >> 9) & 1) << 5)); }
__host__ __device__ __forceinline__ void stage_rc(int b, int& R, int& C) { const int st = b / 1024, sb = b % 1024, swz = sb ^ (((sb >> 9) & 1) << 5); R = (st >> 1) * 16 + swz / 64; C = (st & 1) * 32 + (swz % 64) / 2; }
__host__ __device__ __forceinline__ int perm32(int rho) { const int n = rho >> 4, i = rho & 15; return 8 * (i >> 2) + 4 * n + (i & 3); }

struct Unit { int pm, pn; };
struct Gemm { const bf16_t* A; const bf16_t* Bt; int lda; int K; };

struct StaticOrder {
    int nM, nN, nwg, G, c;
    __device__ void init(int M_, int N_, int G_, int c_) { nM = M_ / BM; nN = N_ / BM; nwg = nM * nN; G = G_; c = c_; }
    __device__ bool next(int i, Unit& u) const {
        const long L = (long)i * G + c; if (L >= nwg) return false;
        int wgid = (int)L; { const int q = nwg / NXCD, r = nwg % NXCD, xcd = wgid % NXCD, off = wgid / NXCD; wgid = (xcd < r ? xcd * (q + 1) : r * (q + 1) + (xcd - r) * q) + off; }
        const int nig = WGM * nN, gid = wgid / nig, fm = gid * WGM, gsz = (nM - fm) < WGM ? (nM - fm) : WGM;
        u.pm = fm + ((wgid % nig) % gsz); u.pn = (wgid % nig) / gsz; return true;
    }
};
struct CmpOrder {
    int G, c;
    __device__ bool next(int i, Unit& u) const { const int L = i * G + c; if (L >= 32) return false; u.pm = L; u.pn = L >> 4; return true; }
};

template <class Epi, class Sched>
__device__ __forceinline__ void gemm_phase(LAS unsigned char* lds, const Gemm g, const Sched& S, const Epi& E) {
    const int tid = my_tid(), wid = __builtin_amdgcn_readfirstlane(tid >> 6), lane = tid & 63, wr = wid >> 2, wc = wid & 3, fr = lane & 15, fq = lane >> 4;
    const int K = g.K, nt = K / BK, lda = g.lda;
    unsigned voffA, voffB;
    { int R, C; stage_rc(tid * 16, R, C); const int Rb = (R & ~31) + perm32(R & 31);
        voffA = (unsigned)(R * lda + C) * 2u; voffB = (unsigned)(Rb * K + C) * 2u; }
    const size_t qvoffA = (size_t)64 * lda * 2, qvoffB = (size_t)64 * K * 2;
    const size_t kstep = (size_t)(BK * 2);
    const size_t hstepA = (size_t)HALF * lda * 2, hstepB = (size_t)HALF * K * 2;
    const size_t tstepA = 2 * hstepA, tstepB = 2 * hstepB;
    const unsigned ldsw = (unsigned)wid * 1024u;
    const int aoff = lds_byte(wr * 64 + fr, fq * 8), boff = lds_byte(wc * 32 + fr, fq * 8);
#define PG8_SA(b, h) (((b) * 2 + (h)) * HTB)
#define PG8_SB(b, h) ((4 + (b) * 2 + (h)) * HTB)
#define PG8_STAGE(bufoff, gbase, voff) do { _Pragma("unroll") for (int _i = 0; _i < 2; ++_i) \
        __builtin_amdgcn_global_load_lds((const unsigned*)((const char*)(gbase) + (size_t)_i * q##voff + (voff)), (LAS unsigned*)(lds + (bufoff) + ldsw + _i * 8192), 16, 0, 0); } while (0)
#define PG8_LDA(dst, b, h) do { _Pragma("unroll") for (int m = 0; m < 4; ++m) _Pragma("unroll") for (int k = 0; k < 2; ++k) dst[m][k] = *(const LAS bf16x8*)(lds + PG8_SA(b, h) + aoff + m * 2048 + k * 1024); } while (0)
#define PG8_LDB(dst, b, h) do { _Pragma("unroll") for (int n = 0; n < 2; ++n) _Pragma("unroll") for (int k = 0; k < 2; ++k) dst[n][k] = *(const LAS bf16x8*)(lds + PG8_SB(b, h) + boff + n * 2048 + k * 1024); } while (0)
#define PG8_MMA(ai, bj, At, Bt) do { __builtin_amdgcn_s_setprio(1); _Pragma("unroll") for (int m = 0; m < 4; ++m) _Pragma("unroll") for (int n = 0; n < 2; ++n) _Pragma("unroll") for (int k = 0; k < 2; ++k) \
        acc[ai][bj][m][n] = __builtin_amdgcn_mfma_f32_16x16x32_bf16(Bt[n][k], At[m][k], acc[ai][bj][m][n], 0, 0, 0); __builtin_amdgcn_s_setprio(0); } while (0)
#define PG8_WAIT_V(n) asm volatile("s_waitcnt vmcnt(" #n ")" ::: "memory")
#define PG8_WAIT_L(n) asm volatile("s_waitcnt lgkmcnt(" #n ")" ::: "memory")
#define PG8_BAR __builtin_amdgcn_s_barrier()
#define PG8_SCHED __builtin_amdgcn_sched_barrier(0)
    Unit cur, nxt; int ui = 0;
    if (!S.next(0, cur)) return;
    f32x4 acc[2][2][4][2];
#pragma unroll
    for (int a = 0; a < 2; ++a)
#pragma unroll
        for (int b = 0; b < 2; ++b)
#pragma unroll
            for (int m = 0; m < 4; ++m)
#pragma unroll
                for (int n = 0; n < 2; ++n) acc[a][b][m][n] = (f32x4){0.f, 0.f, 0.f, 0.f};
    bf16x8 At[4][2], B0[2][2], B1[2][2];
    const char* cA = (const char*)g.A + (size_t)cur.pm * tstepA; const char* cB = (const char*)g.Bt + (size_t)cur.pn * tstepB;
    PG8_STAGE(PG8_SB(0, 0), cB, voffB); PG8_STAGE(PG8_SB(0, 1), cB + hstepB, voffB); PG8_STAGE(PG8_SA(0, 0), cA, voffA); PG8_STAGE(PG8_SA(0, 1), cA + hstepA, voffA);
    if (wr == 1) PG8_BAR;
    PG8_WAIT_V(2); PG8_BAR;
    PG8_STAGE(PG8_SB(1, 0), cB + kstep, voffB); PG8_STAGE(PG8_SA(1, 0), cA + kstep, voffA); PG8_STAGE(PG8_SB(1, 1), cB + hstepB + kstep, voffB);
    PG8_WAIT_V(6); PG8_BAR;
    for (;;) {
        const bool has_next = S.next(ui + 1, nxt);
        const char* nA = has_next ? (const char*)g.A + (size_t)nxt.pm * tstepA : cA; const char* nB = has_next ? (const char*)g.Bt + (size_t)nxt.pn * tstepB : cB;
        for (int t = 0; t < nt; t += 2) {
            const bool last = (t == nt - 2);
            const char* a1 = cA + (size_t)(t + 1) * kstep;
            const char* a2 = last ? nA : cA + (size_t)(t + 2) * kstep; const char* b2 = last ? nB : cB + (size_t)(t + 2) * kstep;
            const char* a3 = a2 + kstep; const char* b3 = b2 + kstep;
            PG8_LDB(B0, 0, 0); PG8_LDB(B1, 0, 1); PG8_SCHED; PG8_LDA(At, 0, 0); PG8_STAGE(PG8_SA(1, 1), a1 + hstepA, voffA);
            PG8_WAIT_V(8); PG8_WAIT_L(0); PG8_BAR; PG8_MMA(0, 0, At, B0); PG8_MMA(0, 1, At, B1); PG8_BAR; PG8_SCHED;
            PG8_LDA(At, 0, 1); PG8_STAGE(PG8_SB(0, 0), b2, voffB); PG8_STAGE(PG8_SB(0, 1), b2 + hstepB, voffB); PG8_STAGE(PG8_SA(0, 0), a2, voffA);
            PG8_WAIT_V(8); PG8_WAIT_L(0); PG8_BAR; PG8_MMA(1, 0, At, B0); PG8_MMA(1, 1, At, B1); PG8_BAR; PG8_SCHED;
            PG8_LDB(B0, 1, 0); PG8_LDB(B1, 1, 1); PG8_SCHED; PG8_LDA(At, 1, 0); PG8_STAGE(PG8_SA(0, 1), a2 + hstepA, voffA);
            PG8_WAIT_V(8); PG8_WAIT_L(0); PG8_BAR; PG8_MMA(0, 0, At, B0); PG8_MMA(0, 1, At, B1); PG8_BAR; PG8_SCHED;
            PG8_LDA(At, 1, 1); PG8_STAGE(PG8_SB(1, 0), b3, voffB); PG8_STAGE(PG8_SB(1, 1), b3 + hstepB, voffB); PG8_STAGE(PG8_SA(1, 0), a3, voffA);
            PG8_WAIT_V(8); PG8_WAIT_L(0); PG8_BAR; PG8_MMA(1, 0, At, B0); PG8_MMA(1, 1, At, B1); PG8_BAR; PG8_SCHED;
        }
        if (wr == 0) PG8_BAR;
        E(acc, cur, wr, wc, fr, fq);
        if (!has_next) break;
#pragma unroll
        for (int a = 0; a < 2; ++a)
#pragma unroll
            for (int b = 0; b < 2; ++b)
#pragma unroll
                for (int m = 0; m < 4; ++m)
#pragma unroll
                    for (int n = 0; n < 2; ++n) acc[a][b][m][n] = (f32x4){0.f, 0.f, 0.f, 0.f};
        cur = nxt; cA = nA; cB = nB; ++ui;
        if (wr == 1) PG8_BAR;
    }
    PG8_WAIT_V(0);
    PG8_BAR;
#undef PG8_SA
#undef PG8_SB
#undef PG8_STAGE
#undef PG8_LDA
#undef PG8_LDB
#undef PG8_MMA
#undef PG8_WAIT_V
#undef PG8_WAIT_L
#undef PG8_BAR
#undef PG8_SCHED
}
}
using pg8::Unit;

DI void store8(bf16_t* p, const float (&v)[8]) { u32x4 w = {pk2(v[0], v[1]), pk2(v[2], v[3]), pk2(v[4], v[5]), pk2(v[6], v[7])}; *(u32x4*)p = w; }
DI void rope8(float (&v)[8], const f32x2* cs) {
    const f32x4 c0 = *(const f32x4*)cs, c1 = *(const f32x4*)(cs + 2);
    const float co[4] = {c0[0], c0[2], c1[0], c1[2]}, si[4] = {c0[1], c0[3], c1[1], c1[3]};
#pragma unroll
    for (int k = 0; k < 4; ++k) { const float a = v[2 * k], b = v[2 * k + 1]; v[2 * k] = a * co[k] - b * si[k]; v[2 * k + 1] = a * si[k] + b * co[k]; }
}
DI float sumsq_fq(const float (&v)[8]) {
    float s = 0.f;
#pragma unroll
    for (int e = 0; e < 8; ++e) s += v[e] * v[e];
    s += __shfl_xor(s, 16); s += __shfl_xor(s, 32); return s;
}

template <class Impl> struct EpiWrap : Impl {
    static constexpr bool MID = false;
    DI void operator()(const f32x4 (&acc)[2][2][4][2], const Unit& u, int wr, int wc, int, int) const {
        const int t2 = my_tid(), fr = t2 & 15, fq = (t2 >> 4) & 3;
#pragma unroll
        for (int ai = 0; ai < 2; ++ai)
#pragma unroll
            for (int m = 0; m < 4; ++m)
#pragma unroll
                for (int bj = 0; bj < 2; ++bj) {
                    const f32x4 a0 = acc[ai][bj][m][0], a1 = acc[ai][bj][m][1];
                    float v[8] = {a0[0], a0[1], a0[2], a0[3], a1[0], a1[1], a1[2], a1[3]};
                    this->chunk(u.pm * 256 + ai * 128 + wr * 64 + m * 16 + fr, u.pn, bj * 128 + wc * 32 + 8 * fq, v);
                }
    }
};

#define WSP(T, off) ((T*)(ws + (off)))
struct EpiInImpl {
    unsigned char* ws;
    DI void chunk(int row, int pn, int cc, float (&v)[8]) const {
        const int pos = row & (S - 1), b = row >> 12;
        bf16_t* const QN = WSP(bf16_t, WS_QN); bf16_t* const KCV = WSP(bf16_t, WS_KCV); bf16_t* const CQ = WSP(bf16_t, WS_CQ); bf16_t* const T6 = WSP(bf16_t, WS_T6);
        bf16_t* const KPE = WSP(bf16_t, WS_KPE); float* const GN = WSP(float, WS_GN); float* const PQ = WSP(float, WS_PQ); float* const PKV = WSP(float, WS_PKV);
        const f32x2* const CS64 = WSP(const f32x2, WS_CS64); const f32x2* const CS32 = WSP(const f32x2, WS_CS32);
        if (pn < 2) {
            rope8(v, CS64 + pos * 32 + ((cc & 63) >> 1));
            store8(QN + (size_t)row * 512 + pn * 256 + cc, v);
        } else if (pn < 5) {
            const int kv = cc >> 7, g = (cc >> 6) & 1, p = cc & 63, bg = b * 2 + g;
            if (kv == 0) {
                rope8(v, CS64 + pos * 32 + (p >> 1));
                bf16_t* dst = WSP(bf16_t, pn == 2 ? WS_KCV : (pn == 3 ? WS_KS : WS_KW));
                store8(dst + ((size_t)bg * S + pos) * 64 + p, v);
            } else if (pn == 2) {
                store8(KCV + ((size_t)(16 + bg) * S + pos) * 64 + p, v);
            } else {
                bf16_t* dst = WSP(bf16_t, pn == 3 ? WS_VST : WS_VWT);
#pragma unroll
                for (int e = 0; e < 8; ++e) dst[((size_t)bg * 64 + p + e) * S + pos] = f2bf(v[e]);
            }
        } else if (pn == 5) {
            store8(CQ + (size_t)row * 256 + cc, v);
            const float s = sumsq_fq(v);
            if ((threadIdx.x & 48) == 0) PQ[(size_t)row * 8 + (cc >> 5)] = s;
        } else if (pn == 6) {
            store8(T6 + (size_t)row * 256 + cc, v);
            if (cc < 128) {
                const float s = sumsq_fq(v);
                if ((threadIdx.x & 48) == 0) PKV[(size_t)row * 4 + (cc >> 5)] = s;
            } else if (cc < 160) {
                rope8(v, CS32 + pos * 16 + ((cc - 128) >> 1));
                store8(KPE + (size_t)row * 32 + (cc - 128), v);
            } else if (cc < 184) {
#pragma unroll
                for (int e = 0; e < 8; ++e) GN[(size_t)row * 24 + (cc - 160) + e] = sigmoidf_(v[e]);
            }
        } else {
#pragma unroll
            for (int e = 0; e < 8; ++e) v[e] = sigmoidf_(v[e]);
            if (pn < 11) store8(WSP(bf16_t, WS_GA) + (size_t)row * 1024 + (pn - 7) * 256 + cc, v);
            else store8(WSP(bf16_t, WS_GB) + (size_t)row * 1024 + (pn - 11) * 256 + cc, v);
        }
    }
};
struct EpiC1Impl {
    unsigned char* ws;
    DI void chunk(int row, int pn, int cc, float (&v)[8]) const {
        bf16_t* const HC = WSP(bf16_t, WS_HC); const float* const CB1 = WSP(const float, WS_CB1);
        const f32x4 b0 = *(const f32x4*)(CB1 + pn * 256 + cc), b1 = *(const f32x4*)(CB1 + pn * 256 + cc + 4);
        const float bb[8] = {b0[0], b0[1], b0[2], b0[3], b1[0], b1[1], b1[2], b1[3]};
#pragma unroll
        for (int e = 0; e < 8; ++e) { const float x = v[e] + bb[e]; v[e] = x / (1.f + __expf(-x)); }
        store8(HC + (size_t)row * 256 + cc, v);
    }
};
struct EpiC2Impl {
    unsigned char* ws;
    DI void chunk(int row, int pn, int cc, float (&v)[8]) const {
        if (cc >= 64) return;
        bf16_t* const KCMP = WSP(bf16_t, WS_KCMP); bf16_t* const VCMPT = WSP(bf16_t, WS_VCMPT);
        const int bg = (row >> 8) & 15, n = row & 255;
        if (n == 255) {
#pragma unroll
            for (int e = 0; e < 8; ++e) v[e] = 0.f;
        }
        if (pn == 0) store8(KCMP + ((size_t)bg * 256 + n) * 64 + cc, v);
        else {
#pragma unroll
            for (int e = 0; e < 8; ++e) VCMPT[((size_t)bg * 64 + cc + e) * 256 + n] = f2bf(v[e]);
        }
    }
};
struct EpiUQImpl {
    unsigned char* ws;
    DI void chunk(int row, int pn, int cc, float (&v)[8]) const {
        bf16_t* const QM = WSP(bf16_t, WS_QM); const float* const PQ = WSP(const float, WS_PQ); const f32x2* const CS32 = WSP(const f32x2, WS_CS32);
        const int c = pn * 256 + cc, hh = c / 96, c96 = c - hh * 96, pos = row & (S - 1);
        const f32x4 p0 = *(const f32x4*)(PQ + (size_t)row * 8), p1 = *(const f32x4*)(PQ + (size_t)row * 8 + 4);
        const float rstd = rsqrtf((((p0[0] + p0[1]) + (p0[2] + p0[3])) + ((p1[0] + p1[1]) + (p1[2] + p1[3]))) * (1.f / 256.f) + EPS);
#pragma unroll
        for (int e = 0; e < 8; ++e) v[e] *= rstd;
        if (c96 >= 64) rope8(v, CS32 + pos * 16 + ((c96 - 64) >> 1));
        store8(QM + (size_t)row * 768 + c, v);
    }
};
struct EpiUKVImpl {
    unsigned char* ws;
    DI void chunk(int row, int pn, int cc, float (&v)[8]) const {
        bf16_t* const KM = WSP(bf16_t, WS_KM); bf16_t* const VMT = WSP(bf16_t, WS_VMT); const float* const PKV = WSP(const float, WS_PKV);
        const int c = pn * 256 + cc, hh = c >> 7, c128 = c & 127, pos = row & (S - 1), b = row >> 12;
        const f32x4 p0 = *(const f32x4*)(PKV + (size_t)row * 4);
        const float rstd = rsqrtf(((p0[0] + p0[1]) + (p0[2] + p0[3])) * (1.f / 128.f) + EPS);
#pragma unroll
        for (int e = 0; e < 8; ++e) v[e] *= rstd;
        if (c128 < 64) store8(KM + ((size_t)(b * 8 + hh) * S + pos) * 64 + c128, v);
        else {
#pragma unroll
            for (int e = 0; e < 8; ++e) VMT[((size_t)(b * 8 + hh) * 64 + (c128 - 64) + e) * S + pos] = f2bf(v[e]);
        }
    }
};
struct EpiD2Impl {
    const float* xin; float* X;
    DI void chunk(int row, int pn, int cc, float (&v)[8]) const {
        const size_t o = (size_t)row * 1024 + pn * 256 + cc;
        const f32x4 x0 = *(const f32x4*)(xin + o), x1 = *(const f32x4*)(xin + o + 4);
        *(f32x4*)(X + o) = (f32x4){x0[0] + v[0], x0[1] + v[1], x0[2] + v[2], x0[3] + v[3]};
        *(f32x4*)(X + o + 4) = (f32x4){x1[0] + v[4], x1[1] + v[5], x1[2] + v[6], x1[3] + v[7]};
    }
};
struct EpiUpImpl {
    unsigned char* ws;
    DI void chunk(int row, int pn, int cc, float (&v)[8]) const {
        bf16_t* const HF = WSP(bf16_t, WS_HF);
#pragma unroll
        for (int e = 0; e < 8; ++e) { const float r = fmaxf(v[e], 0.f); v[e] = r * r; }
        store8(HF + (size_t)row * FF + pn * 256 + cc, v);
    }
};
struct EpiD1aImpl {
    unsigned char* ws;
    DI void chunk(int row, int pn, int cc, float (&v)[8]) const {
        const size_t o = (size_t)row * 1024 + pn * 256 + cc;
        const u32x4 a = *(const u32x4*)(WSP(const bf16_t, WS_GA) + o);
        v[0] *= bflo(a[0]); v[1] *= bfhi(a[0]); v[2] *= bflo(a[1]); v[3] *= bfhi(a[1]); v[4] *= bflo(a[2]); v[5] *= bfhi(a[2]); v[6] *= bflo(a[3]); v[7] *= bfhi(a[3]);
        store8(WSP(bf16_t, WS_MG) + o, v);
    }
};
struct EpiD1bImpl {
    unsigned char* ws;
    DI void chunk(int row, int pn, int cc, float (&v)[8]) const {
        const size_t o = (size_t)row * 1024 + pn * 256 + cc;
        const u32x4 b = *(const u32x4*)(WSP(const bf16_t, WS_GB) + o), g = *(const u32x4*)(WSP(const bf16_t, WS_MG) + o);
        v[0] = bflo(g[0]) + v[0] * bflo(b[0]); v[1] = bfhi(g[0]) + v[1] * bfhi(b[0]); v[2] = bflo(g[1]) + v[2] * bflo(b[1]); v[3] = bfhi(g[1]) + v[3] * bfhi(b[1]);
        v[4] = bflo(g[2]) + v[4] * bflo(b[2]); v[5] = bfhi(g[2]) + v[5] * bfhi(b[2]); v[6] = bflo(g[3]) + v[6] * bflo(b[3]); v[7] = bfhi(g[3]) + v[7] * bfhi(b[3]);
        store8(WSP(bf16_t, WS_MG) + o, v);
    }
};

#define MFMA32(a, b, c) __builtin_amdgcn_mfma_f32_32x32x16_bf16((a), (b), (c), 0, 0, 0)

template <int DQK> DI void qk_tile(const LAS unsigned char* sK, const bf16x8 (&qf)[DQK / 16], f32x16 (&s)[2], int lane) {
    constexpr int KSTR = DQK * 2 + 16;
    const int r = lane & 31, h = lane >> 5;
    const int rp = (r & 0x13) | ((r & 4) << 1) | ((r & 8) >> 1);
    bf16x8 kf[2][DQK / 16];
#pragma unroll
    for (int kt = 0; kt < 2; ++kt)
#pragma unroll
        for (int ks = 0; ks < DQK / 16; ++ks) kf[kt][ks] = *(const LAS bf16x8*)(sK + (32 * kt + rp) * KSTR + ks * 32 + h * 16);
    __builtin_amdgcn_sched_barrier(0);
#pragma unroll
    for (int kt = 0; kt < 2; ++kt) {
        f32x16 a;
#pragma unroll
        for (int i = 0; i < 16; ++i) a[i] = 0.f;
#pragma unroll
        for (int ks = 0; ks < DQK / 16; ++ks) a = MFMA32(kf[kt][ks], qf[ks], a);
        s[kt] = a;
    }
}
DI void v_load(bf16x8 (&vf)[2][2][2], const LAS unsigned char* sV, int lane) {
    const int h = lane >> 5, r = lane & 31;
#pragma unroll
    for (int kt = 0; kt < 2; ++kt)
#pragma unroll
        for (int s2 = 0; s2 < 2; ++s2)
#pragma unroll
            for (int dt = 0; dt < 2; ++dt) vf[kt][s2][dt] = *(const LAS bf16x8*)(sV + (32 * dt + r) * 144 + (32 * kt + 16 * s2 + 8 * h) * 2);
}

template <bool LANEOFF> DI void pack_p(const f32x16 (&s)[2], unsigned keep, u32x4 (&pp)[4]) {
#pragma unroll
    for (int kt = 0; kt < 2; ++kt)
#pragma unroll
        for (int s2 = 0; s2 < 2; ++s2) {
            u32x4 pw = {pk2(s[kt][8 * s2 + 0], s[kt][8 * s2 + 1]), pk2(s[kt][8 * s2 + 2], s[kt][8 * s2 + 3]),
                        pk2(s[kt][8 * s2 + 4], s[kt][8 * s2 + 5]), pk2(s[kt][8 * s2 + 6], s[kt][8 * s2 + 7])};
            if constexpr (LANEOFF) { pw[0] &= keep; pw[1] &= keep; pw[2] &= keep; pw[3] &= keep; }
            pp[kt * 2 + s2] = pw;
        }
}
DI void pv_packed(const u32x4 (&pp)[4], const bf16x8 (&vf)[2][2][2], f32x16 (&o)[2]) {
#pragma unroll
    for (int kt = 0; kt < 2; ++kt)
#pragma unroll
        for (int s2 = 0; s2 < 2; ++s2) {
            const bf16x8 pb = __builtin_bit_cast(bf16x8, pp[kt * 2 + s2]);
#pragma unroll
            for (int dt = 0; dt < 2; ++dt) o[dt] = MFMA32(vf[kt][s2][dt], pb, o[dt]);
        }
}
template <class Mask> DI void softmax_masked(f32x16 (&s)[2], int tile, const Mask& mask, float c, float& m, float& l, f32x16 (&o)[2], int lane) {
    const int h = lane >> 5;
    float mx = -1e30f;
#pragma unroll
    for (int kt = 0; kt < 2; ++kt)
#pragma unroll
        for (int reg = 0; reg < 16; ++reg) {
            const int key = 32 * kt + (reg & 7) + 8 * h + 16 * (reg >> 3);
            const float x = mask(tile, key) ? s[kt][reg] : -1e30f;
            s[kt][reg] = x; mx = fmaxf(mx, x);
        }
    mx = fmaxf(mx, __shfl_xor(mx, 32));
    const float mn = fmaxf(m, mx), alpha = ex2((m - mn) * c), nmc = -mn * c;
    m = mn;
    float sum = 0.f;
#pragma unroll
    for (int kt = 0; kt < 2; ++kt)
#pragma unroll
        for (int reg = 0; reg < 16; ++reg) {
            const float x = s[kt][reg];
            const float p = (x > -5e29f) ? ex2(__builtin_fmaf(x, c, nmc)) : 0.f;
            s[kt][reg] = p; sum += p;
        }
    l = l * alpha + sum;
    o[0] *= alpha; o[1] *= alpha;
}
DI float vmax3(float a, float b, float c) { float r; asm("v_max3_f32 %0, %1, %2, %3" : "=v"(r) : "v"(a), "v"(b), "v"(c)); return r; }
template <bool LANEOFF> DI void softmax_full(f32x16 (&s)[2], bool lane_on, float c, float& m, float& l, f32x16 (&o)[2]) {
    __builtin_amdgcn_sched_barrier(0);
    asm volatile("s_nop 11" ::: "memory");
    __builtin_amdgcn_sched_barrier(0);
    float x0 = vmax3(s[0][0], s[1][0], s[0][1]), x1 = vmax3(s[1][1], s[0][2], s[1][2]);
#pragma unroll
    for (int reg = 3; reg < 15; reg += 2) { x0 = vmax3(x0, s[0][reg], s[1][reg]); x1 = vmax3(x1, s[0][reg + 1], s[1][reg + 1]); }
    float mx = vmax3(x0, x1, s[0][15]);
    mx = fmaxf(mx, s[1][15]);
    mx = fmaxf(mx, __shfl_xor(mx, 32));
    if constexpr (LANEOFF) mx = lane_on ? mx : -1e30f;
    const float mn = fmaxf(m, mx);
    const float alpha = ex2((m - mn) * c);
    l *= alpha; o[0] *= alpha; o[1] *= alpha;
    m = mn;
    const float nmc = -mn * c;
    float sum0 = 0.f, sum1 = 0.f;
#pragma unroll
    for (int kt = 0; kt < 2; ++kt)
#pragma unroll
        for (int reg = 0; reg < 16; reg += 2) {
            const float p0 = ex2(__builtin_fmaf(s[kt][reg], c, nmc)), p1 = ex2(__builtin_fmaf(s[kt][reg + 1], c, nmc));
            s[kt][reg] = p0; s[kt][reg + 1] = p1; sum0 += p0; sum1 += p1;
        }
    float sum = sum0 + sum1;
    if constexpr (LANEOFF) sum = lane_on ? sum : 0.f;
    l += sum;
}

struct TileRegs { u32x4 k, v, p; };
template <int DQK, bool LANEOFF, bool STAG, class TileOf, class Mask, class Skip>
DI void attn_run(LAS unsigned char* lds, const bf16_t* Kg, const bf16_t* Kpe, const bf16_t* Vg, int ldv, int ntiles,
                 const TileOf& tile_of, const Mask& mask, const Skip& skip, float c, const bf16x8 (&qf)[DQK / 16], float& m, float& l, f32x16 (&o)[2]) {
    constexpr int KSTR = DQK * 2 + 16;
    const int tid = my_tid(), lane = tid & 63;
    const int krow = tid >> 3, kch = tid & 7, prow = (tid >> 2) & 63, pch = tid & 3;
    TileRegs RA, RB;
    asm volatile("" : "=v"(RA.k), "=v"(RA.v), "=v"(RA.p), "=v"(RB.k), "=v"(RB.v), "=v"(RB.p));
#define ATT_LOAD(R, tt) do { const int t_ = (tt); (R).k = *(const u32x4*)(Kg + ((size_t)(t_ * 64 + krow)) * 64 + kch * 8); (R).v = *(const u32x4*)(Vg + (size_t)krow * ldv + t_ * 64 + kch * 8); \
        if constexpr (DQK == 96) { if (tid < 256) (R).p = *(const u32x4*)(Kpe + ((size_t)(t_ * 64 + prow)) * 32 + pch * 8); } } while (0)
#define ATT_WRITE(R, kb_, vb_) do { *(LAS u32x4*)(lds + AT_K + (kb_) + krow * KSTR + kch * 16) = (R).k; *(LAS u32x4*)(lds + AT_V + (vb_) + krow * 144 + kch * 16) = (R).v; \
        if constexpr (DQK == 96) { if (tid < 256) *(LAS u32x4*)(lds + AT_K + (kb_) + prow * KSTR + 128 + pch * 16) = (R).p; } } while (0)
#define ATT_ITER(i_, RL, RW) do { const int t = tile_of(i_); const int kb = ((i_) & 1) * AT_KB, vb = ((i_) & 1) * AT_VB; \
        if ((i_) + 2 < ntiles) ATT_LOAD(RL, tile_of((i_) + 2)); \
        if (!skip(t)) { \
            f32x16 s[2]; \
            qk_tile<DQK>(lds + AT_K + kb, qf, s, lane); \
            bf16x8 vf[2][2][2]; v_load(vf, lds + AT_V + vb, lane); \
            unsigned keep = 0xffffffffu; \
            if (mask.full(t)) { const bool on = mask.lane_on(t); softmax_full<LANEOFF>(s, on, c, m, l, o); if constexpr (LANEOFF) keep = on ? 0xffffffffu : 0u; } \
            else softmax_masked(s, t, mask, c, m, l, o, lane); \
            u32x4 pp[4]; pack_p<LANEOFF>(s, keep, pp); pv_packed(pp, vf, o); \
        } \
        if ((i_) + 1 < ntiles) ATT_WRITE(RW, AT_KB - kb, AT_VB - vb); \
        __syncthreads(); } while (0)
    __syncthreads();
    if (ntiles > 0) { ATT_LOAD(RA, tile_of(0)); ATT_WRITE(RA, 0, 0); }
    if (ntiles > 1) ATT_LOAD(RB, tile_of(1));
    __syncthreads();
    for (int i = 0; i < ntiles; i += 2) {
        ATT_ITER(i, RA, RB);
        if (i + 1 < ntiles) ATT_ITER(i + 1, RB, RA);
    }
#undef ATT_LOAD
#undef ATT_WRITE
#undef ATT_ITER
}

struct TileId { DI int operator()(int i) const { return i; } };
struct TileOff { int off; DI int operator()(int i) const { return off + i; } };
struct TileList { const LAS int* lst; DI int operator()(int i) const { return lst[i]; } };
struct NoSkip { DI bool operator()(int) const { return false; } };
struct SkipAbove { int tmax; DI bool operator()(int t) const { return t * 64 > tmax; } };
struct MaskCmp { int tq;
    DI bool operator()(int t, int key) const { return 16 * (64 * t + key) + 31 <= tq; }
    DI bool full(int) const { return false; } DI bool lane_on(int) const { return true; } };
struct MaskSlc { int tq; unsigned lo, hi; int qt;
    DI bool bit(int t) const { return ((t < 32 ? (lo >> t) : (hi >> (t - 32))) & 1u) != 0u; }
    DI bool operator()(int t, int key) const { return bit(t) && (64 * t + key <= tq); }
    DI bool full(int t) const { return t < qt; } DI bool lane_on(int t) const { return bit(t); } };
struct MaskWin { int tq, tq0w;
    DI bool operator()(int t, int key) const { const int d = tq - (64 * t + key); return d >= 0 && d < 512; }
    DI bool full(int t) const { return (64 * t + 63 <= tq0w) && (tq0w + 31 - 64 * t <= 511); } DI bool lane_on(int) const { return true; } };
struct MaskCausal { int tq, tq0w;
    DI bool operator()(int t, int key) const { return 64 * t + key <= tq; }
    DI bool full(int t) const { return 64 * t + 63 <= tq0w; } DI bool lane_on(int) const { return true; } };

struct Bufs {
    const bf16_t *QN, *KS, *KW, *VST, *VWT, *KCMP, *VCMPT, *QM, *KM, *KPE, *VMT; const float* GN; bf16_t* OAB;
};

DI void zero16(f32x16& v) {
#pragma unroll
    for (int i = 0; i < 16; ++i) v[i] = 0.f;
}

DI void nsa_unit(const Bufs& B, LAS unsigned char* lds, int b, int g, int qt) {
    const int tid = my_tid(), lane = tid & 63, w = __builtin_amdgcn_readfirstlane(tid >> 6), r = w >> 1, hh = lane >> 5;
    const int qs = (w & 1) * 32 + (lane & 31), bg = b * 2 + g, tq = qt * 64 + qs, head = g * 4 + r;
    const size_t row = (size_t)b * S + tq;
    LAS unsigned* sImp = (LAS unsigned*)(lds + AT_IMP);
    LAS unsigned* sSel = (LAS unsigned*)(lds + AT_SEL);
    LAS int* sList = (LAS int*)(lds + AT_LIST);
    LAS int* sCnt = (LAS int*)(lds + AT_CNT);
    bf16x8 qf[4];
#pragma unroll
    for (int ks = 0; ks < 4; ++ks) qf[ks] = *(const bf16x8*)(B.QN + row * 512 + head * 64 + ks * 16 + hh * 8);
    for (int i = tid; i < 4096; i += 512) sImp[i] = 0u;
    const float c = 0.125f * LOG2E;
    LAS float* stash = (LAS float*)(lds + AT_ACC + w * 8192) + lane;
    float m, l; f32x16 o[2];
    const int nct = (4 * qt + 2) / 64 + 1;
    m = -1e30f; l = 0.f; zero16(o[0]); zero16(o[1]);
    attn_run<64, false, STAG_CMP>(lds, B.KCMP + (size_t)bg * 256 * 64, nullptr, B.VCMPT + (size_t)bg * 64 * 256, 256, nct, TileId{}, MaskCmp{tq}, NoSkip{}, c, qf, m, l, o);
    const float nmc = -m * c;
    float inv;
    { const float lt = l + __shfl_xor(l, 32); inv = lt > 0.f ? 1.f / lt : 0.f; }
    { const float ig0 = inv * B.GN[row * 24 + head];
#pragma unroll
    for (int dt = 0; dt < 2; ++dt)
#pragma unroll
        for (int e = 0; e < 16; ++e) stash[(dt * 16 + e) * 64] = o[dt][e] * ig0; }
    for (int ct = 0; ct < nct; ++ct) {
        __syncthreads();
        { const int krow = tid >> 3, kch = tid & 7;
          *(LAS u32x4*)(lds + AT_K + krow * 144 + kch * 16) = *(const u32x4*)(B.KCMP + ((size_t)bg * 256 + ct * 64 + krow) * 64 + kch * 8); }
        __syncthreads();
        f32x16 s[2];
        qk_tile<64>(lds + AT_K, qf, s, lane);
#pragma unroll
        for (int kt = 0; kt < 2; ++kt)
#pragma unroll
            for (int a = 0; a < 4; ++a) {
                float pv[4];
#pragma unroll
                for (int bb = 0; bb < 4; ++bb) {
                    const int reg = 4 * a + bb;
                    const int n = 64 * ct + 32 * kt + (reg & 7) + 8 * hh + 16 * (reg >> 3);
                    pv[bb] = (16 * n + 31 <= tq) ? ex2(__builtin_fmaf(s[kt][reg], c, nmc)) * inv : 0.f;
                }
                const int j = 16 * ct + 8 * kt + (a & 1) + 2 * hh + 4 * (a >> 1);
                const float carry = 0.5f * pv[3], direct = (pv[0] + pv[1]) + (pv[2] + carry);
                if (direct > 0.f) __hip_atomic_fetch_add(sImp + qs * 64 + j, (unsigned)(direct * 268435456.f + 0.5f), __ATOMIC_RELAXED, __HIP_MEMORY_SCOPE_WORKGROUP);
                if (carry > 0.f && j < 63) __hip_atomic_fetch_add(sImp + qs * 64 + j + 1, (unsigned)(carry * 268435456.f + 0.5f), __ATOMIC_RELAXED, __HIP_MEMORY_SCOPE_WORKGROUP);
            }
    }
    __syncthreads();
    {
        const int q = tid >> 3, sub = tid & 7;
        unsigned bits = 0;
        if (qt < 16) {
#pragma unroll
            for (int k = 0; k < 8; ++k) if (sub * 8 + k <= qt) bits |= 1u << k;
        } else {
            unsigned v[8]; int cnt[8];
#pragma unroll
            for (int k = 0; k < 8; ++k) { v[k] = sImp[q * 64 + sub * 8 + k]; cnt[k] = 0; }
            for (int jp = 1; jp <= qt - 2; ++jp) {
                const unsigned vp = sImp[q * 64 + jp];
#pragma unroll
                for (int k = 0; k < 8; ++k) cnt[k] += (vp > v[k] || (vp == v[k] && jp < sub * 8 + k)) ? 1 : 0;
            }
#pragma unroll
            for (int k = 0; k < 8; ++k) {
                const int j = sub * 8 + k;
                const bool forced = (j == 0) || (j == qt) || (j == qt - 1), cand = (j >= 1) && (j <= qt - 2);
                if (forced || (cand && cnt[k] < 13)) bits |= 1u << k;
            }
        }
        unsigned lo = sub < 4 ? bits << (sub * 8) : 0u, hi = sub >= 4 ? bits << ((sub - 4) * 8) : 0u;
        lo |= __shfl_xor(lo, 1); hi |= __shfl_xor(hi, 1); lo |= __shfl_xor(lo, 2); hi |= __shfl_xor(hi, 2); lo |= __shfl_xor(lo, 4); hi |= __shfl_xor(hi, 4);
        if (sub == 0) { sSel[q * 2] = lo; sSel[q * 2 + 1] = hi; }
    }
    __syncthreads();
    if (w == 0) {
        unsigned lo = sSel[lane * 2], hi = sSel[lane * 2 + 1];
#pragma unroll
        for (int x = 1; x < 64; x <<= 1) { lo |= __shfl_xor(lo, x); hi |= __shfl_xor(hi, x); }
        if (lane == 0) {
            int n = 0;
            for (int j = 0; j <= qt; ++j) { const unsigned bit = j < 32 ? (lo >> j) : (hi >> (j - 32)); if (bit & 1u) sList[n++] = j; }
            *sCnt = n;
        }
    }
    __syncthreads();
    {
        const int nsel = *sCnt;
        const unsigned lo = sSel[qs * 2], hi = sSel[qs * 2 + 1];
        m = -1e30f; l = 0.f; zero16(o[0]); zero16(o[1]);
        attn_run<64, true, STAG_SLC>(lds, B.KS + (size_t)bg * S * 64, nullptr, B.VST + (size_t)bg * 64 * S, S, nsel, TileList{sList}, MaskSlc{tq, lo, hi, qt}, NoSkip{}, c, qf, m, l, o);
        const float lt = l + __shfl_xor(l, 32); const float iv = (lt > 0.f ? 1.f / lt : 0.f) * B.GN[row * 24 + 8 + head];
#pragma unroll
        for (int dt = 0; dt < 2; ++dt)
#pragma unroll
            for (int e = 0; e < 16; ++e) stash[(dt * 16 + e) * 64] += o[dt][e] * iv;
    }
    {
        const int t0 = qt >= 8 ? qt - 8 : 0;
        m = -1e30f; l = 0.f; zero16(o[0]); zero16(o[1]);
        attn_run<64, false, STAG_WIN>(lds, B.KW + (size_t)bg * S * 64, nullptr, B.VWT + (size_t)bg * 64 * S, S, qt - t0 + 1, TileOff{t0}, MaskWin{tq, qt * 64 + (w & 1) * 32}, NoSkip{}, c, qf, m, l, o);
        const float lt = l + __shfl_xor(l, 32); const float iv = (lt > 0.f ? 1.f / lt : 0.f) * B.GN[row * 24 + 16 + head];
#pragma unroll
        for (int dt = 0; dt < 2; ++dt)
#pragma unroll
            for (int e = 0; e < 16; ++e) o[dt][e] = stash[(dt * 16 + e) * 64] + o[dt][e] * iv;
    }
    bf16_t* orow = B.OAB + row * 1024 + head * 64;
#pragma unroll
    for (int dt = 0; dt < 2; ++dt)
#pragma unroll
        for (int a = 0; a < 4; ++a) {
            u32x2 w2 = {pk2(o[dt][4 * a], o[dt][4 * a + 1]), pk2(o[dt][4 * a + 2], o[dt][4 * a + 3])};
            *(u32x2*)(orow + 32 * dt + 8 * a + 4 * hh) = w2;
        }
}

DI void mla_unit(const Bufs& B, LAS unsigned char* lds, int b, int h, int qb) {
    const int tid = my_tid(), lane = tid & 63, w = __builtin_amdgcn_readfirstlane(tid >> 6), hh = lane >> 5;
    const int tq = qb * 256 + w * 32 + (lane & 31);
    const size_t row = (size_t)b * S + tq;
    bf16x8 qf[6];
#pragma unroll
    for (int ks = 0; ks < 6; ++ks) qf[ks] = *(const bf16x8*)(B.QM + row * 768 + h * 96 + ks * 16 + hh * 8);
    const float c = 0.10206207261596575f * LOG2E;
    float m = -1e30f, l = 0.f; f32x16 o[2]; zero16(o[0]); zero16(o[1]);
    attn_run<96, false, STAG_MLA>(lds, B.KM + (size_t)(b * 8 + h) * S * 64, B.KPE + (size_t)b * S * 32, B.VMT + (size_t)(b * 8 + h) * 64 * S, S, 4 * (qb + 1),
                 TileId{}, MaskCausal{tq, qb * 256 + w * 32}, SkipAbove{qb * 256 + w * 32 + 31}, c, qf, m, l, o);
    const float lt = l + __shfl_xor(l, 32); const float iv = lt > 0.f ? 1.f / lt : 0.f;
    bf16_t* orow = B.OAB + row * 1024 + 512 + h * 64;
#pragma unroll
    for (int dt = 0; dt < 2; ++dt)
#pragma unroll
        for (int a = 0; a < 4; ++a) {
            u32x2 w2 = {pk2(o[dt][4 * a] * iv, o[dt][4 * a + 1] * iv), pk2(o[dt][4 * a + 2] * iv, o[dt][4 * a + 3] * iv)};
            *(u32x2*)(orow + 32 * dt + 8 * a + 4 * hh) = w2;
        }
}

DI void attn_phase(const Bufs& B, LAS unsigned char* lds, unsigned* counter) {
    LAS int* sUnit = (LAS int*)(lds + MISC_OFF); int it_ = 0; (void)sUnit; (void)it_; (void)counter;
    for (;;) {
#if ATT_STATIC
        __syncthreads();
        const int u = (int)blockIdx.x + 256 * it_; ++it_;
        if (u >= 2048) break;
#else
        __syncthreads();
        if (threadIdx.x == 0) *sUnit = (int)atomicAdd(counter, 1u);
        __syncthreads();
        const int u = *sUnit;
        if (u >= 2048) break;
#endif
        const int i = u >> 1;
        if ((u & 1) == 0) {
#if EXP_ATT == 2
            { const int b = (i & 63) >> 3, h = i & 7, qb = 15 - (i >> 6);
              for (int e = threadIdx.x; e < 2048; e += 512) *(u32x4*)(B.OAB + ((size_t)b * S + qb * 256 + (e >> 3)) * 1024 + 512 + h * 64 + (e & 7) * 8) = (u32x4){0x3c003c00u, 0x3c003c00u, 0x3c003c00u, 0x3c003c00u}; }
#else
            mla_unit(B, lds, (i & 63) >> 3, i & 7, 15 - (i >> 6));
#if ATT_DUP == 1
            __syncthreads(); mla_unit(B, lds, (i & 63) >> 3, i & 7, 15 - (i >> 6));
#endif
#endif
        } else {
#if EXP_ATT == 1
            { const int b = (i & 15) >> 1, g = i & 1, qt = 63 - (i >> 4);
              for (int e = threadIdx.x; e < 2048; e += 512) *(u32x4*)(B.OAB + ((size_t)b * S + qt * 64 + (e >> 5)) * 1024 + g * 256 + (e & 31) * 8) = (u32x4){0x3c003c00u, 0x3c003c00u, 0x3c003c00u, 0x3c003c00u}; }
#else
            nsa_unit(B, lds, (i & 15) >> 1, i & 1, 63 - (i >> 4));
#if ATT_DUP == 2
            __syncthreads(); nsa_unit(B, lds, (i & 15) >> 1, i & 1, 63 - (i >> 4));
#endif
#endif
        }
    }
}

DI float wave_sum(float v) {
#pragma unroll
    for (int o = 1; o < 64; o <<= 1) v += __shfl_xor(v, o);
    return v;
}
DI void norm_rows_bf16(const float* x, const float* g, bf16_t* xn) {
    const int tid_ = my_tid(), lane = tid_ & 63, gw = blockIdx.x * 8 + (tid_ >> 6), ngw = gridDim.x * 8;
    f32x4 gv[4];
#pragma unroll
    for (int j = 0; j < 4; ++j) gv[j] = ((const f32x4*)g)[lane + 64 * j];
    for (int r = gw; r < M; r += ngw) {
        const f32x4* xr = (const f32x4*)(x + (size_t)r * D) + lane;
        f32x4 v[4]; float s = 0.f;
#pragma unroll
        for (int j = 0; j < 4; ++j) { v[j] = xr[64 * j]; s += (v[j][0] * v[j][0] + v[j][1] * v[j][1]) + (v[j][2] * v[j][2] + v[j][3] * v[j][3]); }
        const float rstd = rsqrtf(wave_sum(s) * (1.f / D) + EPS);
        u32x2* o8 = (u32x2*)(xn + (size_t)r * D) + lane;
#pragma unroll
        for (int j = 0; j < 4; ++j) o8[64 * j] = (u32x2){pk2(v[j][0] * rstd * gv[j][0], v[j][1] * rstd * gv[j][1]), pk2(v[j][2] * rstd * gv[j][2], v[j][3] * rstd * gv[j][3])};
    }
}
DI void norm_rows_f32_inplace(float* x, const float* g) {
    const int tid_ = my_tid(), lane = tid_ & 63, gw = blockIdx.x * 8 + (tid_ >> 6), ngw = gridDim.x * 8;
    f32x4 gv[4];
#pragma unroll
    for (int j = 0; j < 4; ++j) gv[j] = ((const f32x4*)g)[lane + 64 * j];
    for (int r = gw; r < M; r += ngw) {
        f32x4* xr = (f32x4*)(x + (size_t)r * D) + lane;
        f32x4 v[4]; float s = 0.f;
#pragma unroll
        for (int j = 0; j < 4; ++j) { v[j] = xr[64 * j]; s += (v[j][0] * v[j][0] + v[j][1] * v[j][1]) + (v[j][2] * v[j][2] + v[j][3] * v[j][3]); }
        const float rstd = rsqrtf(wave_sum(s) * (1.f / D) + EPS);
#pragma unroll
        for (int j = 0; j < 4; ++j) xr[64 * j] = (f32x4){v[j][0] * rstd * gv[j][0], v[j][1] * rstd * gv[j][1], v[j][2] * rstd * gv[j][2], v[j][3] * rstd * gv[j][3]};
    }
}

DI int perm64(int p) { return (p >> 1) + 32 * (p & 1); }
DI int perm32r(int p) { return (p >> 1) + 16 * (p & 1); }
DI int map_in(int c) {
    if (c < 512) return (c & ~63) + perm64(c & 63);
    if (c < 1280) { const int t = (c - 512) >> 8, cc = (c - 512) & 255, kv = cc >> 7, g = (cc >> 6) & 1, p = cc & 63; return 512 + t * 256 + kv * 128 + g * 64 + (kv == 0 ? perm64(p) : p); }
    if (c < 1536) return 1304 + (c - 1280);
    if (c < 1792) { const int cc = c - 1536; if (cc < 128) return 1560 + cc; if (cc < 160) return 1688 + perm32r(cc - 128); if (cc < 184) return 1280 + (cc - 160); return -1; }
    if (c < 2816) return 1720 + (c - 1792);
    return 2744 + (c - 2816);
}
struct Wts {
    const float *w_in, *cmp_pe, *cmp_w1, *cmp_w2, *nsa_w_o, *q_norm, *kv_norm, *w_uq, *w_ukv, *mla_w_o, *w_out, *w_up, *w_down;
};
template <int JOB> DI float prep_get(const Wts& W, int n, int k) {
    if constexpr (JOB == 0) { const int c = map_in(n); return c >= 0 ? W.w_in[(size_t)k * IN_COLS + c] : 0.f; }
    if constexpr (JOB == 1) { const int j = n >> 8, h = n & 255, lp = k >> 6, p = k & 63, d = j == 0 ? perm64(p) : p; return W.cmp_w1[((size_t)j * 2048 + lp * 64 + d) * 256 + h]; }
    if constexpr (JOB == 2) { const int j = n >> 8, np = n & 255; return np < 64 ? W.cmp_w2[((size_t)j * 256 + k) * 64 + (j == 0 ? perm64(np) : np)] : 0.f; }
    if constexpr (JOB == 3) { return n < 1024 ? W.nsa_w_o[(size_t)k * 1024 + n] : W.mla_w_o[(size_t)k * 1024 + (n - 1024)]; }
    if constexpr (JOB == 4) { const int hh = n / 96, c = n - hh * 96; const int sc = c < 64 ? n : hh * 96 + 64 + perm32r(c - 64); return W.q_norm[k] * W.w_uq[(size_t)k * 768 + sc]; }
    if constexpr (JOB == 5) { return k < 128 ? W.kv_norm[k] * W.w_ukv[(size_t)k * 1024 + n] : 0.f; }
    if constexpr (JOB == 6) { return W.w_out[(size_t)k * 1024 + n]; }
    if constexpr (JOB == 7) { return W.w_up[(size_t)k * 4096 + n]; }
    if constexpr (JOB == 8) { return W.w_down[(size_t)k * 1024 + n]; }
    return 0.f;
}
template <int JOB> DI void prep_tile(const Wts& W, LAS float* scr, bf16_t* dst, int ldd, int n0, int k0) {
    const int tid = my_tid();
#pragma unroll
    for (int it = 0; it < 8; ++it) { const int kk = it * 8 + (tid >> 6), nn = tid & 63; scr[kk * 65 + nn] = prep_get<JOB>(W, n0 + nn, k0 + kk); }
    __syncthreads();
    { const int n = tid >> 3, kc = tid & 7; const LAS float* s = scr + (kc * 8) * 65 + n;
      u32x4 o = {pk2(s[0], s[65]), pk2(s[130], s[195]), pk2(s[260], s[325]), pk2(s[390], s[455])};
      *(u32x4*)(dst + (size_t)(n0 + n) * ldd + k0 + kc * 8) = o; }
    __syncthreads();
}
DI void prep_tile_vec(const float* src, int ldsrc, LAS float* scr, bf16_t* dst, int ldd, int n0, int k0) {
    const int tid = my_tid();
    f32x4 v[4];
#pragma unroll
    for (int it = 0; it < 4; ++it) v[it] = *(const f32x4*)(src + (size_t)(k0 + it * 32 + (tid >> 4)) * ldsrc + (tid & 15) * 4);
#pragma unroll
    for (int it = 0; it < 4; ++it) { LAS float* d = scr + (it * 32 + (tid >> 4)) * 65 + (tid & 15) * 4; d[0] = v[it][0]; d[1] = v[it][1]; d[2] = v[it][2]; d[3] = v[it][3]; }
    __syncthreads();
    { const int n = tid >> 3, kc = tid & 7;
#pragma unroll
      for (int hh = 0; hh < 2; ++hh) { const LAS float* s = scr + (hh * 64 + kc * 8) * 65 + n;
        u32x4 o = {pk2(s[0], s[65]), pk2(s[130], s[195]), pk2(s[260], s[325]), pk2(s[390], s[455])};
        *(u32x4*)(dst + (size_t)(n0 + n) * ldd + k0 + hh * 64 + kc * 8) = o; } }
    __syncthreads();
}
DI void prep_phase(const Wts& W, unsigned char* ws, LAS unsigned char* lds, int layer) {
    LAS float* scr = (LAS float*)lds;
    const int tid = my_tid();
    constexpr int T0a = 384, T0 = T0a + 288, T1 = T0 + 256, T2 = T1 + 32, T3 = T2 + 128, T4 = T3 + 48, T5 = T4 + 64, T6_ = T5 + 128, T7 = T6_ + 512, T8 = T7 + 512, TB = T8 + 8;
    for (int job = blockIdx.x; job < TB; job += gridDim.x) {
        int r = job;
        if (r < T0a) { const int ix = r >> 4, n0 = (ix < 20 ? ix : ix + 4) * 64;
            prep_tile<0>(W, scr, (bf16_t*)(ws + WS_WIN), 1024, n0, (r & 15) * 64); continue; }
        if (r < T0) { r -= T0a; const int ix = r >> 3, n0 = (ix < 4 ? 20 + ix : 24 + ix) * 64;
            prep_tile_vec(W.w_in + map_in(n0), IN_COLS, scr, (bf16_t*)(ws + WS_WIN), 1024, n0, (r & 7) * 128); continue; }
        if (r < T1) { r -= T0; prep_tile<1>(W, scr, (bf16_t*)(ws + WS_W1T), 2048, (r >> 5) * 64, (r & 31) * 64); continue; }
        if (r < T2) { r -= T1; prep_tile<2>(W, scr, (bf16_t*)(ws + WS_W2T), 256, (r >> 2) * 64, (r & 3) * 64); continue; }
        if (r < T3) { r -= T2; const int n0 = (r >> 2) * 64, k0 = (r & 3) * 128;
            prep_tile_vec(n0 < 1024 ? W.nsa_w_o + n0 : W.mla_w_o + (n0 - 1024), 1024, scr, (bf16_t*)(ws + WS_WOAB), 512, n0, k0); continue; }
        if (r < T4) { r -= T3; prep_tile<4>(W, scr, (bf16_t*)(ws + WS_WUQ), 256, (r >> 2) * 64, (r & 3) * 64); continue; }
        if (r < T5) { r -= T4; prep_tile<5>(W, scr, (bf16_t*)(ws + WS_WUKV), 256, (r >> 2) * 64, (r & 3) * 64); continue; }
        if (r < T6_) { r -= T5; const int n0 = (r >> 3) * 64; prep_tile_vec(W.w_out + n0, 1024, scr, (bf16_t*)(ws + WS_WOUT), 1024, n0, (r & 7) * 128); continue; }
        if (r < T7) { r -= T6_; const int n0 = (r >> 3) * 64; prep_tile_vec(W.w_up + n0, 4096, scr, (bf16_t*)(ws + WS_WUP), 1024, n0, (r & 7) * 128); continue; }
        if (r < T8) { r -= T7; const int n0 = (r >> 5) * 64; prep_tile_vec(W.w_down + n0, 1024, scr, (bf16_t*)(ws + WS_WDN), 4096, n0, (r & 31) * 128); continue; }
        {
            r -= T8; const int j = r >> 2, hc = r & 3, kk = tid >> 4, h4 = (tid & 15) * 4;
            const float* pe = W.cmp_pe + j * 2048; const float* w1 = W.cmp_w1 + (size_t)j * 2048 * 256 + hc * 64 + h4;
            f32x4 a = {0.f, 0.f, 0.f, 0.f};
#pragma unroll 8
            for (int i = 0; i < 64; ++i) { const int k = kk + 32 * i; const f32x4 wv = *(const f32x4*)(w1 + (size_t)k * 256); a += wv * pe[k]; }
            LAS float* d = scr + kk * 64 + h4; d[0] = a[0]; d[1] = a[1]; d[2] = a[2]; d[3] = a[3];
            __syncthreads();
            if (tid < 64) { float sm = 0.f; for (int q = 0; q < 32; ++q) sm += scr[q * 64 + tid]; ((float*)(ws + WS_CB1))[j * 256 + hc * 64 + tid] = sm; }
            __syncthreads();
        }
    }
    if (layer == 0) {
        f32x2* cs64 = (f32x2*)(ws + WS_CS64); f32x2* cs32 = (f32x2*)(ws + WS_CS32);
        for (int idx = blockIdx.x * 512 + tid; idx < S * 48; idx += gridDim.x * 512) {
            int pos, i; float inv;
            if (idx < S * 32) { pos = idx >> 5; i = idx & 31; inv = (float)exp2(-(double)i * (13.287712379549449 / 32.0)); }
            else { const int e = idx - S * 32; pos = e >> 4; i = e & 15; inv = (float)exp2(-(double)i * (13.287712379549449 / 16.0)); }
            const float ang = (float)pos * inv;
            const double rev = (double)ang * 0.15915494309189535; const float fr = (float)(rev - floor(rev));
            const f32x2 v = {__builtin_amdgcn_cosf(fr), __builtin_amdgcn_sinf(fr)};
            if (idx < S * 32) cs64[idx] = v; else cs32[idx - S * 32] = v;
        }
    }
}

struct Params { const float* in[17]; float* out; unsigned char* ws; int ph_lo, ph_hi; };
typedef const __attribute__((address_space(4))) unsigned char* kaptr_t;
DI const float* karg_ptr(int byte_off) { kaptr_t ka = (kaptr_t)__builtin_amdgcn_kernarg_segment_ptr(); asm volatile("" : "+s"(ka)); return *(const float* const __attribute__((address_space(4)))*)(ka + byte_off); }
#define KIN(i) karg_ptr(8 * (i))

DI void grid_barrier_cg(cg::grid_group& grid) {
    asm volatile("s_waitcnt vmcnt(0) lgkmcnt(0)" ::: "memory");
    __syncthreads();
    if (threadIdx.x < 64) asm volatile("buffer_wbl2 sc1\n\ts_waitcnt vmcnt(0)" ::: "memory");
    __syncthreads();
    grid.sync();
    asm volatile("buffer_inv sc1\n\ts_waitcnt vmcnt(0)" ::: "memory");
}

#define XB_TMO      128
#define XB_XCNT(j)  (256  + 64 * (j))
#define XB_XSUB(j)  (1280 + 64 * (j))
#define XB_XGEN(j)  (2304 + 64 * (j))
#define XB_TOP      3328
#define XB_TOPGEN   3392
#define XCD_BAR_WORDS 3456
#define XB_SPIN_CAP (1u << 18)
DI unsigned xb_ld(unsigned* p)              { return __hip_atomic_load(p, __ATOMIC_RELAXED, __HIP_MEMORY_SCOPE_AGENT); }
DI unsigned xb_add(unsigned* p, unsigned v) { return __hip_atomic_fetch_add(p, v, __ATOMIC_RELAXED, __HIP_MEMORY_SCOPE_AGENT); }
DI unsigned xb_xcc_id() { return (unsigned)__builtin_amdgcn_s_getreg((3 << 11) | 20) & 0xFu; }
#define XB_SPIN(cond, bar) do { unsigned _sp = 0; while (cond) { __builtin_amdgcn_s_sleep(1); \
    if ((++_sp & 255u) == 0u) { if (xb_ld(&(bar)[XB_TMO])) break; if (_sp > XB_SPIN_CAP) { atomicAdd(&(bar)[XB_TMO], 1u); break; } } } } while (0)
DI void xcd_barrier_complete(unsigned* bar, unsigned x, unsigned& nloc, unsigned& nx) {
    const unsigned G = gridDim.x * gridDim.y * gridDim.z;
    unsigned sum, cnt, mine, sp = 0u;
    for (;;) {
        sum = 0u; cnt = 0u; mine = 0u;
#pragma unroll
        for (unsigned j = 0; j < 16; ++j) { const unsigned c = xb_ld(&bar[XB_XCNT(j)]); sum += c; cnt += (c > 0u) ? 1u : 0u; mine = (j == x) ? c : mine; }
        if (sum == G) break;
        __builtin_amdgcn_s_sleep(1);
        if ((++sp & 255u) == 0u) { if (xb_ld(&bar[XB_TMO])) break; if (sp > XB_SPIN_CAP) { atomicAdd(&bar[XB_TMO], 1u); break; } }
    }
    nloc = mine > 0u ? mine : 1u; nx = cnt > 0u ? cnt : 1u;
}
DI void xcd_barrier(unsigned* bar, volatile LAS unsigned* st) {
    asm volatile("s_waitcnt vmcnt(0)" ::: "memory");
    __syncthreads();
    if (threadIdx.x == 0) {
        const unsigned x = xb_xcc_id();
        __builtin_amdgcn_s_waitcnt(0);
        unsigned nloc = st[0], nx = st[1];
        if (nloc == 0u) { xcd_barrier_complete(bar, x, nloc, nx); st[0] = nloc; st[1] = nx; }
        const unsigned old = xb_add(&bar[XB_XSUB(x)], 1u);
        const unsigned gen = old / nloc;
        if (old + 1u == (gen + 1u) * nloc) {
            __builtin_amdgcn_fence(__ATOMIC_RELEASE, "agent");
            asm volatile("s_waitcnt vmcnt(0)" ::: "memory");
            const unsigned og = xb_add(&bar[XB_TOP], 1u);
            const unsigned tg = og / nx;
            if (og + 1u == (tg + 1u) * nx) xb_add(&bar[XB_TOPGEN], 1u);
            else XB_SPIN(xb_ld(&bar[XB_TOPGEN]) == tg, bar);
            __builtin_amdgcn_fence(__ATOMIC_ACQUIRE, "agent");
            xb_add(&bar[XB_XGEN(x)], 1u);
            asm volatile("s_waitcnt vmcnt(0)" ::: "memory");
        } else {
            XB_SPIN(xb_ld(&bar[XB_XGEN(x)]) == gen, bar);
            __builtin_amdgcn_fence(__ATOMIC_ACQUIRE, "agent");
            asm volatile("s_waitcnt vmcnt(0)" ::: "memory");
        }
    }
    __syncthreads();
}
template <bool FIRST> DI void grid_barrier(cg::grid_group& grid, LAS unsigned char* lds) {
    unsigned* bar = (unsigned*)((unsigned char*)karg_ptr(144) + WS_BAR);
    if constexpr (FIRST) {
        grid_barrier_cg(grid);
        if (threadIdx.x == 0) (void)xb_add(&bar[XB_XCNT(xb_xcc_id())], 1u);
    } else {
        xcd_barrier(bar, (volatile LAS unsigned*)(lds + MISC_OFF + 64));
    }
}

#define PH_IN(k) (lo <= (k) && (k) < hi)
#define PH_SEAM(k) do { if (PH_IN(k) && PH_IN((k) + 1)) grid_barrier<(k) == 0>(grid, lds); } while (0)
#define PH_ENV() int G = gridDim.x, bx = blockIdx.x; asm volatile("" : "+s"(G), "+s"(bx)); unsigned char* ws = (unsigned char*)karg_ptr(144); float* X = (float*)karg_ptr(136); \
                 const int tid = my_tid(); bf16_t* XN = (bf16_t*)(ws + WS_XN); (void)tid; (void)X; (void)XN; (void)G; (void)bx

template <int L> DI void run_layer(LAS unsigned char* lds, cg::grid_group& grid, int lo, int hi) {
    constexpr int P0 = 10 * L;
    if (PH_IN(P0 + 0)) for (int rep_ = 0; rep_ < ((((DUP_MASK >> 0) & 1) && L > 0) ? 2 : 1); ++rep_) { if (rep_) grid_barrier<false>(grid, lds);
        PH_ENV();
        Wts W;
        W.w_in = KIN(2) + (size_t)L * 1024 * IN_COLS; W.cmp_pe = KIN(3) + (size_t)L * 2 * 2048; W.cmp_w1 = KIN(4) + (size_t)L * 2 * 2048 * 256;
        W.cmp_w2 = KIN(5) + (size_t)L * 2 * 256 * 64; W.nsa_w_o = KIN(6) + (size_t)L * 512 * 1024; W.q_norm = KIN(7) + L * 256; W.kv_norm = KIN(8) + L * 128;
        W.w_uq = KIN(9) + (size_t)L * 256 * 768; W.w_ukv = KIN(10) + (size_t)L * 128 * 1024; W.mla_w_o = KIN(11) + (size_t)L * 512 * 1024;
        W.w_out = KIN(12) + (size_t)L * 1024 * 1024; W.w_up = KIN(14) + (size_t)L * 1024 * 4096; W.w_down = KIN(15) + (size_t)L * 4096 * 1024;
        prep_phase(W, ws, lds, L);
        unsigned* ctl = (unsigned*)(ws + WS_CTL);
        if (L == 0 && bx == 0 && tid < 2 * NL) atomicExch(ctl + tid * 64, 0u);
        norm_rows_bf16(L == 0 ? KIN(0) : X, KIN(1) + L * D, XN);
    }
    PH_SEAM(P0 + 0);
    if (PH_IN(P0 + 1)) for (int rep_ = 0; rep_ < (((DUP_MASK >> 1) & 1) ? 2 : 1); ++rep_) { if (rep_) grid_barrier<false>(grid, lds);
        PH_ENV();
        pg8::Gemm g{XN, (const bf16_t*)(ws + WS_WIN), 1024, 1024}; pg8::StaticOrder So; So.init(M, NIN, G, bx);
        EpiWrap<EpiInImpl> E; E.ws = ws;
        pg8::gemm_phase(lds, g, So, E);
    }
    PH_SEAM(P0 + 1);
    if (PH_IN(P0 + 2)) for (int rep_ = 0; rep_ < (((DUP_MASK >> 2) & 1) ? 2 : 1); ++rep_) { if (rep_) grid_barrier<false>(grid, lds);
        PH_ENV();
        if (bx < 32) {
            pg8::CmpOrder So{G, bx};
            { pg8::Gemm g{(const bf16_t*)(ws + WS_KCV), (const bf16_t*)(ws + WS_W1T), 1024, 2048}; EpiWrap<EpiC1Impl> E; E.ws = ws; pg8::gemm_phase(lds, g, So, E); }
            { pg8::Gemm g{(const bf16_t*)(ws + WS_HC), (const bf16_t*)(ws + WS_W2T), 256, 256}; EpiWrap<EpiC2Impl> E; E.ws = ws; pg8::gemm_phase(lds, g, So, E); }
        } else {
            { pg8::Gemm g{(const bf16_t*)(ws + WS_CQ), (const bf16_t*)(ws + WS_WUQ), 256, 256}; pg8::StaticOrder So; So.init(M, 768, G - 32, bx - 32);
              EpiWrap<EpiUQImpl> E; E.ws = ws;
              pg8::gemm_phase(lds, g, So, E); }
            { pg8::Gemm g{(const bf16_t*)(ws + WS_T6), (const bf16_t*)(ws + WS_WUKV), 256, 256}; pg8::StaticOrder So; So.init(M, 1024, G - 32, bx - 32);
              EpiWrap<EpiUKVImpl> E; E.ws = ws;
              pg8::gemm_phase(lds, g, So, E); }
        }
    }
    PH_SEAM(P0 + 2);
    if (PH_IN(P0 + 4)) for (int rep_ = 0; rep_ < (((DUP_MASK >> 4) & 1) ? 2 : 1); ++rep_) { if (rep_) grid_barrier<false>(grid, lds);
        PH_ENV();
        Bufs B; B.QN = (const bf16_t*)(ws + WS_QN); B.KS = (const bf16_t*)(ws + WS_KS); B.KW = (const bf16_t*)(ws + WS_KW); B.VST = (const bf16_t*)(ws + WS_VST);
        B.VWT = (const bf16_t*)(ws + WS_VWT); B.KCMP = (const bf16_t*)(ws + WS_KCMP); B.VCMPT = (const bf16_t*)(ws + WS_VCMPT); B.QM = (const bf16_t*)(ws + WS_QM);
        B.KM = (const bf16_t*)(ws + WS_KM); B.KPE = (const bf16_t*)(ws + WS_KPE); B.VMT = (const bf16_t*)(ws + WS_VMT); B.GN = (const float*)(ws + WS_GN); B.OAB = XN;
#if EXP_NOATTN
        { u32x4* o = (u32x4*)XN; for (size_t i = (size_t)bx * 512 + tid; i < (size_t)M * 1024 / 8; i += (size_t)G * 512) o[i] = (u32x4){0x3c003c00u, 0x3c003c00u, 0x3c003c00u, 0x3c003c00u}; (void)B; }
#else
        attn_phase(B, lds, (unsigned*)(ws + WS_CTL) + (L * 2 + rep_) * 64);
#endif
    }
    PH_SEAM(P0 + 4);
    if (PH_IN(P0 + 5)) for (int rep_ = 0; rep_ < (((DUP_MASK >> 5) & 1) ? 2 : 1); ++rep_) { if (rep_) grid_barrier<false>(grid, lds);
        PH_ENV();
        pg8::StaticOrder So; So.init(M, 1024, G, bx);
        { pg8::Gemm g{XN, (const bf16_t*)(ws + WS_WOAB), 1024, 512}; EpiWrap<EpiD1aImpl> E; E.ws = ws; pg8::gemm_phase(lds, g, So, E); }
        { pg8::Gemm g{XN + 512, (const bf16_t*)(ws + WS_WOAB) + 1024 * 512, 1024, 512}; EpiWrap<EpiD1bImpl> E; E.ws = ws; pg8::gemm_phase(lds, g, So, E); }
    }
    PH_SEAM(P0 + 5);
    if (PH_IN(P0 + 6)) for (int rep_ = 0; rep_ < (((DUP_MASK >> 6) & 1) ? 2 : 1); ++rep_) { if (rep_) grid_barrier<false>(grid, lds);
        PH_ENV();
        pg8::Gemm g{(const bf16_t*)(ws + WS_MG), (const bf16_t*)(ws + WS_WOUT), 1024, 1024}; pg8::StaticOrder So; So.init(M, 1024, G, bx);
        EpiWrap<EpiD2Impl> E; E.xin = (L == 0 ? KIN(0) : X); E.X = X;
        pg8::gemm_phase(lds, g, So, E);
    }
    PH_SEAM(P0 + 6);
    if (PH_IN(P0 + 7)) for (int rep_ = 0; rep_ < (((DUP_MASK >> 7) & 1) ? 2 : 1); ++rep_) { if (rep_) grid_barrier<false>(grid, lds);
        PH_ENV();
        norm_rows_bf16(X, KIN(13) + L * D, XN);
    }
    PH_SEAM(P0 + 7);
    if (PH_IN(P0 + 8)) for (int rep_ = 0; rep_ < (((DUP_MASK >> 8) & 1) ? 2 : 1); ++rep_) { if (rep_) grid_barrier<false>(grid, lds);
        PH_ENV();
        pg8::Gemm g{XN, (const bf16_t*)(ws + WS_WUP), 1024, 1024}; pg8::StaticOrder So; So.init(M, FF, G, bx);
        EpiWrap<EpiUpImpl> E; E.ws = ws;
        pg8::gemm_phase(lds, g, So, E);
    }
    PH_SEAM(P0 + 8);
    if (PH_IN(P0 + 9)) for (int rep_ = 0; rep_ < (((DUP_MASK >> 9) & 1) ? 2 : 1); ++rep_) { if (rep_) grid_barrier<false>(grid, lds);
        PH_ENV();
        pg8::Gemm g{(const bf16_t*)(ws + WS_HF), (const bf16_t*)(ws + WS_WDN), 4096, 4096}; pg8::StaticOrder So; So.init(M, 1024, G, bx);
        EpiWrap<EpiD2Impl> E; E.xin = X; E.X = X;
        pg8::gemm_phase(lds, g, So, E);
    }
    PH_SEAM(P0 + 9);
}

__global__ void __launch_bounds__(512, 2) mega(Params P) {
    extern __shared__ __attribute__((aligned(16))) unsigned char lds_raw[];
    LAS unsigned char* lds = (LAS unsigned char*)lds_raw;
    cg::grid_group grid = cg::this_grid();
    const int lo = P.ph_lo, hi = P.ph_hi;
    if (threadIdx.x < 2) ((volatile LAS unsigned*)(lds + MISC_OFF + 64))[threadIdx.x] = 0u;
    if (blockIdx.x == 0 && hi - lo > 1) { unsigned* bar = (unsigned*)((unsigned char*)karg_ptr(144) + WS_BAR);
        for (int i = threadIdx.x; i < XCD_BAR_WORDS; i += 512) __hip_atomic_store(bar + i, 0u, __ATOMIC_RELAXED, __HIP_MEMORY_SCOPE_AGENT); }
    __syncthreads();
    run_layer<0>(lds, grid, lo, hi);
    run_layer<1>(lds, grid, lo, hi);
    run_layer<2>(lds, grid, lo, hi);
    run_layer<3>(lds, grid, lo, hi);
    if (PH_IN(39) && PH_IN(40)) {   }
    if (PH_IN(40)) { float* X = (float*)karg_ptr(136); norm_rows_f32_inplace(X, KIN(16)); }
}

extern "C" void kernel_launch(void* const* d_in, const int* in_sizes, int n_in, void* d_out, int out_size, void* d_ws, size_t ws_size, hipStream_t stream) {
    static int grid = 0;
    if (grid == 0) {
        if (n_in != 17 || out_size != M * D || ws_size < WS_END) { fprintf(stderr, "kernel_launch: unexpected shapes (n_in %d out %d ws %zu)\n", n_in, out_size, ws_size); grid = -1; return; }
        int dev = 0, cus = 0, per_cu = 0;
        hipGetDevice(&dev);
        hipDeviceGetAttribute(&cus, hipDeviceAttributeMultiprocessorCount, dev);
        if (hipFuncSetAttribute((const void*)mega, hipFuncAttributeMaxDynamicSharedMemorySize, LDS_BYTES) != hipSuccess) { fprintf(stderr, "kernel_launch: hipFuncSetAttribute failed\n"); grid = -1; return; }
        if (hipOccupancyMaxActiveBlocksPerMultiprocessor(&per_cu, (const void*)mega, 512, LDS_BYTES) != hipSuccess || per_cu < 1) { fprintf(stderr, "kernel_launch: occupancy query gave %d\n", per_cu); per_cu = 1; }
        (void)hipGetLastError();
        grid = cus * per_cu;
        if (grid < 64) { fprintf(stderr, "kernel_launch: grid %d too small for the phase program\n", grid); grid = -1; return; }
    }
    if (grid < 0) return;
    Params p{};
    for (int i = 0; i < 17; ++i) p.in[i] = (const float*)d_in[i];
    p.out = (float*)d_out; p.ws = (unsigned char*)d_ws;
#if MK_MULTI
    for (int ph = 0; ph <= 40; ++ph) {
        p.ph_lo = ph; p.ph_hi = ph + 1;
        hipLaunchKernelGGL(mega, dim3(grid), dim3(512), LDS_BYTES, stream, p);
    }
#else
    p.ph_lo = 0; p.ph_hi = 41;
    void* args[] = {&p};
    hipError_t e = hipLaunchCooperativeKernel((const void*)mega, dim3(grid), dim3(512), args, LDS_BYTES, stream);
    if (e != hipSuccess) fprintf(stderr, "kernel_launch: cooperative launch failed: %s (grid %d)\n", hipGetErrorString(e), grid);
#endif
}
```

```cpp
#include <hip/hip_runtime.h>
#include <hip/hip_cooperative_groups.h>
#include <cstdio>
#include <cstdint>
namespace cg = cooperative_groups;

#ifndef EXP_NOATTN
#define EXP_NOATTN 0
#endif
#ifndef ATT_STATIC
#define ATT_STATIC 0
#endif
#ifndef EXP_ATT
#define EXP_ATT 0
#endif
#ifndef DUP_MASK
#define DUP_MASK 0
#endif
#ifndef ATT_DUP
#define ATT_DUP 0
#endif
#ifndef STAG_CMP
#define STAG_CMP false
#define STAG_SLC false
#define STAG_WIN true
#define STAG_MLA true
#endif
#ifndef MK_MULTI
#define MK_MULTI 0
#endif

#define LAS __attribute__((address_space(3)))
#define DI __device__ __forceinline__
typedef unsigned short bf16_t;
typedef short bf16x8 __attribute__((ext_vector_type(8)));
typedef float f32x4 __attribute__((ext_vector_type(4)));
typedef float f32x2 __attribute__((ext_vector_type(2)));
typedef float f32x16 __attribute__((ext_vector_type(16)));
typedef unsigned u32x4 __attribute__((ext_vector_type(4)));
typedef unsigned u32x2 __attribute__((ext_vector_type(2)));
typedef __bf16 bf16v2 __attribute__((ext_vector_type(2)));

DI unsigned pk2(float lo, float hi) { f32x2 v = {lo, hi}; return __builtin_bit_cast(unsigned, __builtin_convertvector(v, bf16v2)); }
DI bf16_t f2bf(float x) { return (bf16_t)(pk2(x, 0.f) & 0xffffu); }
DI float bflo(unsigned w) { return __uint_as_float(w << 16); }
DI float bfhi(unsigned w) { return __uint_as_float(w & 0xffff0000u); }
DI float sigmoidf_(float x) { return 1.f / (1.f + __expf(-x)); }
DI float ex2(float x) { return __builtin_amdgcn_exp2f(x); }
DI int my_tid() { int t = threadIdx.x; asm volatile("" : "+v"(t)); return t; }

constexpr int NB = 8, S = 4096, D = 1024, NL = 4, M = NB * S, FF = 4096;
constexpr int NIN = 3840;
constexpr int IN_COLS = 3768;
constexpr float EPS = 1e-6f;
constexpr float LOG2E = 1.4426950408889634f;

constexpr size_t MiB = 1u << 20;
constexpr size_t WS_CTL = 0;
constexpr size_t WS_BAR = 16384;
constexpr size_t WS_CB1 = 4096;
constexpr size_t WS_RSQ = 65536;
constexpr size_t WS_RSKV = 65536 + 131072;
constexpr size_t WS_CS64 = 1 * MiB;
constexpr size_t WS_CS32 = 2 * MiB;
constexpr size_t WS_WIN = 3 * MiB;
constexpr size_t WS_W1T = WS_WIN + (size_t)NIN * 1024 * 2;
constexpr size_t WS_W2T = WS_W1T + 2 * MiB;
constexpr size_t WS_WOAB = WS_W2T + 256 * 1024;
constexpr size_t WS_WUQ = WS_WOAB + 2 * MiB;
constexpr size_t WS_WUKV = WS_WUQ + 384 * 1024;
constexpr size_t WS_WOUT = 16 * MiB;
constexpr size_t WS_WUP = 18 * MiB;
constexpr size_t WS_WDN = 26 * MiB;
constexpr size_t WS_XN = 34 * MiB;
constexpr size_t WS_GA = 98 * MiB;
constexpr size_t WS_GB = 162 * MiB;
constexpr size_t WS_QN = 226 * MiB;
constexpr size_t WS_KCV = 258 * MiB;
constexpr size_t WS_KS = 274 * MiB, WS_KW = 282 * MiB, WS_VST = 290 * MiB, WS_VWT = 298 * MiB;
constexpr size_t WS_CQ = 306 * MiB, WS_T6 = 322 * MiB, WS_KPE = 338 * MiB, WS_GN = 340 * MiB;
constexpr size_t WS_QM = 343 * MiB, WS_KM = 391 * MiB, WS_VMT = 423 * MiB, WS_HC = 455 * MiB;
constexpr size_t WS_KCMP = 459 * MiB, WS_VCMPT = WS_KCMP + 512 * 1024;
constexpr size_t WS_MG = 226 * MiB;
constexpr size_t WS_HF = 98 * MiB;
constexpr size_t WS_PQ = 460 * MiB;
constexpr size_t WS_PKV = 461 * MiB;
constexpr size_t WS_END = 462 * MiB;
static_assert(WS_WUKV + 512 * 1024 <= WS_WOUT, "ws map");

constexpr int LDS_BYTES = 147456;
constexpr int MISC_OFF = 147200;
constexpr int AT_K = 0, AT_KB = 13312  , AT_V = 26624, AT_VB = 9216  , AT_IMP = 54272, AT_SEL = 70656, AT_LIST = 71168, AT_CNT = 71424, AT_ACC = 71680;

namespace pg8 {
constexpr int BM = 256, BK = 64, HALF = 128, HTB = HALF * BK * 2, NXCD = 8, WGM = 8;
__host__ __device__ __forceinline__ int lds_byte(int r, int c) { const int st = (r >> 4) * 2 + (c >> 5), rr = r & 15, cc = c & 31, ob = rr * 64 + cc * 2; return st * 1024 + (ob ^ (((ob >> 9) & 1) << 5)); }
__host__ __device__ __forceinline__ void stage_rc(int b, int& R, int& C) { const int st = b / 1024, sb = b % 1024, swz = sb ^ (((sb >> 9) & 1) << 5); R = (st >> 1) * 16 + swz / 64; C = (st & 1) * 32 + (swz % 64) / 2; }
__host__ __device__ __forceinline__ int perm32(int rho) { const int n = rho >> 4, i = rho & 15; return 8 * (i >> 2) + 4 * n + (i & 3); }

struct Unit { int pm, pn; };
struct Gemm { const bf16_t* A; const bf16_t* Bt; int lda; int K; };

struct StaticOrder {
    int nM, nN, nwg, G, c;
    __device__ void init(int M_, int N_, int G_, int c_) { nM = M_ / BM; nN = N_ / BM; nwg = nM * nN; G = G_; c = c_; }
    __device__ bool next(int i, Unit& u) const {
        const long L = (long)i * G + c; if (L >= nwg) return false;
        int wgid = (int)L; { const int q = nwg / NXCD, r = nwg % NXCD, xcd = wgid % NXCD, off = wgid / NXCD; wgid = (xcd < r ? xcd * (q + 1) : r * (q + 1) + (xcd - r) * q) + off; }
        const int nig = WGM * nN, gid = wgid / nig, fm = gid * WGM, gsz = (nM - fm) < WGM ? (nM - fm) : WGM;
        u.pm = fm + ((wgid % nig) % gsz); u.pn = (wgid % nig) / gsz; return true;
    }
};
struct CmpOrder {
    int G, c;
    __device__ bool next(int i, Unit& u) const { const int L = i * G + c; if (L >= 32) return false; u.pm = L; u.pn = L >> 4; return true; }
};

template <class Epi, class Sched>
__device__ __forceinline__ void gemm_phase(LAS unsigned char* lds, const Gemm g, const Sched& S, const Epi& E) {
    const int tid = my_tid(), wid = __builtin_amdgcn_readfirstlane(tid >> 6), lane = tid & 63, wr = wid >> 2, wc = wid & 3, fr = lane & 15, fq = lane >> 4;
    const int K = g.K, nt = K / BK, lda = g.lda;
    unsigned voffA, voffB;
    { int R, C; stage_rc(tid * 16, R, C); const int Rb = (R & ~31) + perm32(R & 31);
        voffA = (unsigned)(R * lda + C) * 2u; voffB = (unsigned)(Rb * K + C) * 2u; }
    const size_t qvoffA = (size_t)64 * lda * 2, qvoffB = (size_t)64 * K * 2;
    const size_t kstep = (size_t)(BK * 2);
    const size_t hstepA = (size_t)HALF * lda * 2, hstepB = (size_t)HALF * K * 2;
    const size_t tstepA = 2 * hstepA, tstepB = 2 * hstepB;
    const unsigned ldsw = (unsigned)wid * 1024u;
    const int aoff = lds_byte(wr * 64 + fr, fq * 8), boff = lds_byte(wc * 32 + fr, fq * 8);
#define PG8_SA(b, h) (((b) * 2 + (h)) * HTB)
#define PG8_SB(b, h) ((4 + (b) * 2 + (h)) * HTB)
#define PG8_STAGE(bufoff, gbase, voff) do { _Pragma("unroll") for (int _i = 0; _i < 2; ++_i) \
        __builtin_amdgcn_global_load_lds((const unsigned*)((const char*)(gbase) + (size_t)_i * q##voff + (voff)), (LAS unsigned*)(lds + (bufoff) + ldsw + _i * 8192), 16, 0, 0); } while (0)
#define PG8_LDA(dst, b, h) do { _Pragma("unroll") for (int m = 0; m < 4; ++m) _Pragma("unroll") for (int k = 0; k < 2; ++k) dst[m][k] = *(const LAS bf16x8*)(lds + PG8_SA(b, h) + aoff + m * 2048 + k * 1024); } while (0)
#define PG8_LDB(dst, b, h) do { _Pragma("unroll") for (int n = 0; n < 2; ++n) _Pragma("unroll") for (int k = 0; k < 2; ++k) dst[n][k] = *(const LAS bf16x8*)(lds + PG8_SB(b, h) + boff + n * 2048 + k * 1024); } while (0)
#define PG8_MMA(ai, bj, At, Bt) do { __builtin_amdgcn_s_setprio(1); _Pragma("unroll") for (int m = 0; m < 4; ++m) _Pragma("unroll") for (int n = 0; n < 2; ++n) _Pragma("unroll") for (int k = 0; k < 2; ++k) \
        acc[ai][bj][m][n] = __builtin_amdgcn_mfma_f32_16x16x32_bf16(Bt[n][k], At[m][k], acc[ai][bj][m][n], 0, 0, 0); __builtin_amdgcn_s_setprio(0); } while (0)
#define PG8_WAIT_V(n) asm volatile("s_waitcnt vmcnt(" #n ")" ::: "memory")
#define PG8_WAIT_L(n) asm volatile("s_waitcnt lgkmcnt(" #n ")" ::: "memory")
#define PG8_BAR __builtin_amdgcn_s_barrier()
#define PG8_SCHED __builtin_amdgcn_sched_barrier(0)
    Unit cur, nxt; int ui = 0;
    if (!S.next(0, cur)) return;
    f32x4 acc[2][2][4][2];
#pragma unroll
    for (int a = 0; a < 2; ++a)
#pragma unroll
        for (int b = 0; b < 2; ++b)
#pragma unroll
            for (int m = 0; m < 4; ++m)
#pragma unroll
                for (int n = 0; n < 2; ++n) acc[a][b][m][n] = (f32x4){0.f, 0.f, 0.f, 0.f};
    bf16x8 At[4][2], B0[2][2], B1[2][2];
    const char* cA = (const char*)g.A + (size_t)cur.pm * tstepA; const char* cB = (const char*)g.Bt + (size_t)cur.pn * tstepB;
    PG8_STAGE(PG8_SB(0, 0), cB, voffB); PG8_STAGE(PG8_SB(0, 1), cB + hstepB, voffB); PG8_STAGE(PG8_SA(0, 0), cA, voffA); PG8_STAGE(PG8_SA(0, 1), cA + hstepA, voffA);
    if (wr == 1) PG8_BAR;
    PG8_WAIT_V(2); PG8_BAR;
    PG8_STAGE(PG8_SB(1, 0), cB + kstep, voffB); PG8_STAGE(PG8_SA(1, 0), cA + kstep, voffA); PG8_STAGE(PG8_SB(1, 1), cB + hstepB + kstep, voffB);
    PG8_WAIT_V(6); PG8_BAR;
    for (;;) {
        const bool has_next = S.next(ui + 1, nxt);
        const char* nA = has_next ? (const char*)g.A + (size_t)nxt.pm * tstepA : cA; const char* nB = has_next ? (const char*)g.Bt + (size_t)nxt.pn * tstepB : cB;
        for (int t = 0; t < nt; t += 2) {
            const bool last = (t == nt - 2);
            const char* a1 = cA + (size_t)(t + 1) * kstep;
            const char* a2 = last ? nA : cA + (size_t)(t + 2) * kstep; const char* b2 = last ? nB : cB + (size_t)(t + 2) * kstep;
            const char* a3 = a2 + kstep; const char* b3 = b2 + kstep;
            PG8_LDB(B0, 0, 0); PG8_LDB(B1, 0, 1); PG8_SCHED; PG8_LDA(At, 0, 0); PG8_STAGE(PG8_SA(1, 1), a1 + hstepA, voffA);
            PG8_WAIT_V(8); PG8_WAIT_L(0); PG8_BAR; PG8_MMA(0, 0, At, B0); PG8_MMA(0, 1, At, B1); PG8_BAR; PG8_SCHED;
            PG8_LDA(At, 0, 1); PG8_STAGE(PG8_SB(0, 0), b2, voffB); PG8_STAGE(PG8_SB(0, 1), b2 + hstepB, voffB); PG8_STAGE(PG8_SA(0, 0), a2, voffA);
            PG8_WAIT_V(8); PG8_WAIT_L(0); PG8_BAR; PG8_MMA(1, 0, At, B0); PG8_MMA(1, 1, At, B1); PG8_BAR; PG8_SCHED;
            PG8_LDB(B0, 1, 0); PG8_LDB(B1, 1, 1); PG8_SCHED; PG8_LDA(At, 1, 0); PG8_STAGE(PG8_SA(0, 1), a2 + hstepA, voffA);
            PG8_WAIT_V(8); PG8_WAIT_L(0); PG8_BAR; PG8_MMA(0, 0, At, B0); PG8_MMA(0, 1, At, B1); PG8_BAR; PG8_SCHED;
            PG8_LDA(At, 1, 1); PG8_STAGE(PG8_SB(1, 0), b3, voffB); PG8_STAGE(PG8_SB(1, 1), b3 + hstepB, voffB); PG8_STAGE(PG8_SA(1, 0), a3, voffA);
            PG8_WAIT_V(8); PG8_WAIT_L(0); PG8_BAR; PG8_MMA(1, 0, At, B0); PG8_MMA(1, 1, At, B1); PG8_BAR; PG8_SCHED;
        }
        if (wr == 0) PG8_BAR;
        E(acc, cur, wr, wc, fr, fq);
        if (!has_next) break;
#pragma unroll
        for (int a = 0; a < 2; ++a)
#pragma unroll
            for (int b = 0; b < 2; ++b)
#pragma unroll
                for (int m = 0; m < 4; ++m)
#pragma unroll
                    for (int n = 0; n < 2; ++n) acc[a][b][m][n] = (f32x4){0.f, 0.f, 0.f, 0.f};
        cur = nxt; cA = nA; cB = nB; ++ui;
        if (wr == 1) PG8_BAR;
    }
    PG8_WAIT_V(0);
    PG8_BAR;
#undef PG8_SA
#undef PG8_SB
#undef PG8_STAGE
#undef PG8_LDA
#undef PG8_LDB
#undef PG8_MMA
#undef PG8_WAIT_V
#undef PG8_WAIT_L
#undef PG8_BAR
#undef PG8_SCHED
}
}
using pg8::Unit;

DI void store8(bf16_t* p, const float (&v)[8]) { u32x4 w = {pk2(v[0], v[1]), pk2(v[2], v[3]), pk2(v[4], v[5]), pk2(v[6], v[7])}; *(u32x4*)p = w; }
DI void rope8(float (&v)[8], const f32x2* cs) {
    const f32x4 c0 = *(const f32x4*)cs, c1 = *(const f32x4*)(cs + 2);
    const float co[4] = {c0[0], c0[2], c1[0], c1[2]}, si[4] = {c0[1], c0[3], c1[1], c1[3]};
#pragma unroll
    for (int k = 0; k < 4; ++k) { const float a = v[2 * k], b = v[2 * k + 1]; v[2 * k] = a * co[k] - b * si[k]; v[2 * k + 1] = a * si[k] + b * co[k]; }
}
DI float sumsq_fq(const float (&v)[8]) {
    float s = 0.f;
#pragma unroll
    for (int e = 0; e < 8; ++e) s += v[e] * v[e];
    s += __shfl_xor(s, 16); s += __shfl_xor(s, 32); return s;
}

template <class Impl> struct EpiWrap : Impl {
    static constexpr bool MID = false;
    DI void operator()(const f32x4 (&acc)[2][2][4][2], const Unit& u, int wr, int wc, int, int) const {
        const int t2 = my_tid(), fr = t2 & 15, fq = (t2 >> 4) & 3;
#pragma unroll
        for (int ai = 0; ai < 2; ++ai)
#pragma unroll
            for (int m = 0; m < 4; ++m)
#pragma unroll
                for (int bj = 0; bj < 2; ++bj) {
                    const f32x4 a0 = acc[ai][bj][m][0], a1 = acc[ai][bj][m][1];
                    float v[8] = {a0[0], a0[1], a0[2], a0[3], a1[0], a1[1], a1[2], a1[3]};
                    this->chunk(u.pm * 256 + ai * 128 + wr * 64 + m * 16 + fr, u.pn, bj * 128 + wc * 32 + 8 * fq, v);
                }
    }
};

#define WSP(T, off) ((T*)(ws + (off)))
struct EpiInImpl {
    unsigned char* ws;
    DI void chunk(int row, int pn, int cc, float (&v)[8]) const {
        const int pos = row & (S - 1), b = row >> 12;
        bf16_t* const QN = WSP(bf16_t, WS_QN); bf16_t* const KCV = WSP(bf16_t, WS_KCV); bf16_t* const CQ = WSP(bf16_t, WS_CQ); bf16_t* const T6 = WSP(bf16_t, WS_T6);
        bf16_t* const KPE = WSP(bf16_t, WS_KPE); float* const GN = WSP(float, WS_GN); float* const PQ = WSP(float, WS_PQ); float* const PKV = WSP(float, WS_PKV);
        const f32x2* const CS64 = WSP(const f32x2, WS_CS64); const f32x2* const CS32 = WSP(const f32x2, WS_CS32);
        if (pn < 2) {
            rope8(v, CS64 + pos * 32 + ((cc & 63) >> 1));
            store8(QN + (size_t)row * 512 + pn * 256 + cc, v);
        } else if (pn < 5) {
            const int kv = cc >> 7, g = (cc >> 6) & 1, p = cc & 63, bg = b * 2 + g;
            if (kv == 0) {
                rope8(v, CS64 + pos * 32 + (p >> 1));
                bf16_t* dst = WSP(bf16_t, pn == 2 ? WS_KCV : (pn == 3 ? WS_KS : WS_KW));
                store8(dst + ((size_t)bg * S + pos) * 64 + p, v);
            } else if (pn == 2) {
                store8(KCV + ((size_t)(16 + bg) * S + pos) * 64 + p, v);
            } else {
                bf16_t* dst = WSP(bf16_t, pn == 3 ? WS_VST : WS_VWT);
#pragma unroll
                for (int e = 0; e < 8; ++e) dst[((size_t)bg * 64 + p + e) * S + pos] = f2bf(v[e]);
            }
        } else if (pn == 5) {
            store8(CQ + (size_t)row * 256 + cc, v);
            const float s = sumsq_fq(v);
            if ((threadIdx.x & 48) == 0) PQ[(size_t)row * 8 + (cc >> 5)] = s;
        } else if (pn == 6) {
            store8(T6 + (size_t)row * 256 + cc, v);
            if (cc < 128) {
                const float s = sumsq_fq(v);
                if ((threadIdx.x & 48) == 0) PKV[(size_t)row * 4 + (cc >> 5)] = s;
            } else if (cc < 160) {
                rope8(v, CS32 + pos * 16 + ((cc - 128) >> 1));
                store8(KPE + (size_t)row * 32 + (cc - 128), v);
            } else if (cc < 184) {
#pragma unroll
                for (int e = 0; e < 8; ++e) GN[(size_t)row * 24 + (cc - 160) + e] = sigmoidf_(v[e]);
            }
        } else {
#pragma unroll
            for (int e = 0; e < 8; ++e) v[e] = sigmoidf_(v[e]);
            if (pn < 11) store8(WSP(bf16_t, WS_GA) + (size_t)row * 1024 + (pn - 7) * 256 + cc, v);
            else store8(WSP(bf16_t, WS_GB) + (size_t)row * 1024 + (pn - 11) * 256 + cc, v);
        }
    }
};
struct EpiC1Impl {
    unsigned char* ws;
    DI void chunk(int row, int pn, int cc, float (&v)[8]) const {
        bf16_t* const HC = WSP(bf16_t, WS_HC); const float* const CB1 = WSP(const float, WS_CB1);
        const f32x4 b0 = *(const f32x4*)(CB1 + pn * 256 + cc), b1 = *(const f32x4*)(CB1 + pn * 256 + cc + 4);
        const float bb[8] = {b0[0], b0[1], b0[2], b0[3], b1[0], b1[1], b1[2], b1[3]};
#pragma unroll
        for (int e = 0; e < 8; ++e) { const float x = v[e] + bb[e]; v[e] = x / (1.f + __expf(-x)); }
        store8(HC + (size_t)row * 256 + cc, v);
    }
};
struct EpiC2Impl {
    unsigned char* ws;
    DI void chunk(int row, int pn, int cc, float (&v)[8]) const {
        if (cc >= 64) return;
        bf16_t* const KCMP = WSP(bf16_t, WS_KCMP); bf16_t* const VCMPT = WSP(bf16_t, WS_VCMPT);
        const int bg = (row >> 8) & 15, n = row & 255;
        if (n == 255) {
#pragma unroll
            for (int e = 0; e < 8; ++e) v[e] = 0.f;
        }
        if (pn == 0) store8(KCMP + ((size_t)bg * 256 + n) * 64 + cc, v);
        else {
#pragma unroll
            for (int e = 0; e < 8; ++e) VCMPT[((size_t)bg * 64 + cc + e) * 256 + n] = f2bf(v[e]);
        }
    }
};
struct EpiUQImpl {
    unsigned char* ws;
    DI void chunk(int row, int pn, int cc, float (&v)[8]) const {
        bf16_t* const QM = WSP(bf16_t, WS_QM); const float* const PQ = WSP(const float, WS_PQ); const f32x2* const CS32 = WSP(const f32x2, WS_CS32);
        const int c = pn * 256 + cc, hh = c / 96, c96 = c - hh * 96, pos = row & (S - 1);
        const f32x4 p0 = *(const f32x4*)(PQ + (size_t)row * 8), p1 = *(const f32x4*)(PQ + (size_t)row * 8 + 4);
        const float rstd = rsqrtf((((p0[0] + p0[1]) + (p0[2] + p0[3])) + ((p1[0] + p1[1]) + (p1[2] + p1[3]))) * (1.f / 256.f) + EPS);
#pragma unroll
        for (int e = 0; e < 8; ++e) v[e] *= rstd;
        if (c96 >= 64) rope8(v, CS32 + pos * 16 + ((c96 - 64) >> 1));
        store8(QM + (size_t)row * 768 + c, v);
    }
};
struct EpiUKVImpl {
    unsigned char* ws;
    DI void chunk(int row, int pn, int cc, float (&v)[8]) const {
        bf16_t* const KM = WSP(bf16_t, WS_KM); bf16_t* const VMT = WSP(bf16_t, WS_VMT); const float* const PKV = WSP(const float, WS_PKV);
        const int c = pn * 256 + cc, hh = c >> 7, c128 = c & 127, pos = row & (S - 1), b = row >> 12;
        const f32x4 p0 = *(const f32x4*)(PKV + (size_t)row * 4);
        const float rstd = rsqrtf(((p0[0] + p0[1]) + (p0[2] + p0[3])) * (1.f / 128.f) + EPS);
#pragma unroll
        for (int e = 0; e < 8; ++e) v[e] *= rstd;
        if (c128 < 64) store8(KM + ((size_t)(b * 8 + hh) * S + pos) * 64 + c128, v);
        else {
#pragma unroll
            for (int e = 0; e < 8; ++e) VMT[((size_t)(b * 8 + hh) * 64 + (c128 - 64) + e) * S + pos] = f2bf(v[e]);
        }
    }
};
struct EpiD2Impl {
    const float* xin; float* X;
    DI void chunk(int row, int pn, int cc, float (&v)[8]) const {
        const size_t o = (size_t)row * 1024 + pn * 256 + cc;
        const f32x4 x0 = *(const f32x4*)(xin + o), x1 = *(const f32x4*)(xin + o + 4);
        *(f32x4*)(X + o) = (f32x4){x0[0] + v[0], x0[1] + v[1], x0[2] + v[2], x0[3] + v[3]};
        *(f32x4*)(X + o + 4) = (f32x4){x1[0] + v[4], x1[1] + v[5], x1[2] + v[6], x1[3] + v[7]};
    }
};
struct EpiUpImpl {
    unsigned char* ws;
    DI void chunk(int row, int pn, int cc, float (&v)[8]) const {
        bf16_t* const HF = WSP(bf16_t, WS_HF);
#pragma unroll
        for (int e = 0; e < 8; ++e) { const float r = fmaxf(v[e], 0.f); v[e] = r * r; }
        store8(HF + (size_t)row * FF + pn * 256 + cc, v);
    }
};
struct EpiD1aImpl {
    unsigned char* ws;
    DI void chunk(int row, int pn, int cc, float (&v)[8]) const {
        const size_t o = (size_t)row * 1024 + pn * 256 + cc;
        const u32x4 a = *(const u32x4*)(WSP(const bf16_t, WS_GA) + o);
        v[0] *= bflo(a[0]); v[1] *= bfhi(a[0]); v[2] *= bflo(a[1]); v[3] *= bfhi(a[1]); v[4] *= bflo(a[2]); v[5] *= bfhi(a[2]); v[6] *= bflo(a[3]); v[7] *= bfhi(a[3]);
        store8(WSP(bf16_t, WS_MG) + o, v);
    }
};
struct EpiD1bImpl {
    unsigned char* ws;
    DI void chunk(int row, int pn, int cc, float (&v)[8]) const {
        const size_t o = (size_t)row * 1024 + pn * 256 + cc;
        const u32x4 b = *(const u32x4*)(WSP(const bf16_t, WS_GB) + o), g = *(const u32x4*)(WSP(const bf16_t, WS_MG) + o);
        v[0] = bflo(g[0]) + v[0] * bflo(b[0]); v[1] = bfhi(g[0]) + v[1] * bfhi(b[0]); v[2] = bflo(g[1]) + v[2] * bflo(b[1]); v[3] = bfhi(g[1]) + v[3] * bfhi(b[1]);
        v[4] = bflo(g[2]) + v[4] * bflo(b[2]); v[5] = bfhi(g[2]) + v[5] * bfhi(b[2]); v[6] = bflo(g[3]) + v[6] * bflo(b[3]); v[7] = bfhi(g[3]) + v[7] * bfhi(b[3]);
        store8(WSP(bf16_t, WS_MG) + o, v);
    }
};

#define MFMA32(a, b, c) __builtin_amdgcn_mfma_f32_32x32x16_bf16((a), (b), (c), 0, 0, 0)

template <int DQK> DI void qk_tile(const LAS unsigned char* sK, const bf16x8 (&qf)[DQK / 16], f32x16 (&s)[2], int lane) {
    constexpr int KSTR = DQK * 2 + 16;
    const int r = lane & 31, h = lane >> 5;
    const int rp = (r & 0x13) | ((r & 4) << 1) | ((r & 8) >> 1);
    bf16x8 kf[2][DQK / 16];
#pragma unroll
    for (int kt = 0; kt < 2; ++kt)
#pragma unroll
        for (int ks = 0; ks < DQK / 16; ++ks) kf[kt][ks] = *(const LAS bf16x8*)(sK + (32 * kt + rp) * KSTR + ks * 32 + h * 16);
    __builtin_amdgcn_sched_barrier(0);
#pragma unroll
    for (int kt = 0; kt < 2; ++kt) {
        f32x16 a;
#pragma unroll
        for (int i = 0; i < 16; ++i) a[i] = 0.f;
#pragma unroll
        for (int ks = 0; ks < DQK / 16; ++ks) a = MFMA32(kf[kt][ks], qf[ks], a);
        s[kt] = a;
    }
}
DI void v_load(bf16x8 (&vf)[2][2][2], const LAS unsigned char* sV, int lane) {
    const int h = lane >> 5, r = lane & 31;
#pragma unroll
    for (int kt = 0; kt < 2; ++kt)
#pragma unroll
        for (int s2 = 0; s2 < 2; ++s2)
#pragma unroll
            for (int dt = 0; dt < 2; ++dt) vf[kt][s2][dt] = *(const LAS bf16x8*)(sV + (32 * dt + r) * 144 + (32 * kt + 16 * s2 + 8 * h) * 2);
}

template <bool LANEOFF> DI void pack_p(const f32x16 (&s)[2], unsigned keep, u32x4 (&pp)[4]) {
#pragma unroll
    for (int kt = 0; kt < 2; ++kt)
#pragma unroll
        for (int s2 = 0; s2 < 2; ++s2) {
            u32x4 pw = {pk2(s[kt][8 * s2 + 0], s[kt][8 * s2 + 1]), pk2(s[kt][8 * s2 + 2], s[kt][8 * s2 + 3]),
                        pk2(s[kt][8 * s2 + 4], s[kt][8 * s2 + 5]), pk2(s[kt][8 * s2 + 6], s[kt][8 * s2 + 7])};
            if constexpr (LANEOFF) { pw[0] &= keep; pw[1] &= keep; pw[2] &= keep; pw[3] &= keep; }
            pp[kt * 2 + s2] = pw;
        }
}
DI void pv_packed(const u32x4 (&pp)[4], const bf16x8 (&vf)[2][2][2], f32x16 (&o)[2]) {
#pragma unroll
    for (int kt = 0; kt < 2; ++kt)
#pragma unroll
        for (int s2 = 0; s2 < 2; ++s2) {
            const bf16x8 pb = __builtin_bit_cast(bf16x8, pp[kt * 2 + s2]);
#pragma unroll
            for (int dt = 0; dt < 2; ++dt) o[dt] = MFMA32(vf[kt][s2][dt], pb, o[dt]);
        }
}
template <class Mask> DI void mask_apply(f32x16 (&s)[2], int tile, const Mask& mask, int lane) {
    const int h = lane >> 5;
#pragma unroll
    for (int kt = 0; kt < 2; ++kt)
#pragma unroll
        for (int reg = 0; reg < 16; ++reg) {
            const int key = 32 * kt + (reg & 7) + 8 * h + 16 * (reg >> 3);
            s[kt][reg] = mask(tile, key) ? s[kt][reg] : -1e30f;
        }
}
DI float vmax3(float a, float b, float c) { float r; asm("v_max3_f32 %0, %1, %2, %3" : "=v"(r) : "v"(a), "v"(b), "v"(c)); return r; }
template <bool LANEOFF> DI void softmax_full(f32x16 (&s)[2], bool lane_on, float c, float& m, float& l, f32x16 (&o)[2]) {
    __builtin_amdgcn_sched_barrier(0);
    asm volatile("s_nop 11" ::: "memory");
    __builtin_amdgcn_sched_barrier(0);
    float x0 = vmax3(s[0][0], s[1][0], s[0][1]), x1 = vmax3(s[1][1], s[0][2], s[1][2]);
#pragma unroll
    for (int reg = 3; reg < 15; reg += 2) { x0 = vmax3(x0, s[0][reg], s[1][reg]); x1 = vmax3(x1, s[0][reg + 1], s[1][reg + 1]); }
    float mx = vmax3(x0, x1, s[0][15]);
    mx = fmaxf(mx, s[1][15]);
    mx = fmaxf(mx, __shfl_xor(mx, 32));
    if constexpr (LANEOFF) mx = lane_on ? mx : -1e30f;
    const float mn = fmaxf(m, mx);
    const float alpha = ex2((m - mn) * c);
    l *= alpha; o[0] *= alpha; o[1] *= alpha;
    m = mn;
    const float nmc = -fmaxf(mn, -1e29f) * c;
    float sum0 = 0.f, sum1 = 0.f;
#pragma unroll
    for (int kt = 0; kt < 2; ++kt)
#pragma unroll
        for (int reg = 0; reg < 16; reg += 2) {
            const float p0 = ex2(__builtin_fmaf(s[kt][reg], c, nmc)), p1 = ex2(__builtin_fmaf(s[kt][reg + 1], c, nmc));
            s[kt][reg] = p0; s[kt][reg + 1] = p1; sum0 += p0; sum1 += p1;
        }
    float sum = sum0 + sum1;
    if constexpr (LANEOFF) sum = lane_on ? sum : 0.f;
    l += sum;
}

struct TileRegs { u32x4 k, v, p; };
template <int DQK, bool LANEOFF, bool STAG, class TileOf, class Mask, class Skip>
DI void attn_run(LAS unsigned char* lds, const bf16_t* Kg, const bf16_t* Kpe, const bf16_t* Vg, int ldv, int ntiles,
                 const TileOf& tile_of, const Mask& mask, const Skip& skip, float c, const bf16x8 (&qf)[DQK / 16], float& m, float& l, f32x16 (&o)[2]) {
    constexpr int KSTR = DQK * 2 + 16;
    const int tid = my_tid(), lane = tid & 63;
    const int krow = tid >> 3, kch = tid & 7, prow = (tid >> 2) & 63, pch = tid & 3;
    TileRegs RA, RB;
    asm volatile("" : "=v"(RA.k), "=v"(RA.v), "=v"(RA.p), "=v"(RB.k), "=v"(RB.v), "=v"(RB.p));
#define ATT_LOAD(R, tt) do { const int t_ = (tt); (R).k = *(const u32x4*)(Kg + ((size_t)(t_ * 64 + krow)) * 64 + kch * 8); (R).v = *(const u32x4*)(Vg + (size_t)krow * ldv + t_ * 64 + kch * 8); \
        if constexpr (DQK == 96) { if (tid < 256) (R).p = *(const u32x4*)(Kpe + ((size_t)(t_ * 64 + prow)) * 32 + pch * 8); } } while (0)
#define ATT_WRITE(R, kb_, vb_) do { *(LAS u32x4*)(lds + AT_K + (kb_) + krow * KSTR + kch * 16) = (R).k; *(LAS u32x4*)(lds + AT_V + (vb_) + krow * 144 + kch * 16) = (R).v; \
        if constexpr (DQK == 96) { if (tid < 256) *(LAS u32x4*)(lds + AT_K + (kb_) + prow * KSTR + 128 + pch * 16) = (R).p; } } while (0)
#define ATT_ITER(i_, RL, RW) do { const int t = tile_of(i_); const int kb = ((i_) & 1) * AT_KB, vb = ((i_) & 1) * AT_VB; \
        if ((i_) + 2 < ntiles) ATT_LOAD(RL, tile_of((i_) + 2)); \
        if (!skip(t)) { \
            f32x16 s[2]; \
            qk_tile<DQK>(lds + AT_K + kb, qf, s, lane); \
            bf16x8 vf[2][2][2]; v_load(vf, lds + AT_V + vb, lane); \
            unsigned keep = 0xffffffffu; \
            const bool fullt = mask.full(t); const bool on = fullt ? mask.lane_on(t) : true; \
            if (!fullt) mask_apply(s, t, mask, lane); \
            softmax_full<LANEOFF>(s, on, c, m, l, o); if constexpr (LANEOFF) keep = on ? 0xffffffffu : 0u; \
            u32x4 pp[4]; pack_p<LANEOFF>(s, keep, pp); pv_packed(pp, vf, o); \
        } \
        if ((i_) + 1 < ntiles) ATT_WRITE(RW, AT_KB - kb, AT_VB - vb); \
        __syncthreads(); } while (0)
    __syncthreads();
    if (ntiles > 0) { ATT_LOAD(RA, tile_of(0)); ATT_WRITE(RA, 0, 0); }
    if (ntiles > 1) ATT_LOAD(RB, tile_of(1));
    __syncthreads();
    for (int i = 0; i < ntiles; i += 2) {
        ATT_ITER(i, RA, RB);
        if (i + 1 < ntiles) ATT_ITER(i + 1, RB, RA);
    }
#undef ATT_LOAD
#undef ATT_WRITE
#undef ATT_ITER
}

struct TileId { DI int operator()(int i) const { return i; } };
struct TileOff { int off; DI int operator()(int i) const { return off + i; } };
struct TileList { const LAS int* lst; DI int operator()(int i) const { return lst[i]; } };
struct NoSkip { DI bool operator()(int) const { return false; } };
struct SkipAbove { int tmax; DI bool operator()(int t) const { return t * 64 > tmax; } };
struct MaskCmp { int tq;
    DI bool operator()(int t, int key) const { return 16 * (64 * t + key) + 31 <= tq; }
    DI bool full(int) const { return false; } DI bool lane_on(int) const { return true; } };
struct MaskSlc { int tq; unsigned lo, hi; int qt;
    DI bool bit(int t) const { return ((t < 32 ? (lo >> t) : (hi >> (t - 32))) & 1u) != 0u; }
    DI bool operator()(int t, int key) const { return bit(t) && (64 * t + key <= tq); }
    DI bool full(int t) const { return t < qt; } DI bool lane_on(int t) const { return bit(t); } };
struct MaskWin { int tq, tq0w;
    DI bool operator()(int t, int key) const { const int d = tq - (64 * t + key); return d >= 0 && d < 512; }
    DI bool full(int t) const { return (64 * t + 63 <= tq0w) && (tq0w + 31 - 64 * t <= 511); } DI bool lane_on(int) const { return true; } };
struct MaskCausal { int tq, tq0w;
    DI bool operator()(int t, int key) const { return 64 * t + key <= tq; }
    DI bool full(int t) const { return 64 * t + 63 <= tq0w; } DI bool lane_on(int) const { return true; } };

struct Bufs {
    const bf16_t *QN, *KS, *KW, *VST, *VWT, *KCMP, *VCMPT, *QM, *KM, *KPE, *VMT; const float* GN; bf16_t* OAB;
};

DI void zero16(f32x16& v) {
#pragma unroll
    for (int i = 0; i < 16; ++i) v[i] = 0.f;
}

DI void nsa_unit(const Bufs& B, LAS unsigned char* lds, int b, int g, int qt) {
    const int tid = my_tid(), lane = tid & 63, w = __builtin_amdgcn_readfirstlane(tid >> 6), r = w >> 1, hh = lane >> 5;
    const int qs = (w & 1) * 32 + (lane & 31), bg = b * 2 + g, tq = qt * 64 + qs, head = g * 4 + r;
    const size_t row = (size_t)b * S + tq;
    LAS unsigned* sImp = (LAS unsigned*)(lds + AT_IMP);
    LAS unsigned* sSel = (LAS unsigned*)(lds + AT_SEL);
    LAS int* sList = (LAS int*)(lds + AT_LIST);
    LAS int* sCnt = (LAS int*)(lds + AT_CNT);
    bf16x8 qf[4];
#pragma unroll
    for (int ks = 0; ks < 4; ++ks) qf[ks] = *(const bf16x8*)(B.QN + row * 512 + head * 64 + ks * 16 + hh * 8);
    for (int i = tid; i < 4096; i += 512) sImp[i] = 0u;
    const float c = 0.125f * LOG2E;
    LAS float* stash = (LAS float*)(lds + AT_ACC + w * 8192) + lane;
    float m, l; f32x16 o[2];
    const int nct = (4 * qt + 2) / 64 + 1;
    m = -1e30f; l = 0.f; zero16(o[0]); zero16(o[1]);
    attn_run<64, false, STAG_CMP>(lds, B.KCMP + (size_t)bg * 256 * 64, nullptr, B.VCMPT + (size_t)bg * 64 * 256, 256, nct, TileId{}, MaskCmp{tq}, NoSkip{}, c, qf, m, l, o);
    const float nmc = -m * c;
    float inv;
    { const float lt = l + __shfl_xor(l, 32); inv = lt > 0.f ? 1.f / lt : 0.f; }
    { const float ig0 = inv * B.GN[row * 24 + head];
#pragma unroll
    for (int dt = 0; dt < 2; ++dt)
#pragma unroll
        for (int e = 0; e < 16; ++e) stash[(dt * 16 + e) * 64] = o[dt][e] * ig0; }
    for (int ct = 0; ct < nct; ++ct) {
        __syncthreads();
        { const int krow = tid >> 3, kch = tid & 7;
          *(LAS u32x4*)(lds + AT_K + krow * 144 + kch * 16) = *(const u32x4*)(B.KCMP + ((size_t)bg * 256 + ct * 64 + krow) * 64 + kch * 8); }
        __syncthreads();
        f32x16 s[2];
        qk_tile<64>(lds + AT_K, qf, s, lane);
#pragma unroll
        for (int kt = 0; kt < 2; ++kt)
#pragma unroll
            for (int a = 0; a < 4; ++a) {
                float pv[4];
#pragma unroll
                for (int bb = 0; bb < 4; ++bb) {
                    const int reg = 4 * a + bb;
                    const int n = 64 * ct + 32 * kt + (reg & 7) + 8 * hh + 16 * (reg >> 3);
                    pv[bb] = (16 * n + 31 <= tq) ? ex2(__builtin_fmaf(s[kt][reg], c, nmc)) * inv : 0.f;
                }
                const int j = 16 * ct + 8 * kt + (a & 1) + 2 * hh + 4 * (a >> 1);
                const float carry = 0.5f * pv[3], direct = (pv[0] + pv[1]) + (pv[2] + carry);
                if (direct > 0.f) __hip_atomic_fetch_add(sImp + qs * 64 + j, (unsigned)(direct * 268435456.f + 0.5f), __ATOMIC_RELAXED, __HIP_MEMORY_SCOPE_WORKGROUP);
                if (carry > 0.f && j < 63) __hip_atomic_fetch_add(sImp + qs * 64 + j + 1, (unsigned)(carry * 268435456.f + 0.5f), __ATOMIC_RELAXED, __HIP_MEMORY_SCOPE_WORKGROUP);
            }
    }
    __syncthreads();
    {
        const int q = tid >> 3, sub = tid & 7;
        unsigned bits = 0;
        if (qt < 16) {
#pragma unroll
            for (int k = 0; k < 8; ++k) if (sub * 8 + k <= qt) bits |= 1u << k;
        } else {
            unsigned v[8]; int cnt[8];
#pragma unroll
            for (int k = 0; k < 8; ++k) { v[k] = sImp[q * 64 + sub * 8 + k]; cnt[k] = 0; }
            for (int jp = 1; jp <= qt - 2; ++jp) {
                const unsigned vp = sImp[q * 64 + jp];
#pragma unroll
                for (int k = 0; k < 8; ++k) cnt[k] += (vp > v[k] || (vp == v[k] && jp < sub * 8 + k)) ? 1 : 0;
            }
#pragma unroll
            for (int k = 0; k < 8; ++k) {
                const int j = sub * 8 + k;
                const bool forced = (j == 0) || (j == qt) || (j == qt - 1), cand = (j >= 1) && (j <= qt - 2);
                if (forced || (cand && cnt[k] < 13)) bits |= 1u << k;
            }
        }
        unsigned lo = sub < 4 ? bits << (sub * 8) : 0u, hi = sub >= 4 ? bits << ((sub - 4) * 8) : 0u;
        lo |= __shfl_xor(lo, 1); hi |= __shfl_xor(hi, 1); lo |= __shfl_xor(lo, 2); hi |= __shfl_xor(hi, 2); lo |= __shfl_xor(lo, 4); hi |= __shfl_xor(hi, 4);
        if (sub == 0) { sSel[q * 2] = lo; sSel[q * 2 + 1] = hi; }
    }
    __syncthreads();
    if (w == 0) {
        unsigned lo = sSel[lane * 2], hi = sSel[lane * 2 + 1];
#pragma unroll
        for (int x = 1; x < 64; x <<= 1) { lo |= __shfl_xor(lo, x); hi |= __shfl_xor(hi, x); }
        if (lane == 0) {
            int n = 0;
            for (int j = 0; j <= qt; ++j) { const unsigned bit = j < 32 ? (lo >> j) : (hi >> (j - 32)); if (bit & 1u) sList[n++] = j; }
            *sCnt = n;
        }
    }
    __syncthreads();
    {
        const int nsel = *sCnt;
        const unsigned lo = sSel[qs * 2], hi = sSel[qs * 2 + 1];
        m = -1e30f; l = 0.f; zero16(o[0]); zero16(o[1]);
        attn_run<64, true, STAG_SLC>(lds, B.KS + (size_t)bg * S * 64, nullptr, B.VST + (size_t)bg * 64 * S, S, nsel, TileList{sList}, MaskSlc{tq, lo, hi, qt}, NoSkip{}, c, qf, m, l, o);
        const float lt = l + __shfl_xor(l, 32); const float iv = (lt > 0.f ? 1.f / lt : 0.f) * B.GN[row * 24 + 8 + head];
#pragma unroll
        for (int dt = 0; dt < 2; ++dt)
#pragma unroll
            for (int e = 0; e < 16; ++e) stash[(dt * 16 + e) * 64] += o[dt][e] * iv;
    }
    {
        const int t0 = qt >= 8 ? qt - 8 : 0;
        m = -1e30f; l = 0.f; zero16(o[0]); zero16(o[1]);
        attn_run<64, false, STAG_WIN>(lds, B.KW + (size_t)bg * S * 64, nullptr, B.VWT + (size_t)bg * 64 * S, S, qt - t0 + 1, TileOff{t0}, MaskWin{tq, qt * 64 + (w & 1) * 32}, NoSkip{}, c, qf, m, l, o);
        const float lt = l + __shfl_xor(l, 32); const float iv = (lt > 0.f ? 1.f / lt : 0.f) * B.GN[row * 24 + 16 + head];
#pragma unroll
        for (int dt = 0; dt < 2; ++dt)
#pragma unroll
            for (int e = 0; e < 16; ++e) o[dt][e] = stash[(dt * 16 + e) * 64] + o[dt][e] * iv;
    }
    bf16_t* orow = B.OAB + row * 1024 + head * 64;
#pragma unroll
    for (int dt = 0; dt < 2; ++dt)
#pragma unroll
        for (int a = 0; a < 4; ++a) {
            u32x2 w2 = {pk2(o[dt][4 * a], o[dt][4 * a + 1]), pk2(o[dt][4 * a + 2], o[dt][4 * a + 3])};
            *(u32x2*)(orow + 32 * dt + 8 * a + 4 * hh) = w2;
        }
}

DI void mla_unit(const Bufs& B, LAS unsigned char* lds, int b, int h, int qb) {
    const int tid = my_tid(), lane = tid & 63, w = __builtin_amdgcn_readfirstlane(tid >> 6), hh = lane >> 5;
    const int tq = qb * 256 + w * 32 + (lane & 31);
    const size_t row = (size_t)b * S + tq;
    bf16x8 qf[6];
#pragma unroll
    for (int ks = 0; ks < 6; ++ks) qf[ks] = *(const bf16x8*)(B.QM + row * 768 + h * 96 + ks * 16 + hh * 8);
    const float c = 0.10206207261596575f * LOG2E;
    float m = -1e30f, l = 0.f; f32x16 o[2]; zero16(o[0]); zero16(o[1]);
    attn_run<96, false, STAG_MLA>(lds, B.KM + (size_t)(b * 8 + h) * S * 64, B.KPE + (size_t)b * S * 32, B.VMT + (size_t)(b * 8 + h) * 64 * S, S, 4 * (qb + 1),
                 TileId{}, MaskCausal{tq, qb * 256 + w * 32}, SkipAbove{qb * 256 + w * 32 + 31}, c, qf, m, l, o);
    const float lt = l + __shfl_xor(l, 32); const float iv = lt > 0.f ? 1.f / lt : 0.f;
    bf16_t* orow = B.OAB + row * 1024 + 512 + h * 64;
#pragma unroll
    for (int dt = 0; dt < 2; ++dt)
#pragma unroll
        for (int a = 0; a < 4; ++a) {
            u32x2 w2 = {pk2(o[dt][4 * a] * iv, o[dt][4 * a + 1] * iv), pk2(o[dt][4 * a + 2] * iv, o[dt][4 * a + 3] * iv)};
            *(u32x2*)(orow + 32 * dt + 8 * a + 4 * hh) = w2;
        }
}

DI void attn_phase(const Bufs& B, LAS unsigned char* lds, unsigned* counter) {
    LAS int* sUnit = (LAS int*)(lds + MISC_OFF); int it_ = 0; (void)sUnit; (void)it_; (void)counter;
    for (;;) {
#if ATT_STATIC
        __syncthreads();
        const int u = (int)blockIdx.x + 256 * it_; ++it_;
        if (u >= 2048) break;
#else
        __syncthreads();
        if (threadIdx.x == 0) *sUnit = (int)atomicAdd(counter, 1u);
        __syncthreads();
        const int u = *sUnit;
        if (u >= 2048) break;
#endif
        const int i = u >> 1;
        if ((u & 1) == 0) {
#if EXP_ATT == 2
            { const int b = (i & 63) >> 3, h = i & 7, qb = 15 - (i >> 6);
              for (int e = threadIdx.x; e < 2048; e += 512) *(u32x4*)(B.OAB + ((size_t)b * S + qb * 256 + (e >> 3)) * 1024 + 512 + h * 64 + (e & 7) * 8) = (u32x4){0x3c003c00u, 0x3c003c00u, 0x3c003c00u, 0x3c003c00u}; }
#else
            mla_unit(B, lds, (i & 63) >> 3, i & 7, 15 - (i >> 6));
#if ATT_DUP == 1
            __syncthreads(); mla_unit(B, lds, (i & 63) >> 3, i & 7, 15 - (i >> 6));
#endif
#endif
        } else {
#if EXP_ATT == 1
            { const int b = (i & 15) >> 1, g = i & 1, qt = 63 - (i >> 4);
              for (int e = threadIdx.x; e < 2048; e += 512) *(u32x4*)(B.OAB + ((size_t)b * S + qt * 64 + (e >> 5)) * 1024 + g * 256 + (e & 31) * 8) = (u32x4){0x3c003c00u, 0x3c003c00u, 0x3c003c00u, 0x3c003c00u}; }
#else
            nsa_unit(B, lds, (i & 15) >> 1, i & 1, 63 - (i >> 4));
#if ATT_DUP == 2
            __syncthreads(); nsa_unit(B, lds, (i & 15) >> 1, i & 1, 63 - (i >> 4));
#endif
#endif
        }
    }
}

DI float wave_sum(float v) {
#pragma unroll
    for (int o = 1; o < 64; o <<= 1) v += __shfl_xor(v, o);
    return v;
}
DI void norm_rows_bf16(const float* x, const float* g, bf16_t* xn) {
    const int tid_ = my_tid(), lane = tid_ & 63, gw = blockIdx.x * 8 + (tid_ >> 6), ngw = gridDim.x * 8;
    f32x4 gv[4];
#pragma unroll
    for (int j = 0; j < 4; ++j) gv[j] = ((const f32x4*)g)[lane + 64 * j];
    for (int r = gw; r < M; r += ngw) {
        const f32x4* xr = (const f32x4*)(x + (size_t)r * D) + lane;
        f32x4 v[4]; float s = 0.f;
#pragma unroll
        for (int j = 0; j < 4; ++j) { v[j] = xr[64 * j]; s += (v[j][0] * v[j][0] + v[j][1] * v[j][1]) + (v[j][2] * v[j][2] + v[j][3] * v[j][3]); }
        const float rstd = rsqrtf(wave_sum(s) * (1.f / D) + EPS);
        u32x2* o8 = (u32x2*)(xn + (size_t)r * D) + lane;
#pragma unroll
        for (int j = 0; j < 4; ++j) o8[64 * j] = (u32x2){pk2(v[j][0] * rstd * gv[j][0], v[j][1] * rstd * gv[j][1]), pk2(v[j][2] * rstd * gv[j][2], v[j][3] * rstd * gv[j][3])};
    }
}
DI void norm_rows_f32_inplace(float* x, const float* g) {
    const int tid_ = my_tid(), lane = tid_ & 63, gw = blockIdx.x * 8 + (tid_ >> 6), ngw = gridDim.x * 8;
    f32x4 gv[4];
#pragma unroll
    for (int j = 0; j < 4; ++j) gv[j] = ((const f32x4*)g)[lane + 64 * j];
    for (int r = gw; r < M; r += ngw) {
        f32x4* xr = (f32x4*)(x + (size_t)r * D) + lane;
        f32x4 v[4]; float s = 0.f;
#pragma unroll
        for (int j = 0; j < 4; ++j) { v[j] = xr[64 * j]; s += (v[j][0] * v[j][0] + v[j][1] * v[j][1]) + (v[j][2] * v[j][2] + v[j][3] * v[j][3]); }
        const float rstd = rsqrtf(wave_sum(s) * (1.f / D) + EPS);
#pragma unroll
        for (int j = 0; j < 4; ++j) xr[64 * j] = (f32x4){v[j][0] * rstd * gv[j][0], v[j][1] * rstd * gv[j][1], v[j][2] * rstd * gv[j][2], v[j][3] * rstd * gv[j][3]};
    }
}

DI int perm64(int p) { return (p >> 1) + 32 * (p & 1); }
DI int perm32r(int p) { return (p >> 1) + 16 * (p & 1); }
DI int map_in(int c) {
    if (c < 512) return (c & ~63) + perm64(c & 63);
    if (c < 1280) { const int t = (c - 512) >> 8, cc = (c - 512) & 255, kv = cc >> 7, g = (cc >> 6) & 1, p = cc & 63; return 512 + t * 256 + kv * 128 + g * 64 + (kv == 0 ? perm64(p) : p); }
    if (c < 1536) return 1304 + (c - 1280);
    if (c < 1792) { const int cc = c - 1536; if (cc < 128) return 1560 + cc; if (cc < 160) return 1688 + perm32r(cc - 128); if (cc < 184) return 1280 + (cc - 160); return -1; }
    if (c < 2816) return 1720 + (c - 1792);
    return 2744 + (c - 2816);
}
struct Wts {
    const float *w_in, *cmp_pe, *cmp_w1, *cmp_w2, *nsa_w_o, *q_norm, *kv_norm, *w_uq, *w_ukv, *mla_w_o, *w_out, *w_up, *w_down;
};
template <int JOB> DI float prep_get(const Wts& W, int n, int k) {
    if constexpr (JOB == 0) { const int c = map_in(n); return c >= 0 ? W.w_in[(size_t)k * IN_COLS + c] : 0.f; }
    if constexpr (JOB == 1) { const int j = n >> 8, h = n & 255, lp = k >> 6, p = k & 63, d = j == 0 ? perm64(p) : p; return W.cmp_w1[((size_t)j * 2048 + lp * 64 + d) * 256 + h]; }
    if constexpr (JOB == 2) { const int j = n >> 8, np = n & 255; return np < 64 ? W.cmp_w2[((size_t)j * 256 + k) * 64 + (j == 0 ? perm64(np) : np)] : 0.f; }
    if constexpr (JOB == 3) { return n < 1024 ? W.nsa_w_o[(size_t)k * 1024 + n] : W.mla_w_o[(size_t)k * 1024 + (n - 1024)]; }
    if constexpr (JOB == 4) { const int hh = n / 96, c = n - hh * 96; const int sc = c < 64 ? n : hh * 96 + 64 + perm32r(c - 64); return W.q_norm[k] * W.w_uq[(size_t)k * 768 + sc]; }
    if constexpr (JOB == 5) { return k < 128 ? W.kv_norm[k] * W.w_ukv[(size_t)k * 1024 + n] : 0.f; }
    if constexpr (JOB == 6) { return W.w_out[(size_t)k * 1024 + n]; }
    if constexpr (JOB == 7) { return W.w_up[(size_t)k * 4096 + n]; }
    if constexpr (JOB == 8) { return W.w_down[(size_t)k * 1024 + n]; }
    return 0.f;
}
template <int JOB> DI void prep_tile(const Wts& W, LAS float* scr, bf16_t* dst, int ldd, int n0, int k0) {
    const int tid = my_tid();
#pragma unroll
    for (int it = 0; it < 8; ++it) { const int kk = it * 8 + (tid >> 6), nn = tid & 63; scr[kk * 65 + nn] = prep_get<JOB>(W, n0 + nn, k0 + kk); }
    __syncthreads();
    { const int n = tid >> 3, kc = tid & 7; const LAS float* s = scr + (kc * 8) * 65 + n;
      u32x4 o = {pk2(s[0], s[65]), pk2(s[130], s[195]), pk2(s[260], s[325]), pk2(s[390], s[455])};
      *(u32x4*)(dst + (size_t)(n0 + n) * ldd + k0 + kc * 8) = o; }
    __syncthreads();
}
DI void prep_tile_vec(const float* src, int ldsrc, LAS float* scr, bf16_t* dst, int ldd, int n0, int k0) {
    const int tid = my_tid();
    f32x4 v[4];
#pragma unroll
    for (int it = 0; it < 4; ++it) v[it] = *(const f32x4*)(src + (size_t)(k0 + it * 32 + (tid >> 4)) * ldsrc + (tid & 15) * 4);
#pragma unroll
    for (int it = 0; it < 4; ++it) { LAS float* d = scr + (it * 32 + (tid >> 4)) * 65 + (tid & 15) * 4; d[0] = v[it][0]; d[1] = v[it][1]; d[2] = v[it][2]; d[3] = v[it][3]; }
    __syncthreads();
    { const int n = tid >> 3, kc = tid & 7;
#pragma unroll
      for (int hh = 0; hh < 2; ++hh) { const LAS float* s = scr + (hh * 64 + kc * 8) * 65 + n;
        u32x4 o = {pk2(s[0], s[65]), pk2(s[130], s[195]), pk2(s[260], s[325]), pk2(s[390], s[455])};
        *(u32x4*)(dst + (size_t)(n0 + n) * ldd + k0 + hh * 64 + kc * 8) = o; } }
    __syncthreads();
}
DI void prep_phase(const Wts& W, unsigned char* ws, LAS unsigned char* lds, int layer) {
    LAS float* scr = (LAS float*)lds;
    const int tid = my_tid();
    constexpr int T0a = 384, T0 = T0a + 288, T1 = T0 + 256, T2 = T1 + 32, T3 = T2 + 128, T4 = T3 + 48, T5 = T4 + 64, T6_ = T5 + 128, T7 = T6_ + 512, T8 = T7 + 512, TB = T8 + 8;
    for (int job = blockIdx.x; job < TB; job += gridDim.x) {
        int r = job;
        if (r < T0a) { const int ix = r >> 4, n0 = (ix < 20 ? ix : ix + 4) * 64;
            prep_tile<0>(W, scr, (bf16_t*)(ws + WS_WIN), 1024, n0, (r & 15) * 64); continue; }
        if (r < T0) { r -= T0a; const int ix = r >> 3, n0 = (ix < 4 ? 20 + ix : 24 + ix) * 64;
            prep_tile_vec(W.w_in + map_in(n0), IN_COLS, scr, (bf16_t*)(ws + WS_WIN), 1024, n0, (r & 7) * 128); continue; }
        if (r < T1) { r -= T0; prep_tile<1>(W, scr, (bf16_t*)(ws + WS_W1T), 2048, (r >> 5) * 64, (r & 31) * 64); continue; }
        if (r < T2) { r -= T1; prep_tile<2>(W, scr, (bf16_t*)(ws + WS_W2T), 256, (r >> 2) * 64, (r & 3) * 64); continue; }
        if (r < T3) { r -= T2; const int n0 = (r >> 2) * 64, k0 = (r & 3) * 128;
            prep_tile_vec(n0 < 1024 ? W.nsa_w_o + n0 : W.mla_w_o + (n0 - 1024), 1024, scr, (bf16_t*)(ws + WS_WOAB), 512, n0, k0); continue; }
        if (r < T4) { r -= T3; prep_tile<4>(W, scr, (bf16_t*)(ws + WS_WUQ), 256, (r >> 2) * 64, (r & 3) * 64); continue; }
        if (r < T5) { r -= T4; prep_tile<5>(W, scr, (bf16_t*)(ws + WS_WUKV), 256, (r >> 2) * 64, (r & 3) * 64); continue; }
        if (r < T6_) { r -= T5; const int n0 = (r >> 3) * 64; prep_tile_vec(W.w_out + n0, 1024, scr, (bf16_t*)(ws + WS_WOUT), 1024, n0, (r & 7) * 128); continue; }
        if (r < T7) { r -= T6_; const int n0 = (r >> 3) * 64; prep_tile_vec(W.w_up + n0, 4096, scr, (bf16_t*)(ws + WS_WUP), 1024, n0, (r & 7) * 128); continue; }
        if (r < T8) { r -= T7; const int n0 = (r >> 5) * 64; prep_tile_vec(W.w_down + n0, 1024, scr, (bf16_t*)(ws + WS_WDN), 4096, n0, (r & 31) * 128); continue; }
        {
            r -= T8; const int j = r >> 2, hc = r & 3, kk = tid >> 4, h4 = (tid & 15) * 4;
            const float* pe = W.cmp_pe + j * 2048; const float* w1 = W.cmp_w1 + (size_t)j * 2048 * 256 + hc * 64 + h4;
            f32x4 a = {0.f, 0.f, 0.f, 0.f};
#pragma unroll 8
            for (int i = 0; i < 64; ++i) { const int k = kk + 32 * i; const f32x4 wv = *(const f32x4*)(w1 + (size_t)k * 256); a += wv * pe[k]; }
            LAS float* d = scr + kk * 64 + h4; d[0] = a[0]; d[1] = a[1]; d[2] = a[2]; d[3] = a[3];
            __syncthreads();
            if (tid < 64) { float sm = 0.f; for (int q = 0; q < 32; ++q) sm += scr[q * 64 + tid]; ((float*)(ws + WS_CB1))[j * 256 + hc * 64 + tid] = sm; }
            __syncthreads();
        }
    }
    if (layer == 0) {
        f32x2* cs64 = (f32x2*)(ws + WS_CS64); f32x2* cs32 = (f32x2*)(ws + WS_CS32);
        for (int idx = blockIdx.x * 512 + tid; idx < S * 48; idx += gridDim.x * 512) {
            int pos, i; float inv;
            if (idx < S * 32) { pos = idx >> 5; i = idx & 31; inv = (float)exp2(-(double)i * (13.287712379549449 / 32.0)); }
            else { const int e = idx - S * 32; pos = e >> 4; i = e & 15; inv = (float)exp2(-(double)i * (13.287712379549449 / 16.0)); }
            const float ang = (float)pos * inv;
            const double rev = (double)ang * 0.15915494309189535; const float fr = (float)(rev - floor(rev));
            const f32x2 v = {__builtin_amdgcn_cosf(fr), __builtin_amdgcn_sinf(fr)};
            if (idx < S * 32) cs64[idx] = v; else cs32[idx - S * 32] = v;
        }
    }
}

struct Params { const float* in[17]; float* out; unsigned char* ws; int ph_lo, ph_hi; };
typedef const __attribute__((address_space(4))) unsigned char* kaptr_t;
DI const float* karg_ptr(int byte_off) { kaptr_t ka = (kaptr_t)__builtin_amdgcn_kernarg_segment_ptr(); asm volatile("" : "+s"(ka)); return *(const float* const __attribute__((address_space(4)))*)(ka + byte_off); }
#define KIN(i) karg_ptr(8 * (i))

DI void grid_barrier_cg(cg::grid_group& grid) {
    asm volatile("s_waitcnt vmcnt(0) lgkmcnt(0)" ::: "memory");
    __syncthreads();
    if (threadIdx.x < 64) asm volatile("buffer_wbl2 sc1\n\ts_waitcnt vmcnt(0)" ::: "memory");
    __syncthreads();
    grid.sync();
    asm volatile("buffer_inv sc1\n\ts_waitcnt vmcnt(0)" ::: "memory");
}

#define XB_TMO      128
#define XB_XCNT(j)  (256  + 64 * (j))
#define XB_XSUB(j)  (1280 + 64 * (j))
#define XB_XGEN(j)  (2304 + 64 * (j))
#define XB_TOP      3328
#define XB_TOPGEN   3392
#define XCD_BAR_WORDS 3456
#define XB_SPIN_CAP (1u << 18)
DI unsigned xb_ld(unsigned* p)              { return __hip_atomic_load(p, __ATOMIC_RELAXED, __HIP_MEMORY_SCOPE_AGENT); }
DI unsigned xb_add(unsigned* p, unsigned v) { return __hip_atomic_fetch_add(p, v, __ATOMIC_RELAXED, __HIP_MEMORY_SCOPE_AGENT); }
DI unsigned xb_xcc_id() { return (unsigned)__builtin_amdgcn_s_getreg((3 << 11) | 20) & 0xFu; }
#define XB_SPIN(cond, bar) do { unsigned _sp = 0; while (cond) { __builtin_amdgcn_s_sleep(1); \
    if ((++_sp & 255u) == 0u) { if (xb_ld(&(bar)[XB_TMO])) break; if (_sp > XB_SPIN_CAP) { atomicAdd(&(bar)[XB_TMO], 1u); break; } } } } while (0)
DI void xcd_barrier_complete(unsigned* bar, unsigned x, unsigned& nloc, unsigned& nx) {
    const unsigned G = gridDim.x * gridDim.y * gridDim.z;
    unsigned sum, cnt, mine, sp = 0u;
    for (;;) {
        sum = 0u; cnt = 0u; mine = 0u;
#pragma unroll
        for (unsigned j = 0; j < 16; ++j) { const unsigned c = xb_ld(&bar[XB_XCNT(j)]); sum += c; cnt += (c > 0u) ? 1u : 0u; mine = (j == x) ? c : mine; }
        if (sum == G) break;
        __builtin_amdgcn_s_sleep(1);
        if ((++sp & 255u) == 0u) { if (xb_ld(&bar[XB_TMO])) break; if (sp > XB_SPIN_CAP) { atomicAdd(&bar[XB_TMO], 1u); break; } }
    }
    nloc = mine > 0u ? mine : 1u; nx = cnt > 0u ? cnt : 1u;
}
DI void xcd_barrier(unsigned* bar, volatile LAS unsigned* st) {
    asm volatile("s_waitcnt vmcnt(0)" ::: "memory");
    __syncthreads();
    if (threadIdx.x == 0) {
        const unsigned x = xb_xcc_id();
        __builtin_amdgcn_s_waitcnt(0);
        unsigned nloc = st[0], nx = st[1];
        if (nloc == 0u) { xcd_barrier_complete(bar, x, nloc, nx); st[0] = nloc; st[1] = nx; }
        const unsigned old = xb_add(&bar[XB_XSUB(x)], 1u);
        const unsigned gen = old / nloc;
        if (old + 1u == (gen + 1u) * nloc) {
            __builtin_amdgcn_fence(__ATOMIC_RELEASE, "agent");
            asm volatile("s_waitcnt vmcnt(0)" ::: "memory");
            const unsigned og = xb_add(&bar[XB_TOP], 1u);
            const unsigned tg = og / nx;
            if (og + 1u == (tg + 1u) * nx) xb_add(&bar[XB_TOPGEN], 1u);
            else XB_SPIN(xb_ld(&bar[XB_TOPGEN]) == tg, bar);
            __builtin_amdgcn_fence(__ATOMIC_ACQUIRE, "agent");
            xb_add(&bar[XB_XGEN(x)], 1u);
            asm volatile("s_waitcnt vmcnt(0)" ::: "memory");
        } else {
            XB_SPIN(xb_ld(&bar[XB_XGEN(x)]) == gen, bar);
            __builtin_amdgcn_fence(__ATOMIC_ACQUIRE, "agent");
            asm volatile("s_waitcnt vmcnt(0)" ::: "memory");
        }
    }
    __syncthreads();
}
template <bool FIRST> DI void grid_barrier(cg::grid_group& grid, LAS unsigned char* lds) {
    unsigned* bar = (unsigned*)((unsigned char*)karg_ptr(144) + WS_BAR);
    if constexpr (FIRST) {
        grid_barrier_cg(grid);
        if (threadIdx.x == 0) (void)xb_add(&bar[XB_XCNT(xb_xcc_id())], 1u);
    } else {
        xcd_barrier(bar, (volatile LAS unsigned*)(lds + MISC_OFF + 64));
    }
}

#define PH_IN(k) (lo <= (k) && (k) < hi)
#define PH_SEAM(k) do { if (PH_IN(k) && PH_IN((k) + 1)) grid_barrier<(k) == 0>(grid, lds); } while (0)
#define PH_ENV() int G = gridDim.x, bx = blockIdx.x; asm volatile("" : "+s"(G), "+s"(bx)); unsigned char* ws = (unsigned char*)karg_ptr(144); float* X = (float*)karg_ptr(136); \
                 const int tid = my_tid(); bf16_t* XN = (bf16_t*)(ws + WS_XN); (void)tid; (void)X; (void)XN; (void)G; (void)bx

template <int L> DI void run_layer(LAS unsigned char* lds, cg::grid_group& grid, int lo, int hi) {
    constexpr int P0 = 10 * L;
    if (PH_IN(P0 + 0)) for (int rep_ = 0; rep_ < ((((DUP_MASK >> 0) & 1) && L > 0) ? 2 : 1); ++rep_) { if (rep_) grid_barrier<false>(grid, lds);
        PH_ENV();
        Wts W;
        W.w_in = KIN(2) + (size_t)L * 1024 * IN_COLS; W.cmp_pe = KIN(3) + (size_t)L * 2 * 2048; W.cmp_w1 = KIN(4) + (size_t)L * 2 * 2048 * 256;
        W.cmp_w2 = KIN(5) + (size_t)L * 2 * 256 * 64; W.nsa_w_o = KIN(6) + (size_t)L * 512 * 1024; W.q_norm = KIN(7) + L * 256; W.kv_norm = KIN(8) + L * 128;
        W.w_uq = KIN(9) + (size_t)L * 256 * 768; W.w_ukv = KIN(10) + (size_t)L * 128 * 1024; W.mla_w_o = KIN(11) + (size_t)L * 512 * 1024;
        W.w_out = KIN(12) + (size_t)L * 1024 * 1024; W.w_up = KIN(14) + (size_t)L * 1024 * 4096; W.w_down = KIN(15) + (size_t)L * 4096 * 1024;
        prep_phase(W, ws, lds, L);
        unsigned* ctl = (unsigned*)(ws + WS_CTL);
        if (L == 0 && bx == 0 && tid < 2 * NL) atomicExch(ctl + tid * 64, 0u);
        norm_rows_bf16(L == 0 ? KIN(0) : X, KIN(1) + L * D, XN);
    }
    PH_SEAM(P0 + 0);
    if (PH_IN(P0 + 1)) for (int rep_ = 0; rep_ < (((DUP_MASK >> 1) & 1) ? 2 : 1); ++rep_) { if (rep_) grid_barrier<false>(grid, lds);
        PH_ENV();
        pg8::Gemm g{XN, (const bf16_t*)(ws + WS_WIN), 1024, 1024}; pg8::StaticOrder So; So.init(M, NIN, G, bx);
        EpiWrap<EpiInImpl> E; E.ws = ws;
        pg8::gemm_phase(lds, g, So, E);
    }
    PH_SEAM(P0 + 1);
    if (PH_IN(P0 + 2)) for (int rep_ = 0; rep_ < (((DUP_MASK >> 2) & 1) ? 2 : 1); ++rep_) { if (rep_) grid_barrier<false>(grid, lds);
        PH_ENV();
        if (bx < 32) {
            pg8::CmpOrder So{G, bx};
            { pg8::Gemm g{(const bf16_t*)(ws + WS_KCV), (const bf16_t*)(ws + WS_W1T), 1024, 2048}; EpiWrap<EpiC1Impl> E; E.ws = ws; pg8::gemm_phase(lds, g, So, E); }
            { pg8::Gemm g{(const bf16_t*)(ws + WS_HC), (const bf16_t*)(ws + WS_W2T), 256, 256}; EpiWrap<EpiC2Impl> E; E.ws = ws; pg8::gemm_phase(lds, g, So, E); }
        } else {
            { pg8::Gemm g{(const bf16_t*)(ws + WS_CQ), (const bf16_t*)(ws + WS_WUQ), 256, 256}; pg8::StaticOrder So; So.init(M, 768, G - 32, bx - 32);
              EpiWrap<EpiUQImpl> E; E.ws = ws;
              pg8::gemm_phase(lds, g, So, E); }
            { pg8::Gemm g{(const bf16_t*)(ws + WS_T6), (const bf16_t*)(ws + WS_WUKV), 256, 256}; pg8::StaticOrder So; So.init(M, 1024, G - 32, bx - 32);
              EpiWrap<EpiUKVImpl> E; E.ws = ws;
              pg8::gemm_phase(lds, g, So, E); }
        }
    }
    PH_SEAM(P0 + 2);
    if (PH_IN(P0 + 4)) for (int rep_ = 0; rep_ < (((DUP_MASK >> 4) & 1) ? 2 : 1); ++rep_) { if (rep_) grid_barrier<false>(grid, lds);
        PH_ENV();
        Bufs B; B.QN = (const bf16_t*)(ws + WS_QN); B.KS = (const bf16_t*)(ws + WS_KS); B.KW = (const bf16_t*)(ws + WS_KW); B.VST = (const bf16_t*)(ws + WS_VST);
        B.VWT = (const bf16_t*)(ws + WS_VWT); B.KCMP = (const bf16_t*)(ws + WS_KCMP); B.VCMPT = (const bf16_t*)(ws + WS_VCMPT); B.QM = (const bf16_t*)(ws + WS_QM);
        B.KM = (const bf16_t*)(ws + WS_KM); B.KPE = (const bf16_t*)(ws + WS_KPE); B.VMT = (const bf16_t*)(ws + WS_VMT); B.GN = (const float*)(ws + WS_GN); B.OAB = XN;
#if EXP_NOATTN
        { u32x4* o = (u32x4*)XN; for (size_t i = (size_t)bx * 512 + tid; i < (size_t)M * 1024 / 8; i += (size_t)G * 512) o[i] = (u32x4){0x3c003c00u, 0x3c003c00u, 0x3c003c00u, 0x3c003c00u}; (void)B; }
#else
        attn_phase(B, lds, (unsigned*)(ws + WS_CTL) + (L * 2 + rep_) * 64);
#endif
    }
    PH_SEAM(P0 + 4);
    if (PH_IN(P0 + 5)) for (int rep_ = 0; rep_ < (((DUP_MASK >> 5) & 1) ? 2 : 1); ++rep_) { if (rep_) grid_barrier<false>(grid, lds);
        PH_ENV();
        pg8::StaticOrder So; So.init(M, 1024, G, bx);
        { pg8::Gemm g{XN, (const bf16_t*)(ws + WS_WOAB), 1024, 512}; EpiWrap<EpiD1aImpl> E; E.ws = ws; pg8::gemm_phase(lds, g, So, E); }
        { pg8::Gemm g{XN + 512, (const bf16_t*)(ws + WS_WOAB) + 1024 * 512, 1024, 512}; EpiWrap<EpiD1bImpl> E; E.ws = ws; pg8::gemm_phase(lds, g, So, E); }
    }
    PH_SEAM(P0 + 5);
    if (PH_IN(P0 + 6)) for (int rep_ = 0; rep_ < (((DUP_MASK >> 6) & 1) ? 2 : 1); ++rep_) { if (rep_) grid_barrier<false>(grid, lds);
        PH_ENV();
        pg8::Gemm g{(const bf16_t*)(ws + WS_MG), (const bf16_t*)(ws + WS_WOUT), 1024, 1024}; pg8::StaticOrder So; So.init(M, 1024, G, bx);
        EpiWrap<EpiD2Impl> E; E.xin = (L == 0 ? KIN(0) : X); E.X = X;
        pg8::gemm_phase(lds, g, So, E);
    }
    PH_SEAM(P0 + 6);
    if (PH_IN(P0 + 7)) for (int rep_ = 0; rep_ < (((DUP_MASK >> 7) & 1) ? 2 : 1); ++rep_) { if (rep_) grid_barrier<false>(grid, lds);
        PH_ENV();
        norm_rows_bf16(X, KIN(13) + L * D, XN);
    }
    PH_SEAM(P0 + 7);
    if (PH_IN(P0 + 8)) for (int rep_ = 0; rep_ < (((DUP_MASK >> 8) & 1) ? 2 : 1); ++rep_) { if (rep_) grid_barrier<false>(grid, lds);
        PH_ENV();
        pg8::Gemm g{XN, (const bf16_t*)(ws + WS_WUP), 1024, 1024}; pg8::StaticOrder So; So.init(M, FF, G, bx);
        EpiWrap<EpiUpImpl> E; E.ws = ws;
        pg8::gemm_phase(lds, g, So, E);
    }
    PH_SEAM(P0 + 8);
    if (PH_IN(P0 + 9)) for (int rep_ = 0; rep_ < (((DUP_MASK >> 9) & 1) ? 2 : 1); ++rep_) { if (rep_) grid_barrier<false>(grid, lds);
        PH_ENV();
        pg8::Gemm g{(const bf16_t*)(ws + WS_HF), (const bf16_t*)(ws + WS_WDN), 4096, 4096}; pg8::StaticOrder So; So.init(M, 1024, G, bx);
        EpiWrap<EpiD2Impl> E; E.xin = X; E.X = X;
        pg8::gemm_phase(lds, g, So, E);
    }
    PH_SEAM(P0 + 9);
}

__global__ void __launch_bounds__(512, 2) mega(Params P) {
    extern __shared__ __attribute__((aligned(16))) unsigned char lds_raw[];
    LAS unsigned char* lds = (LAS unsigned char*)lds_raw;
    cg::grid_group grid = cg::this_grid();
    const int lo = P.ph_lo, hi = P.ph_hi;
    if (threadIdx.x < 2) ((volatile LAS unsigned*)(lds + MISC_OFF + 64))[threadIdx.x] = 0u;
    if (blockIdx.x == 0 && hi - lo > 1) { unsigned* bar = (unsigned*)((unsigned char*)karg_ptr(144) + WS_BAR);
        for (int i = threadIdx.x; i < XCD_BAR_WORDS; i += 512) __hip_atomic_store(bar + i, 0u, __ATOMIC_RELAXED, __HIP_MEMORY_SCOPE_AGENT); }
    __syncthreads();
    run_layer<0>(lds, grid, lo, hi);
    run_layer<1>(lds, grid, lo, hi);
    run_layer<2>(lds, grid, lo, hi);
    run_layer<3>(lds, grid, lo, hi);
    if (PH_IN(39) && PH_IN(40)) {   }
    if (PH_IN(40)) { float* X = (float*)karg_ptr(136); norm_rows_f32_inplace(X, KIN(16)); }
}

extern "C" void kernel_launch(void* const* d_in, const int* in_sizes, int n_in, void* d_out, int out_size, void* d_ws, size_t ws_size, hipStream_t stream) {
    static int grid = 0;
    if (grid == 0) {
        if (n_in != 17 || out_size != M * D || ws_size < WS_END) { fprintf(stderr, "kernel_launch: unexpected shapes (n_in %d out %d ws %zu)\n", n_in, out_size, ws_size); grid = -1; return; }
        int dev = 0, cus = 0, per_cu = 0;
        hipGetDevice(&dev);
        hipDeviceGetAttribute(&cus, hipDeviceAttributeMultiprocessorCount, dev);
        if (hipFuncSetAttribute((const void*)mega, hipFuncAttributeMaxDynamicSharedMemorySize, LDS_BYTES) != hipSuccess) { fprintf(stderr, "kernel_launch: hipFuncSetAttribute failed\n"); grid = -1; return; }
        if (hipOccupancyMaxActiveBlocksPerMultiprocessor(&per_cu, (const void*)mega, 512, LDS_BYTES) != hipSuccess || per_cu < 1) { fprintf(stderr, "kernel_launch: occupancy query gave %d\n", per_cu); per_cu = 1; }
        (void)hipGetLastError();
        grid = cus * per_cu;
        if (grid < 64) { fprintf(stderr, "kernel_launch: grid %d too small for the phase program\n", grid); grid = -1; return; }
    }
    if (grid < 0) return;
    Params p{};
    for (int i = 0; i < 17; ++i) p.in[i] = (const float*)d_in[i];
    p.out = (float*)d_out; p.ws = (unsigned char*)d_ws;
#if MK_MULTI
    for (int ph = 0; ph <= 40; ++ph) {
        p.ph_lo = ph; p.ph_hi = ph + 1;
        hipLaunchKernelGGL(mega, dim3(grid), dim3(512), LDS_BYTES, stream, p);
    }
#else
    p.ph_lo = 0; p.ph_hi = 41;
    void* args[] = {&p};
    hipError_t e = hipLaunchCooperativeKernel((const void*)mega, dim3(grid), dim3(512), args, LDS_BYTES, stream);
    if (e != hipSuccess) fprintf(stderr, "kernel_launch: cooperative launch failed: %s (grid %d)\n", hipGetErrorString(e), grid);
#endif
}
```
